# Optimizing an MI355X kernel written in HIP

```python
import math
import jax, jax.numpy as jnp
from jax import lax
import numpy as np

D_MODEL = 1024
BATCH = 2
SEQ = 16384
DEPTH = 4

GRID_W = 64
CTX_LEN = 256
D_MIX = D_MODEL
POOL_WINDOWS = (2, 4, 8, 16)
D_POOL = D_MIX // 4
POOL_GROUP = D_POOL // len(POOL_WINDOWS)
SWA_HEADS = 4
SWA_KV_HEADS = 2
SWA_HEAD_DIM = 64
SWA_WINDOW = 128
BLOCK = 128
MLA_HEADS = 4
MLA_NOPE = 64
MLA_ROPE = 32
MLA_V = 64
MLA_Q_RANK = 256
MLA_KV_RANK = 128
SGU_HEADS = 4
SGU_WIDTH = D_MIX // 4
SGU_HEAD_DIM = SGU_WIDTH // SGU_HEADS
SGU_CHUNK = 128
D_FF = 4 * D_MODEL
ROPE_BASE = 10000.0
DN_ALPHA = (2 * DEPTH) ** 0.25
DN_BETA = (8 * DEPTH) ** -0.25
N_MOD = 6
EPS = 1e-6

W_POOL = D_POOL
W_SWA_Q = SWA_HEADS * SWA_HEAD_DIM
W_MLA_CQ = MLA_Q_RANK
W_SGU = 2 * SGU_WIDTH
W_SWA_KV = SWA_KV_HEADS * SWA_HEAD_DIM
W_MLA_CKV = MLA_KV_RANK
W_MLA_KR = MLA_ROPE
C_POOL = 0
C_SWA_Q = C_POOL + W_POOL
C_MLA_CQ = C_SWA_Q + W_SWA_Q
C_SGU = C_MLA_CQ + W_MLA_CQ
C_KV = C_SGU + W_SGU
C_SWA_K = C_KV
C_SWA_V = C_SWA_K + W_SWA_KV
C_MLA_CKV = C_SWA_V + W_SWA_KV
C_MLA_KR = C_MLA_CKV + W_MLA_CKV
D_IN = C_MLA_KR + W_MLA_KR

kernel_name = 'hybrid_pool_swa_mla_sgu_dit_trunk'

F32 = jnp.float32


def cols(z, start, width):
    return z[..., start:start + width]


def layer_norm(x):
    xf = x.astype(F32)
    mu = jnp.mean(xf, axis=-1, keepdims=True)
    var = jnp.mean(jnp.square(xf - mu), axis=-1, keepdims=True)
    return ((xf - mu) * lax.rsqrt(var + EPS)).astype(x.dtype)


def layer_norm_affine(x, g, b):
    return layer_norm(x) * g + b


def rms_norm(x, g):
    xf = x.astype(F32)
    y = xf * lax.rsqrt(jnp.mean(jnp.square(xf), axis=-1, keepdims=True) + EPS)
    return y.astype(x.dtype) * g


def modulate(x, shift, scale):
    return layer_norm(x) * (1 + scale) + shift


def axial_angles(n, d_rot):
    rows = n // GRID_W
    row = jnp.repeat(jnp.arange(rows), GRID_W).astype(F32)
    col = jnp.tile(jnp.arange(GRID_W), rows).astype(F32)
    d_ax = d_rot // 2
    inv = ROPE_BASE ** (-jnp.arange(0, d_ax, 2, dtype=F32) / d_ax)
    return row[:, None] * inv, col[:, None] * inv


def _rotate(x, ang):
    xf = x.astype(F32)
    x1, x2 = jnp.split(xf, 2, axis=-1)
    cos, sin = jnp.cos(ang), jnp.sin(ang)
    return jnp.concatenate([x1 * cos - x2 * sin, x2 * cos + x1 * sin], axis=-1).astype(x.dtype)


def apply_axial_rope(x, angles):
    xr, xc = jnp.split(x, 2, axis=-1)
    return jnp.concatenate([_rotate(xr, angles[0]), _rotate(xc, angles[1])], axis=-1)


def pool_mixer(za, pool_w, pool_scale):
    b, n, _ = za.shape
    g_n = len(POOL_WINDOWS)
    xg = za.reshape(b, n, g_n, POOL_GROUP)
    xf = xg.astype(F32)
    cs = jnp.concatenate([jnp.zeros((b, 1, g_n, POOL_GROUP), F32), jnp.cumsum(xf, axis=1)], axis=1)
    t = jnp.arange(n)
    means = []
    for gi, w in enumerate(POOL_WINDOWS):
        lo = jnp.clip(t - w // 2, 0, n)
        hi = jnp.clip(t + w // 2, 0, n)
        s = cs[:, hi, gi] - cs[:, lo, gi]
        means.append(s / (hi - lo).astype(F32)[None, :, None])
    d = (jnp.stack(means, axis=2) - xf).astype(za.dtype)
    y = jnp.einsum('bngc,gce->bnge', d, pool_w).reshape(b, n, D_POOL)
    return y * pool_scale


def swa_latent(q, k, v, k_c, v_c, sink):
    b, n, _, d = q.shape
    nb = n // BLOCK
    grp = SWA_HEADS // SWA_KV_HEADS
    scale = d ** -0.5
    qb = q.reshape(b, nb, BLOCK, SWA_KV_HEADS, grp, d)
    pad = ((0, 0), (BLOCK, BLOCK), (0, 0), (0, 0))
    kp = jnp.pad(k, pad).reshape(b, nb + 2, BLOCK, SWA_KV_HEADS, d)
    vp = jnp.pad(v, pad).reshape(b, nb + 2, BLOCK, SWA_KV_HEADS, d)
    kband = jnp.concatenate([kp[:, :-2], kp[:, 1:-1], kp[:, 2:]], axis=2)
    vband = jnp.concatenate([vp[:, :-2], vp[:, 1:-1], vp[:, 2:]], axis=2)
    s_band = jnp.einsum('bnqhgd,bnkhd->bnhgqk', qb, kband, preferred_element_type=F32) * scale
    qpos = jnp.arange(nb)[:, None] * BLOCK + jnp.arange(BLOCK)[None, :]
    kpos = (jnp.arange(nb)[:, None] - 1) * BLOCK + jnp.arange(3 * BLOCK)[None, :]
    rel = kpos[:, None, :] - qpos[:, :, None]
    valid = (jnp.abs(rel) <= SWA_WINDOW) & (kpos[:, None, :] >= 0) & (kpos[:, None, :] < n)
    s_band = jnp.where(valid[None, :, None, None], s_band, -jnp.inf)
    s_ctx = jnp.einsum('bnqhgd,bchd->bnhgqc', qb, k_c, preferred_element_type=F32) * scale
    sink_col = jnp.broadcast_to(sink.astype(F32).reshape(SWA_KV_HEADS, grp)[:, :, None, None],
                                s_band.shape[:-1] + (1,))
    p = jax.nn.softmax(jnp.concatenate([s_band, s_ctx, sink_col], axis=-1), axis=-1)
    nk = 3 * BLOCK
    n_ctx = k_c.shape[1]
    o = (jnp.einsum('bnhgqk,bnkhd->bnqhgd', p[..., :nk].astype(v.dtype), vband)
         + jnp.einsum('bnhgqc,bchd->bnqhgd', p[..., nk:nk + n_ctx].astype(v.dtype), v_c))
    return o.reshape(b, n, SWA_HEADS * d)


def swa_context(q_c, k_c, v_c, sink):
    b, n, _, d = q_c.shape
    grp = SWA_HEADS // SWA_KV_HEADS
    qg = q_c.reshape(b, n, SWA_KV_HEADS, grp, d)
    s = jnp.einsum('bqhgd,bkhd->bhgqk', qg, k_c, preferred_element_type=F32) * d ** -0.5
    sink_col = jnp.broadcast_to(sink.astype(F32).reshape(SWA_KV_HEADS, grp)[None, :, :, None, None],
                                s.shape[:-1] + (1,))
    p = jax.nn.softmax(jnp.concatenate([s, sink_col], axis=-1), axis=-1)[..., :n]
    o = jnp.einsum('bhgqk,bkhd->bqhgd', p.astype(v_c.dtype), v_c)
    return o.reshape(b, n, SWA_HEADS * d)


def mla_expand_q(cq, g, w_uq):
    b, n, _ = cq.shape
    q = (rms_norm(cq, g) @ w_uq).reshape(b, n, MLA_HEADS, MLA_NOPE + MLA_ROPE)
    return q[..., :MLA_NOPE], q[..., MLA_NOPE:]


def mla_expand_kv(ckv, g, w_ukv):
    b, n, _ = ckv.shape
    kv = (rms_norm(ckv, g) @ w_ukv).reshape(b, n, MLA_HEADS, MLA_NOPE + MLA_V)
    return kv[..., :MLA_NOPE], kv[..., MLA_NOPE:]


def kv_sources(zkv, kv_norm, w_ukv):
    b, n, _ = zkv.shape
    k = cols(zkv, C_SWA_K - C_KV, W_SWA_KV).reshape(b, n, SWA_KV_HEADS, SWA_HEAD_DIM)
    v = cols(zkv, C_SWA_V - C_KV, W_SWA_KV).reshape(b, n, SWA_KV_HEADS, SWA_HEAD_DIM)
    kn, vm = mla_expand_kv(cols(zkv, C_MLA_CKV - C_KV, W_MLA_CKV), kv_norm, w_ukv)
    kr = cols(zkv, C_MLA_KR - C_KV, W_MLA_KR)
    return k, v, kn, kr, vm


def mla_latent(qn, qr, kn, kr, vm, kn_c, kr_c, vm_c):
    b, n, h, _ = qn.shape
    nb = n // BLOCK
    scale = (MLA_NOPE + MLA_ROPE) ** -0.5
    qn_b = qn.reshape(b, nb, BLOCK, h, MLA_NOPE).transpose(1, 0, 2, 3, 4)
    qr_b = qr.reshape(b, nb, BLOCK, h, MLA_ROPE).transpose(1, 0, 2, 3, 4)

    def one_block(args):
        qn_i, qr_i = args
        s_lat = (jnp.einsum('bqhd,bkhd->bhqk', qn_i, kn, preferred_element_type=F32)
                 + jnp.einsum('bqhr,bkr->bhqk', qr_i, kr, preferred_element_type=F32)) * scale
        s_ctx = (jnp.einsum('bqhd,bkhd->bhqk', qn_i, kn_c, preferred_element_type=F32)
                 + jnp.einsum('bqhr,bkr->bhqk', qr_i, kr_c, preferred_element_type=F32)) * scale
        p = jax.nn.softmax(jnp.concatenate([s_lat, s_ctx], axis=-1), axis=-1)
        return (jnp.einsum('bhqk,bkhd->bqhd', p[..., :n].astype(vm.dtype), vm)
                + jnp.einsum('bhqk,bkhd->bqhd', p[..., n:].astype(vm.dtype), vm_c))

    o = lax.map(one_block, (qn_b, qr_b))
    return o.transpose(1, 0, 2, 3, 4).reshape(b, n, h * MLA_V)


def mla_context(qn, qr, kn, kr, vm):
    b, n, h, _ = qn.shape
    scale = (MLA_NOPE + MLA_ROPE) ** -0.5
    s = (jnp.einsum('bqhd,bkhd->bhqk', qn, kn, preferred_element_type=F32)
         + jnp.einsum('bqhr,bkr->bhqk', qr, kr, preferred_element_type=F32)) * scale
    p = jax.nn.softmax(s, axis=-1).astype(vm.dtype)
    return jnp.einsum('bhqk,bkhd->bqhd', p, vm).reshape(b, n, h * MLA_V)


def sgu_mixer(zd, norm_g, norm_b, w_s, b_s):
    b, n, _ = zd.shape
    z = jax.nn.gelu(zd, approximate=False)
    u, v = jnp.split(z, 2, axis=-1)
    v = layer_norm_affine(v, norm_g, norm_b)
    nc = n // SGU_CHUNK
    vc = v.reshape(b, nc, SGU_CHUNK, SGU_HEADS, SGU_HEAD_DIM)
    mixed = jnp.einsum('hpq,bcqhd->bcphd', w_s, vc) + b_s.T[None, None, :, :, None]
    return u * mixed.reshape(b, n, SGU_WIDTH)


def channel_mlp(h, w1, w2):
    return jnp.square(jax.nn.relu(h @ w1)) @ w2


def setup_inputs(seed: int = 0) -> dict:
    key = jax.random.key(seed)
    ks = jax.random.split(key, 32)
    L, D = DEPTH, D_MODEL

    def nrm(i, shape, s):
        return jax.random.normal(ks[i], shape, F32) * s

    gate_offset = jnp.repeat(jnp.array([0., 0., 1., 0., 0., 1.], F32), D)
    return {
        'x': nrm(0, (BATCH, SEQ, D), 1.0),
        'c': nrm(1, (BATCH, D), 1.0),
        'ctx': nrm(2, (BATCH, CTX_LEN, D), 1.0),
        'c_ctx': nrm(3, (D,), 1.0),
        'w_ada': nrm(4, (L, D, N_MOD * D), 0.25 * D ** -0.5),
        'b_ada': nrm(5, (L, N_MOD * D), 0.02) + gate_offset,
        'w_in': nrm(6, (L, D, D_IN), D ** -0.5),
        'pool_w': nrm(7, (L, len(POOL_WINDOWS), POOL_GROUP, POOL_GROUP), POOL_GROUP ** -0.5),
        'pool_scale': 1.0 + nrm(8, (L, D_POOL), 0.1),
        'swa_sink': nrm(9, (L, SWA_HEADS), 0.5),
        'mla_q_norm': 1.0 + nrm(10, (L, MLA_Q_RANK), 0.02),
        'mla_w_uq': nrm(11, (L, MLA_Q_RANK, MLA_HEADS * (MLA_NOPE + MLA_ROPE)), MLA_Q_RANK ** -0.5),
        'mla_kv_norm': 1.0 + nrm(12, (L, MLA_KV_RANK), 0.02),
        'mla_w_ukv': nrm(13, (L, MLA_KV_RANK, MLA_HEADS * (MLA_NOPE + MLA_V)), MLA_KV_RANK ** -0.5),
        'sgu_norm_g': 1.0 + nrm(14, (L, SGU_WIDTH), 0.02),
        'sgu_norm_b': nrm(15, (L, SGU_WIDTH), 0.02),
        'sgu_w': nrm(16, (L, SGU_HEADS, SGU_CHUNK, SGU_CHUNK), SGU_CHUNK ** -0.5),
        'sgu_b': 1.0 + nrm(17, (L, SGU_HEADS, SGU_CHUNK), 0.02),
        'w_out': nrm(18, (L, D_MIX, D), D_MIX ** -0.5 * DN_BETA),
        'ln1_g': 1.0 + nrm(19, (L, D), 0.02),
        'ln1_b': nrm(20, (L, D), 0.02),
        'w_ff1': nrm(21, (L, D, D_FF), D ** -0.5),
        'w_ff2': nrm(22, (L, D_FF, D), D_FF ** -0.5 * DN_BETA),
        'ln2_g': 1.0 + nrm(23, (L, D), 0.02),
        'ln2_b': nrm(24, (L, D), 0.02),
    }


def reference(x, c, ctx, c_ctx, w_ada, b_ada, w_in, pool_w, pool_scale, swa_sink,
              mla_q_norm, mla_w_uq, mla_kv_norm, mla_w_ukv, sgu_norm_g, sgu_norm_b,
              sgu_w, sgu_b, w_out, ln1_g, ln1_b, w_ff1, w_ff2, ln2_g, ln2_b):
    b, n, _ = x.shape
    n_ctx = ctx.shape[1]
    swa_ang = axial_angles(n, SWA_HEAD_DIM)
    swa_ang_h = (swa_ang[0][:, None, :], swa_ang[1][:, None, :])
    mla_ang = axial_angles(n, MLA_ROPE)
    mla_ang_h = (mla_ang[0][:, None, :], mla_ang[1][:, None, :])
    s_c = jax.nn.silu(c)
    s_cc = jax.nn.silu(c_ctx)

    for l in range(DEPTH):
        last = l == DEPTH - 1
        m = jnp.split((s_c @ w_ada[l] + b_ada[l])[:, None, :], N_MOD, axis=-1)
        n_mod_c = 2 if last else N_MOD
        mc = jnp.split(s_cc @ w_ada[l][:, :n_mod_c * D_MODEL] + b_ada[l][:n_mod_c * D_MODEL], n_mod_c)

        hc = modulate(ctx, mc[0], mc[1])
        if last:
            zkv_c = hc @ w_in[l][:, C_KV:]
        else:
            zc = hc @ w_in[l]
            zkv_c = zc[..., C_KV:]
        k_c, v_c, kn_c, kr_c, vm_c = kv_sources(zkv_c, mla_kv_norm[l], mla_w_ukv[l])

        h = modulate(x, m[0], m[1])
        z = h @ w_in[l]
        k, v, kn, kr, vm = kv_sources(z[..., C_KV:], mla_kv_norm[l], mla_w_ukv[l])
        k = apply_axial_rope(k, swa_ang_h)
        kr = apply_axial_rope(kr, mla_ang)
        q = apply_axial_rope(cols(z, C_SWA_Q, W_SWA_Q).reshape(b, n, SWA_HEADS, SWA_HEAD_DIM), swa_ang_h)
        qn, qr = mla_expand_q(cols(z, C_MLA_CQ, W_MLA_CQ), mla_q_norm[l], mla_w_uq[l])
        qr = apply_axial_rope(qr, mla_ang_h)
        y = jnp.concatenate([
            pool_mixer(cols(z, C_POOL, W_POOL), pool_w[l], pool_scale[l]),
            swa_latent(q, k, v, k_c, v_c, swa_sink[l]),
            mla_latent(qn, qr, kn, kr, vm, kn_c, kr_c, vm_c),
            sgu_mixer(cols(z, C_SGU, W_SGU), sgu_norm_g[l], sgu_norm_b[l], sgu_w[l], sgu_b[l]),
        ], axis=-1) @ w_out[l]
        x = layer_norm_affine(DN_ALPHA * x + m[2] * y, ln1_g[l], ln1_b[l])
        f = channel_mlp(modulate(x, m[3], m[4]), w_ff1[l], w_ff2[l])
        x = layer_norm_affine(DN_ALPHA * x + m[5] * f, ln2_g[l], ln2_b[l])

        if not last:
            q_c = cols(zc, C_SWA_Q, W_SWA_Q).reshape(b, n_ctx, SWA_HEADS, SWA_HEAD_DIM)
            qn_c, qr_c = mla_expand_q(cols(zc, C_MLA_CQ, W_MLA_CQ), mla_q_norm[l], mla_w_uq[l])
            yc = jnp.concatenate([
                pool_mixer(cols(zc, C_POOL, W_POOL), pool_w[l], pool_scale[l]),
                swa_context(q_c, k_c, v_c, swa_sink[l]),
                mla_context(qn_c, qr_c, kn_c, kr_c, vm_c),
                sgu_mixer(cols(zc, C_SGU, W_SGU), sgu_norm_g[l], sgu_norm_b[l], sgu_w[l], sgu_b[l]),
            ], axis=-1) @ w_out[l]
            ctx = layer_norm_affine(DN_ALPHA * ctx + mc[2] * yc, ln1_g[l], ln1_b[l])
            fc = channel_mlp(modulate(ctx, mc[3], mc[4]), w_ff1[l], w_ff2[l])
            ctx = layer_norm_affine(DN_ALPHA * ctx + mc[5] * fc, ln2_g[l], ln2_b[l])
    return x
```

```cpp
#include <hip/hip_runtime.h>
#include <hip/hip_cooperative_groups.h>
#include <cstdio>
namespace cg = cooperative_groups;
namespace pg8 {
#define PG8_LAS __attribute__((address_space(3)))
typedef unsigned short bf16_t;
typedef short bf16x8 __attribute__((ext_vector_type(8)));
typedef float f32x4 __attribute__((ext_vector_type(4)));
typedef unsigned u32x4 __attribute__((ext_vector_type(4)));
constexpr int BM = 256, BK = 64, HALF = 128, HTB = HALF * BK * 2  , STAGE_BYTES = 8 * HTB, NXCD = 8, WGM = 8;

__host__ __device__ __forceinline__ int lds_byte(int r, int c) { const int st = (r >> 4) * 2 + (c >> 5), rr = r & 15, cc = c & 31, ob = rr * 64 + cc * 2; return st * 1024 + (ob ^ (((ob >> 9) & 1) << 5)); }
__host__ __device__ __forceinline__ void stage_rc(int b, int& R, int& C) { const int st = b / 1024, sb = b % 1024, swz = sb ^ (((sb >> 9) & 1) << 5); R = (st >> 1) * 16 + swz / 64; C = (st & 1) * 32 + (swz % 64) / 2; }
__host__ __device__ __forceinline__ int perm32(int rho) { const int n = rho >> 4, i = rho & 15; return 8 * (i >> 2) + 4 * n + (i & 3); }

struct Unit { int pm, pn; };
struct Gemm { const bf16_t* A; const bf16_t* Bt; int M, N, K; };

struct StaticOrder {
    int nM, nN, nwg, G, c;
    __host__ __device__ void init(int M, int N, int G_, int c_) { nM = M / BM; nN = N / BM; nwg = nM * nN; G = G_; c = c_; }
    __host__ __device__ bool next(int i, Unit& u) const {
        const long L = (long)i * G + c; if (L >= nwg) return false;
        int wgid = (int)L; { const int q = nwg / NXCD, r = nwg % NXCD, xcd = wgid % NXCD, off = wgid / NXCD; wgid = (xcd < r ? xcd * (q + 1) : r * (q + 1) + (xcd - r) * q) + off; }
        const int nig = WGM * nN, gid = wgid / nig, fm = gid * WGM, gsz = (nM - fm) < WGM ? (nM - fm) : WGM;
        u.pm = fm + ((wgid % nig) % gsz); u.pn = (wgid % nig) / gsz; return true;
    }
    __device__ __forceinline__ void a_ready(const Unit&) const {}
    __device__ __forceinline__ void done(const Unit&) const {}
};
struct CountedOrder : StaticOrder {
    const unsigned* ready; unsigned need; unsigned* tmo;
    __device__ __forceinline__ void a_ready(const Unit& u) const {
        if (threadIdx.x < 64) {
            const unsigned long long t0 = __builtin_amdgcn_s_memrealtime(); unsigned polls = 0;
            while ((unsigned)__builtin_amdgcn_readfirstlane(__hip_atomic_load(ready + 64 * u.pm, __ATOMIC_RELAXED, __HIP_MEMORY_SCOPE_AGENT)) < need) {
                if ((++polls & 255u) == 0u && __builtin_amdgcn_readfirstlane(__hip_atomic_load(tmo, __ATOMIC_RELAXED, __HIP_MEMORY_SCOPE_AGENT)) != 0u) break;
                if (__builtin_amdgcn_s_memrealtime() - t0 > 2000000ull) {
                    if (threadIdx.x == 0) { unsigned expect = 0u; __hip_atomic_compare_exchange_strong(tmo + 1, &expect, 0x600u | (unsigned)(u.pm & 0xff), __ATOMIC_RELAXED, __ATOMIC_RELAXED, __HIP_MEMORY_SCOPE_AGENT); __hip_atomic_store(tmo, 1u, __ATOMIC_RELAXED, __HIP_MEMORY_SCOPE_AGENT); }
                    break; }
                __builtin_amdgcn_s_sleep(2); }
            __builtin_amdgcn_fence(__ATOMIC_ACQUIRE, "agent");
            asm volatile("s_waitcnt vmcnt(0)" ::: "memory");
        }
#if !defined(BROKEN_HOOK_NO_BARRIER)
        asm volatile("" ::: "memory"); __builtin_amdgcn_s_barrier(); asm volatile("" ::: "memory");
#endif
    }
};

__device__ __forceinline__ unsigned cvt_pk_bf16(float lo, float hi) { unsigned r; asm volatile("v_cvt_pk_bf16_f32 %0, %1, %2" : "=v"(r) : "v"(lo), "v"(hi)); return r; }
typedef float f32x2 __attribute__((ext_vector_type(2)));
__device__ __forceinline__ f32x2 gelu_pk(f32x2 v) {
    const f32x2 av = __builtin_elementwise_abs(v), d = av * 0.2316418882f + 1.0f;
    f32x2 t; t.x = __builtin_amdgcn_rcpf(d.x); t.y = __builtin_amdgcn_rcpf(d.y);
    f32x2 q = t * 0.5307027145f + (-0.7265760135f); q = q * t + 0.7107068705f; q = q * t + (-0.142248368f); q = q * t + 0.127414796f; q = q * t;
    const f32x2 s = (v * v) * (-0.72134752044f);
    f32x2 e; e.x = __builtin_amdgcn_exp2f(s.x); e.y = __builtin_amdgcn_exp2f(s.y);
    const f32x2 m = v * (q * e), r = v - m;
    f32x2 o; o.x = v.x < 0.f ? m.x : r.x; o.y = v.y < 0.f ? m.y : r.y; return o;
}

struct EpiF32 {
    static constexpr bool PERM = false, AFTER_DRAIN = false;
    float* C; int ldc; const float* bias;
    __device__ __forceinline__ void operator()(const f32x4 (&acc)[2][2][4][2], const Unit& u, int wr, int wc, int fr, int fq) const {
        const int row0 = u.pm * BM + wr * 64 + fr, col0 = u.pn * BM + wc * 32 + 4 * fq;
        f32x4 bv[2][2];
#pragma unroll
        for (int bj = 0; bj < 2; ++bj)
#pragma unroll
            for (int n = 0; n < 2; ++n) bv[bj][n] = bias ? *(const f32x4*)(bias + col0 + bj * HALF + n * 16) : (f32x4){0.f, 0.f, 0.f, 0.f};
#pragma unroll
        for (int ai = 0; ai < 2; ++ai)
#pragma unroll
            for (int m = 0; m < 4; ++m) { float* rowp = C + (size_t)(row0 + ai * HALF + m * 16) * ldc + col0;
#pragma unroll
                for (int bj = 0; bj < 2; ++bj)
#pragma unroll
                    for (int n = 0; n < 2; ++n) *(f32x4*)(rowp + bj * HALF + n * 16) = acc[ai][bj][m][n] + bv[bj][n]; }
    }
};
template <int ACT  > struct EpiBf16 {
    static constexpr bool PERM = true, AFTER_DRAIN = false;
    bf16_t* O; int ldc; const float* bias; int split_cols; size_t split_stride;
    __device__ __forceinline__ void operator()(const f32x4 (&acc)[2][2][4][2], const Unit& u, int wr, int wc, int fr, int fq) const {
        const int row0 = u.pm * BM + wr * 64 + fr; int colt = u.pn * BM; bf16_t* base = O;
        if (split_cols) { const int t = colt / split_cols; base += (size_t)t * split_stride; colt -= t * split_cols; }
        const int col0 = colt + wc * 32 + 8 * fq, bcol0 = u.pn * BM + wc * 32 + 8 * fq;
        f32x4 bv[2][2];
#pragma unroll
        for (int bj = 0; bj < 2; ++bj)
#pragma unroll
            for (int n = 0; n < 2; ++n) bv[bj][n] = bias ? *(const f32x4*)(bias + bcol0 + bj * HALF + 4 * n) : (f32x4){0.f, 0.f, 0.f, 0.f};
#pragma unroll
        for (int ai = 0; ai < 2; ++ai)
#pragma unroll
            for (int m = 0; m < 4; ++m) { bf16_t* rowp = base + (size_t)(row0 + ai * HALF + m * 16) * ldc + col0;
#pragma unroll
                for (int bj = 0; bj < 2; ++bj) { f32x4 v0 = acc[ai][bj][m][0] + bv[bj][0], v1 = acc[ai][bj][m][1] + bv[bj][1];
                    if (ACT == 1) { f32x2 a = gelu_pk((f32x2){v0[0], v0[1]}), b = gelu_pk((f32x2){v0[2], v0[3]}), c = gelu_pk((f32x2){v1[0], v1[1]}), d = gelu_pk((f32x2){v1[2], v1[3]});
                        v0 = (f32x4){a.x, a.y, b.x, b.y}; v1 = (f32x4){c.x, c.y, d.x, d.y}; }
                    if (ACT == 2) {
#pragma unroll
                        for (int j = 0; j < 4; ++j) { v0[j] = 0.5f * v0[j] * (1.0f + erff(v0[j] * 0.70710678f)); v1[j] = 0.5f * v1[j] * (1.0f + erff(v1[j] * 0.70710678f)); } }
                    u32x4 w; w.x = cvt_pk_bf16(v0[0], v0[1]); w.y = cvt_pk_bf16(v0[2], v0[3]); w.z = cvt_pk_bf16(v1[0], v1[1]); w.w = cvt_pk_bf16(v1[2], v1[3]);
                    *(u32x4*)(rowp + bj * HALF) = w; } }
    }
};
template <class Epi, class Sched, bool STAMP = false>
__device__ __forceinline__ void gemm_phase(PG8_LAS unsigned char* lds, const Gemm g, const Sched& S, const Epi& E, unsigned long long* stamps) {
    int tid_raw = threadIdx.x; asm volatile("" : "+v"(tid_raw)); const int tid = tid_raw, wid = __builtin_amdgcn_readfirstlane(tid >> 6), lane = tid & 63, wr = wid >> 2, wc = wid & 3, fr = lane & 15, fq = lane >> 4;
    const int K = g.K, nt = K / BK;
    int ts_lo = 0, ts_hi = 0, nts = 0; const unsigned long long rt_entry = STAMP ? (unsigned long long)wall_clock64() : 0ull;
#define PG8_STAMP() do { if (STAMP && wid == 0 && nts < 64) { const unsigned long long _c = (unsigned long long)clock64(); \
        ts_lo = (lane == nts) ? (int)(unsigned)_c : ts_lo; ts_hi = (lane == nts) ? (int)(unsigned)(_c >> 32) : ts_hi; ++nts; } } while (0)
    PG8_STAMP();
    unsigned voffA[2], voffB[2];
#pragma unroll
    for (int i = 0; i < 2; ++i) { int R, C; stage_rc(tid * 16 + i * 8192, R, C); const int Rb = Epi::PERM ? ((R & ~31) + perm32(R & 31)) : R;
        voffA[i] = (unsigned)(R * K + C) * 2u; voffB[i] = (unsigned)(Rb * K + C) * 2u; }
    const size_t kstep = (size_t)(BK * 2);
    const size_t hstep = (size_t)HALF * K * 2;
    const size_t tstep = 2 * hstep;
    const unsigned ldsw = (unsigned)wid * 1024u;
    const int aoff = lds_byte(wr * 64 + fr, fq * 8), boff = lds_byte(wc * 32 + fr, fq * 8);
#define PG8_SA(b, h) (((b) * 2 + (h)) * HTB)
#define PG8_SB(b, h) ((4 + (b) * 2 + (h)) * HTB)
#define PG8_STAGE(bufoff, gbase, voff) do { _Pragma("unroll") for (int _i = 0; _i < 2; ++_i) \
        __builtin_amdgcn_global_load_lds((const unsigned*)((const char*)(gbase) + (voff)[_i]), (PG8_LAS unsigned*)(lds + (bufoff) + ldsw + _i * 8192), 16, 0, 0); } while (0)
#define PG8_LDA(dst, b, h) do { _Pragma("unroll") for (int m = 0; m < 4; ++m) _Pragma("unroll") for (int k = 0; k < 2; ++k) dst[m][k] = *(const PG8_LAS bf16x8*)(lds + PG8_SA(b, h) + aoff + m * 2048 + k * 1024); } while (0)
#define PG8_LDB(dst, b, h) do { _Pragma("unroll") for (int n = 0; n < 2; ++n) _Pragma("unroll") for (int k = 0; k < 2; ++k) dst[n][k] = *(const PG8_LAS bf16x8*)(lds + PG8_SB(b, h) + boff + n * 2048 + k * 1024); } while (0)
#define PG8_MMA(ai, bj, At, Bt) do { __builtin_amdgcn_s_setprio(1); _Pragma("unroll") for (int m = 0; m < 4; ++m) _Pragma("unroll") for (int n = 0; n < 2; ++n) _Pragma("unroll") for (int k = 0; k < 2; ++k) \
        acc[ai][bj][m][n] = __builtin_amdgcn_mfma_f32_16x16x32_bf16(Bt[n][k], At[m][k], acc[ai][bj][m][n], 0, 0, 0); __builtin_amdgcn_s_setprio(0); } while (0)
#define PG8_WAIT_V(n) asm volatile("s_waitcnt vmcnt(" #n ")" ::: "memory")
#define PG8_WAIT_L(n) asm volatile("s_waitcnt lgkmcnt(" #n ")" ::: "memory")
#define PG8_BAR __builtin_amdgcn_s_barrier()
#define PG8_SCHED __builtin_amdgcn_sched_barrier(0)
    Unit cur, nxt; int ui = 0;
    if (!S.next(0, cur)) return;
    f32x4 acc[2][2][4][2];
#pragma unroll
    for (int a = 0; a < 2; ++a)
#pragma unroll
        for (int b = 0; b < 2; ++b)
#pragma unroll
            for (int m = 0; m < 4; ++m)
#pragma unroll
                for (int n = 0; n < 2; ++n) acc[a][b][m][n] = (f32x4){0.f, 0.f, 0.f, 0.f};
    bf16x8 At[4][2], B0[2][2], B1[2][2];
    const char* cA = (const char*)g.A + (size_t)cur.pm * tstep; const char* cB = (const char*)g.Bt + (size_t)cur.pn * tstep;
    S.a_ready(cur);
    PG8_STAGE(PG8_SB(0, 0), cB, voffB); PG8_STAGE(PG8_SA(0, 0), cA, voffA); PG8_STAGE(PG8_SB(0, 1), cB + hstep, voffB); PG8_STAGE(PG8_SA(0, 1), cA + hstep, voffA);
    if (wr == 1) PG8_BAR;
    PG8_WAIT_V(4); PG8_BAR;
    PG8_STAGE(PG8_SB(1, 0), cB + kstep, voffB); PG8_STAGE(PG8_SA(1, 0), cA + kstep, voffA); PG8_STAGE(PG8_SB(1, 1), cB + hstep + kstep, voffB);
    PG8_WAIT_V(6); PG8_BAR;
    PG8_STAMP();
    for (;;) {
        const bool has_next = S.next(ui + 1, nxt);
        const char* nA = has_next ? (const char*)g.A + (size_t)nxt.pm * tstep : cA; const char* nB = has_next ? (const char*)g.Bt + (size_t)nxt.pn * tstep : cB;
        for (int t = 0; t < nt; t += 2) {
            const bool last = (t == nt - 2);
            const char* a1 = cA + (size_t)(t + 1) * kstep;
            const char* a2 = last ? nA : cA + (size_t)(t + 2) * kstep; const char* b2 = last ? nB : cB + (size_t)(t + 2) * kstep;
            const char* a3 = a2 + kstep; const char* b3 = b2 + kstep;
            if (last && has_next) S.a_ready(nxt);
            PG8_LDB(B0, 0, 0); PG8_SCHED; PG8_LDA(At, 0, 0); PG8_STAGE(PG8_SA(1, 1), a1 + hstep, voffA);
            PG8_WAIT_L(8); PG8_BAR; PG8_WAIT_L(0); PG8_MMA(0, 0, At, B0); PG8_BAR; PG8_SCHED;
            PG8_LDB(B1, 0, 1); PG8_STAGE(PG8_SB(0, 0), b2, voffB);
            PG8_BAR; PG8_WAIT_L(0); PG8_MMA(0, 1, At, B1); PG8_BAR;
            PG8_LDA(At, 0, 1); PG8_STAGE(PG8_SA(0, 0), a2, voffA);
            PG8_BAR; PG8_WAIT_L(0); PG8_MMA(1, 0, At, B0); PG8_BAR; PG8_SCHED;
            PG8_STAGE(PG8_SB(0, 1), b2 + hstep, voffB);
            PG8_WAIT_V(6); PG8_BAR; PG8_MMA(1, 1, At, B1); PG8_BAR;
            PG8_LDB(B0, 1, 0); PG8_SCHED; PG8_LDA(At, 1, 0); PG8_STAGE(PG8_SA(0, 1), a2 + hstep, voffA);
            PG8_WAIT_L(8); PG8_BAR; PG8_WAIT_L(0); PG8_MMA(0, 0, At, B0); PG8_BAR; PG8_SCHED;
            PG8_LDB(B1, 1, 1); PG8_STAGE(PG8_SB(1, 0), b3, voffB);
            PG8_BAR; PG8_WAIT_L(0); PG8_MMA(0, 1, At, B1); PG8_BAR;
            PG8_LDA(At, 1, 1); PG8_STAGE(PG8_SA(1, 0), a3, voffA);
            PG8_BAR; PG8_WAIT_L(0); PG8_MMA(1, 0, At, B0); PG8_BAR; PG8_SCHED;
            PG8_STAGE(PG8_SB(1, 1), b3 + hstep, voffB);
            PG8_WAIT_V(6); PG8_BAR; PG8_MMA(1, 1, At, B1); PG8_BAR;
        }
        PG8_STAMP();
        if constexpr (!Epi::AFTER_DRAIN) { E(acc, cur, wr, wc, fr, fq); S.done(cur); }
        PG8_STAMP();
        if (!has_next) break;
#pragma unroll
        for (int a = 0; a < 2; ++a)
#pragma unroll
            for (int b = 0; b < 2; ++b)
#pragma unroll
                for (int m = 0; m < 4; ++m)
#pragma unroll
                    for (int n = 0; n < 2; ++n) acc[a][b][m][n] = (f32x4){0.f, 0.f, 0.f, 0.f};
        cur = nxt; cA = nA; cB = nB; ++ui;
    }
    PG8_WAIT_V(0);
    if (wr == 0) PG8_BAR;
    PG8_BAR;
    if constexpr (Epi::AFTER_DRAIN) { E.fused(acc, cur, wr, wc, fr, fq, lds, wid, lane); S.done(cur); }
    PG8_STAMP();
    if (STAMP && wid == 0) { stamps[lane] = lane < nts ? (((unsigned long long)(unsigned)ts_hi << 32) | (unsigned)ts_lo) : 0ull;
        if (lane == 62) stamps[62] = rt_entry; if (lane == 63) stamps[63] = (unsigned long long)wall_clock64(); }
#undef PG8_STAMP
#undef PG8_SA
#undef PG8_SB
#undef PG8_STAGE
#undef PG8_LDA
#undef PG8_LDB
#undef PG8_MMA
#undef PG8_WAIT_V
#undef PG8_WAIT_L
#undef PG8_BAR
#undef PG8_SCHED
}
}

#define DI __device__ __forceinline__
using pg8::bf16_t; using pg8::bf16x8; using pg8::f32x4; using pg8::u32x4;
typedef short s16x4 __attribute__((ext_vector_type(4)));
typedef float f32x16 __attribute__((ext_vector_type(16)));
typedef unsigned u32x2 __attribute__((ext_vector_type(2)));
typedef __bf16 bf2_t __attribute__((ext_vector_type(2)));
typedef float f32x2_t __attribute__((ext_vector_type(2)));
typedef PG8_LAS unsigned char* lds_ptr;

constexpr int D = 1024, NLAT = 32768, NCTX = 512, R = NLAT + NCTX, SEQ = 16384, CTXL = 256, DEPTH = 4;
constexpr int DIN = 1696, DINP = 1792;
constexpr int C_SWA_Q = 256, C_MLA_CQ = 512, C_SGU = 768, C_SWA_K = 1280, C_SWA_V = 1408, C_MLA_CKV = 1536, C_MLA_KR = 1664;
constexpr float EPS = 1e-6f;
constexpr float DN_ALPHA = 1.681792830507429f;
constexpr float LOG2E = 1.4426950408889634f;
constexpr int LDS_BYTES = 131072;

constexpr size_t W_IN = 0;
constexpr size_t W_OUT = W_IN + (size_t)DINP * 1024 * 2;
constexpr size_t W_FF1 = W_OUT + (size_t)1024 * 1024 * 2;
constexpr size_t W_FF2 = W_FF1 + (size_t)4096 * 1024 * 2;
constexpr size_t W_UQ = W_FF2 + (size_t)4096 * 1024 * 2;
constexpr size_t W_UKV = W_UQ + (size_t)512 * 256 * 2;
constexpr size_t W_POOL = W_UKV + (size_t)512 * 256 * 2;
constexpr size_t W_SGU = W_POOL + (size_t)256 * 256 * 2;
constexpr size_t WS_MOD = W_SGU + (size_t)4 * 128 * 128 * 2;
constexpr size_t WS_TAB = WS_MOD + (size_t)DEPTH * 3 * 6144 * 4;
constexpr size_t WS_X = WS_TAB + (size_t)(320 * 16 + 320 * 8) * 8;
constexpr size_t WS_U = WS_X + (size_t)R * 1024 * 4;
constexpr size_t U_Z = 0;
constexpr size_t U_QRAW = U_Z + (size_t)R * DINP * 2;
constexpr size_t U_KVRAW = U_QRAW + (size_t)R * 512 * 2;
constexpr size_t U_CQN = U_KVRAW + (size_t)R * 512 * 2;
constexpr size_t U_CKVN = U_CQN + (size_t)R * 256 * 2;
constexpr size_t U_DPOOL = U_CKVN + (size_t)R * 256 * 2;
constexpr size_t U_UG = U_DPOOL + (size_t)R * 256 * 2;
constexpr size_t U_VG = U_UG + (size_t)R * 256 * 2;
constexpr size_t U_F1 = 0;
constexpr size_t U_H = (size_t)R * 4096 * 2;
constexpr size_t U_YCAT = U_H;
constexpr size_t WS_KSR = WS_U + U_H + (size_t)R * 1024 * 2;
constexpr size_t WS_KRR = WS_KSR + (size_t)R * 128 * 2;
constexpr size_t WS_END = WS_KRR + (size_t)R * 32 * 2;
static_assert(U_VG + (size_t)R * 256 * 2 == U_H, "mixer-mode buffers must exactly fill the f1 slot");
static_assert(WS_END <= (size_t)536870912, "workspace too large");
static_assert(WS_X % 256 == 0 && WS_U % 256 == 0 && WS_MOD % 256 == 0 && WS_TAB % 256 == 0, "alignment");

struct Params { const float* in[25]; float* out; unsigned char* ws; };
DI int tid_() { int t = threadIdx.x; asm volatile("" : "+v"(t)); return t; }
DI int bid_() { int t = blockIdx.x; asm volatile("" : "+s"(t)); return t; }
DI int nblk_() { int t = gridDim.x; asm volatile("" : "+s"(t)); return t; }
DI const Params& params_() { auto k = __builtin_amdgcn_kernarg_segment_ptr(); asm volatile("" : "+s"(k)); return *(const Params*)k; }


DI float bf2f(bf16_t b) { return __uint_as_float(((unsigned)b) << 16); }
DI unsigned pk2(float a, float b) { f32x2_t v = {a, b}; bf2_t r = __builtin_convertvector(v, bf2_t); return __builtin_bit_cast(unsigned, r); }
DI bf16_t f2bf(float a) { return (bf16_t)(pk2(a, 0.f) & 0xffffu); }
DI float lo_f(unsigned u) { return __uint_as_float(u << 16); }
DI float hi_f(unsigned u) { return __uint_as_float(u & 0xffff0000u); }
DI float wsum(float v) {
#pragma unroll
    for (int m = 32; m >= 1; m >>= 1) v += __shfl_xor(v, m);
    return v;
}
DI int crow16(int i, int h) { return (i & 3) + 8 * (i >> 2) + 4 * h; }
#define MFMA32(a, b, c) __builtin_amdgcn_mfma_f32_32x32x16_bf16((a), (b), (c), 0, 0, 0)
DI bf16x8 tr_pair(lds_ptr lo_addr, int hi_delta) {
    const s16x4 lo = __builtin_amdgcn_ds_read_tr16_b64_v4i16((PG8_LAS s16x4*)lo_addr);
    const s16x4 hi = __builtin_amdgcn_ds_read_tr16_b64_v4i16((PG8_LAS s16x4*)(lo_addr + hi_delta));
    return __builtin_shufflevector(lo, hi, 0, 1, 2, 3, 4, 5, 6, 7);
}

struct EpiResid {
    static constexpr bool PERM = false, AFTER_DRAIN = false;
    float* X; const float* modl; int idx;
    DI void operator()(const f32x4 (&acc)[2][2][4][2], const pg8::Unit& u, int wr, int wc, int fr, int fq) const {
        const int row0 = u.pm * 256 + wr * 64 + fr, col0 = u.pn * 256 + wc * 32 + 4 * fq;
        const int set = (u.pm < 64) ? 0 : (u.pm < 128 ? 1 : 2);
        const float* mp = modl + set * 6144 + idx * 1024 + col0;
        f32x4 mv[2][2];
#pragma unroll
        for (int bj = 0; bj < 2; ++bj)
#pragma unroll
            for (int n = 0; n < 2; ++n) mv[bj][n] = *(const f32x4*)(mp + bj * 128 + n * 16);
#pragma unroll
        for (int ai = 0; ai < 2; ++ai)
#pragma unroll
            for (int m = 0; m < 4; ++m) {
                float* rowp = X + (size_t)(row0 + ai * 128 + m * 16) * 1024 + col0;
#pragma unroll
                for (int bj = 0; bj < 2; ++bj)
#pragma unroll
                    for (int n = 0; n < 2; ++n) {
                        const f32x4 xv = *(const f32x4*)(rowp + bj * 128 + n * 16);
                        *(f32x4*)(rowp + bj * 128 + n * 16) = xv * DN_ALPHA + mv[bj][n] * acc[ai][bj][m][n];
                    }
            }
    }
};
struct EpiRelu2 {
    static constexpr bool PERM = true, AFTER_DRAIN = false;
    bf16_t* O; int ldc;
    DI void operator()(const f32x4 (&acc)[2][2][4][2], const pg8::Unit& u, int wr, int wc, int fr, int fq) const {
        const int row0 = u.pm * 256 + wr * 64 + fr, col0 = u.pn * 256 + wc * 32 + 8 * fq;
#pragma unroll
        for (int ai = 0; ai < 2; ++ai)
#pragma unroll
            for (int m = 0; m < 4; ++m) {
                bf16_t* rowp = O + (size_t)(row0 + ai * 128 + m * 16) * ldc + col0;
#pragma unroll
                for (int bj = 0; bj < 2; ++bj) {
                    f32x4 v0 = acc[ai][bj][m][0], v1 = acc[ai][bj][m][1];
#pragma unroll
                    for (int j = 0; j < 4; ++j) { const float a = fmaxf(v0[j], 0.f), b = fmaxf(v1[j], 0.f); v0[j] = a * a; v1[j] = b * b; }
                    u32x4 w; w.x = pk2(v0[0], v0[1]); w.y = pk2(v0[2], v0[3]); w.z = pk2(v1[0], v1[1]); w.w = pk2(v1[2], v1[3]);
                    *(u32x4*)(rowp + bj * 128) = w;
                }
            }
    }
};

template <class Epi>
DI void run_gemm(lds_ptr lds3, const bf16_t* A, const bf16_t* Bt, int M, int N, int K, const Epi& E) {
    pg8::Gemm g; g.A = A; g.Bt = Bt; g.M = M; g.N = N; g.K = K;
    pg8::StaticOrder S; S.init(M, N, (int)nblk_(), (int)bid_());
    pg8::gemm_phase<Epi, pg8::StaticOrder, false>(lds3, g, S, E, nullptr);
}

DI void phase_adaln(const Params& p, float* lf) {
    for (int i = tid_(); i < 3072; i += 512) {
        const int s = i >> 10, k = i & 1023;
        const float v = (s < 2) ? p.in[1][s * 1024 + k] : p.in[3][k];
        lf[i] = v / (1.f + expf(-v));
    }
    __syncthreads();
    float* red = lf + 3072;
    const int wid = tid_() >> 6, lane = tid_() & 63;
    float* mod = (float*)(p.ws + WS_MOD);
    for (int item = bid_(); item < DEPTH * 96; item += nblk_()) {
        const int l = item / 96, jc = (item % 96) * 64;
        const float* w = p.in[4] + (size_t)l * 1024 * 6144 + jc + lane;
        float a0 = 0.f, a1 = 0.f, a2 = 0.f;
        const int i0 = wid * 128;
#pragma unroll 8
        for (int i = 0; i < 128; ++i) {
            const float wv = w[(size_t)(i0 + i) * 6144];
            a0 += lf[i0 + i] * wv; a1 += lf[1024 + i0 + i] * wv; a2 += lf[2048 + i0 + i] * wv;
        }
        red[(wid * 3 + 0) * 64 + lane] = a0; red[(wid * 3 + 1) * 64 + lane] = a1; red[(wid * 3 + 2) * 64 + lane] = a2;
        __syncthreads();
        if (tid_() < 192) {
            const int s = tid_() >> 6;
            float sum = 0.f;
#pragma unroll
            for (int w8 = 0; w8 < 8; ++w8) sum += red[(w8 * 3 + s) * 64 + lane];
            mod[((size_t)l * 3 + s) * 6144 + jc + lane] = sum + p.in[5][l * 6144 + jc + lane];
        }
        __syncthreads();
    }
}

DI void phase_tables(const Params& p) {
    float2* tS = (float2*)(p.ws + WS_TAB);
    float2* tM = tS + 320 * 16;
    const int gtid = bid_() * 512 + tid_(), gsz = nblk_() * 512;
    const float L2B = 13.287712379549449f;
    for (int i = gtid; i < 320 * 16 + 320 * 8; i += gsz) {
        int pos, f; float inv;
        if (i < 320 * 16) { pos = i >> 4; f = i & 15; inv = exp2f(-(float)(2 * f) * (1.f / 32.f) * L2B); }
        else { const int k = i - 320 * 16; pos = k >> 3; f = k & 7; inv = exp2f(-(float)(2 * f) * (1.f / 16.f) * L2B); }
        const float ang = (float)(pos < 256 ? pos : pos - 256) * inv;
        const double ad = (double)ang;
        const double kk = __builtin_rint(ad * 0.15915494309189535);
        const float rr = (float)(ad - kk * 6.283185307179586);
        tS[i] = make_float2(__cosf(rr), __sinf(rr));
    }
}

DI void conv_tile(const float* src, int K, int N, bf16_t* dst, int KP, int tk, int tn, bf16_t* tile) {
    const int t = tid_();
#pragma unroll
    for (int rep = 0; rep < 2; ++rep) {
        const int kl = rep * 32 + (t >> 4), nl = (t & 15) * 4;
        const int k = tk * 64 + kl, n = tn * 64 + nl;
        float4 v = make_float4(0.f, 0.f, 0.f, 0.f);
        if (k < K && n < N) v = *(const float4*)(src + (size_t)k * N + n);
        tile[(nl + 0) * 72 + kl] = f2bf(v.x); tile[(nl + 1) * 72 + kl] = f2bf(v.y);
        tile[(nl + 2) * 72 + kl] = f2bf(v.z); tile[(nl + 3) * 72 + kl] = f2bf(v.w);
    }
    __syncthreads();
    {
        const int nl = t >> 3, kl = (t & 7) * 8;
        const u32x4 w = *(const u32x4*)(tile + nl * 72 + kl);
        *(u32x4*)(dst + (size_t)(tn * 64 + nl) * KP + tk * 64 + kl) = w;
    }
    __syncthreads();
}

DI void convert_layer(const Params& p, int l, unsigned char* smem) {
    bf16_t* tile = (bf16_t*)smem;
    constexpr int T_IN = 16 * 28, T_OUT = 16 * 16, T_FF1 = 16 * 64, T_FF2 = 64 * 16, T_UQ = 4 * 8, T_UKV = 4 * 8;
    constexpr int T_ALL = T_IN + T_OUT + T_FF1 + T_FF2 + T_UQ + T_UKV;
    for (int t = bid_(); t < T_ALL; t += nblk_()) {
        const float* src; int K, N, KP, NT; size_t off; int tt = t;
        if (tt < T_IN) { src = p.in[6] + (size_t)l * 1024 * DIN; K = 1024; N = DIN; KP = 1024; NT = 28; off = W_IN; }
        else if ((tt -= T_IN) < T_OUT) { src = p.in[18] + (size_t)l * 1024 * 1024; K = 1024; N = 1024; KP = 1024; NT = 16; off = W_OUT; }
        else if ((tt -= T_OUT) < T_FF1) { src = p.in[21] + (size_t)l * 1024 * 4096; K = 1024; N = 4096; KP = 1024; NT = 64; off = W_FF1; }
        else if ((tt -= T_FF1) < T_FF2) { src = p.in[22] + (size_t)l * 4096 * 1024; K = 4096; N = 1024; KP = 4096; NT = 16; off = W_FF2; }
        else if ((tt -= T_FF2) < T_UQ) { src = p.in[11] + (size_t)l * 256 * 384; K = 256; N = 384; KP = 256; NT = 8; off = W_UQ; }
        else { tt -= T_UQ; src = p.in[13] + (size_t)l * 128 * 512; K = 128; N = 512; KP = 256; NT = 8; off = W_UKV; }
        conv_tile(src, K, N, (bf16_t*)(p.ws + off), KP, tt / NT, tt % NT, tile);
    }
    const int gtid = bid_() * 512 + tid_(), gsz = nblk_() * 512;
    {
        bf16_t* dst = (bf16_t*)(p.ws + W_POOL);
        const float* pw = p.in[7] + (size_t)l * 4 * 64 * 64; const float* ps = p.in[8] + l * 256;
        for (int i = gtid; i < 65536; i += gsz) {
            const int row = i >> 8, col = i & 255, g = row >> 6, e = row & 63;
            float v = 0.f;
            if ((col >> 6) == g) v = pw[(g * 64 + (col & 63)) * 64 + e] * ps[row];
            dst[i] = f2bf(v);
        }
    }
    {
        bf16_t* dst = (bf16_t*)(p.ws + W_SGU);
        const float* sw = p.in[16] + (size_t)l * 65536;
        for (int i = gtid; i < 65536; i += gsz) dst[i] = f2bf(sw[i]);
    }
}

DI void phase_ln(const Params& p, int mode, const float* g, const float* b, const float* modl, int i0) {
    const int wid = tid_() >> 6, lane = tid_() & 63;
    float* X = (float*)(p.ws + WS_X);
    bf16_t* H = (bf16_t*)(p.ws + WS_U + U_H);
    const int rmax = (mode == 2) ? NLAT : R;
    for (int r = bid_() * 8 + wid; r < rmax; r += nblk_() * 8) {
        const float* src;
        if (mode == 0) src = (r < NLAT) ? p.in[0] + (size_t)r * 1024 : p.in[2] + (size_t)(r - NLAT) * 1024;
        else src = X + (size_t)r * 1024;
        float4 v[4];
#pragma unroll
        for (int j = 0; j < 4; ++j) v[j] = *(const float4*)(src + 4 * lane + 256 * j);
        if (mode != 0) {
            float s = 0.f;
#pragma unroll
            for (int j = 0; j < 4; ++j) s += v[j].x + v[j].y + v[j].z + v[j].w;
            const float mu = wsum(s) * (1.f / 1024.f);
            float q = 0.f;
#pragma unroll
            for (int j = 0; j < 4; ++j) { v[j].x -= mu; v[j].y -= mu; v[j].z -= mu; v[j].w -= mu; q += v[j].x * v[j].x + v[j].y * v[j].y + v[j].z * v[j].z + v[j].w * v[j].w; }
            const float rs = rsqrtf(wsum(q) * (1.f / 1024.f) + EPS);
#pragma unroll
            for (int j = 0; j < 4; ++j) {
                const float4 gg = *(const float4*)(g + 4 * lane + 256 * j), bb = *(const float4*)(b + 4 * lane + 256 * j);
                v[j].x = v[j].x * rs * gg.x + bb.x; v[j].y = v[j].y * rs * gg.y + bb.y; v[j].z = v[j].z * rs * gg.z + bb.z; v[j].w = v[j].w * rs * gg.w + bb.w;
            }
        }
        float* dstx = (mode == 2) ? p.out + (size_t)r * 1024 : X + (size_t)r * 1024;
#pragma unroll
        for (int j = 0; j < 4; ++j) *(float4*)(dstx + 4 * lane + 256 * j) = v[j];
        if (mode != 2) {
            float s = 0.f;
#pragma unroll
            for (int j = 0; j < 4; ++j) s += v[j].x + v[j].y + v[j].z + v[j].w;
            const float mu = wsum(s) * (1.f / 1024.f);
            float q = 0.f;
#pragma unroll
            for (int j = 0; j < 4; ++j) { v[j].x -= mu; v[j].y -= mu; v[j].z -= mu; v[j].w -= mu; q += v[j].x * v[j].x + v[j].y * v[j].y + v[j].z * v[j].z + v[j].w * v[j].w; }
            const float rs = rsqrtf(wsum(q) * (1.f / 1024.f) + EPS);
            const int set = (r < SEQ) ? 0 : (r < NLAT ? 1 : 2);
            const float* msh = modl + set * 6144 + i0 * 1024, *msc = msh + 1024;
#pragma unroll
            for (int j = 0; j < 4; ++j) {
                const float4 sh = *(const float4*)(msh + 4 * lane + 256 * j), sc = *(const float4*)(msc + 4 * lane + 256 * j);
                u32x2 o;
                o.x = pk2(v[j].x * rs * (1.f + sc.x) + sh.x, v[j].y * rs * (1.f + sc.y) + sh.y);
                o.y = pk2(v[j].z * rs * (1.f + sc.z) + sh.z, v[j].w * rs * (1.f + sc.w) + sh.w);
                *(u32x2*)(H + (size_t)r * 1024 + 4 * lane + 256 * j) = o;
            }
        }
    }
}

DI float gelu_exact(float x) { return 0.5f * x * (1.f + erff(x * 0.70710678118654752f)); }

DI void phase_postz(const Params& p, int l) {
    const int wid = tid_() >> 6, lane = tid_() & 63;
    unsigned char* U = p.ws + WS_U;
    const bf16_t* Z = (const bf16_t*)(U + U_Z);
    bf16_t* KSR = (bf16_t*)(p.ws + WS_KSR); bf16_t* KRR = (bf16_t*)(p.ws + WS_KRR);
    bf16_t* CQN = (bf16_t*)(U + U_CQN); bf16_t* CKVN = (bf16_t*)(U + U_CKVN); bf16_t* DPOOL = (bf16_t*)(U + U_DPOOL);
    bf16_t* UG = (bf16_t*)(U + U_UG); bf16_t* VG = (bf16_t*)(U + U_VG);
    const float2* tS = (const float2*)(p.ws + WS_TAB); const float2* tM = tS + 320 * 16;
    const float* gq = p.in[10] + l * 256; const float* gkv = p.in[12] + l * 128;
    const float* sg = p.in[14] + l * 256; const float* sb = p.in[15] + l * 256;
    for (int r = bid_() * 8 + wid; r < R; r += nblk_() * 8) {
        const bf16_t* zr = Z + (size_t)r * DINP;
        const bool lat = r < NLAT;
        const int t = r & (SEQ - 1), rp = t >> 6, cp = t & 63;
        {
            const int hd = lane >> 5, pp = lane & 31, i = pp & 15, off = hd * 64 + ((pp & 16) ? 32 : 0);
            const float x1 = bf2f(zr[C_SWA_K + off + i]), x2 = bf2f(zr[C_SWA_K + off + 16 + i]);
            float o1 = x1, o2 = x2;
            if (lat) { const float2 cs = (pp & 16) ? tS[(256 + cp) * 16 + i] : tS[rp * 16 + i]; o1 = x1 * cs.x - x2 * cs.y; o2 = x2 * cs.x + x1 * cs.y; }
            KSR[(size_t)r * 128 + off + i] = f2bf(o1); KSR[(size_t)r * 128 + off + 16 + i] = f2bf(o2);
        }
        if (lane < 16) {
            const int i = lane & 7, off = (lane & 8) ? 16 : 0;
            const float x1 = bf2f(zr[C_MLA_KR + off + i]), x2 = bf2f(zr[C_MLA_KR + off + 8 + i]);
            float o1 = x1, o2 = x2;
            if (lat) { const float2 cs = (lane & 8) ? tM[(256 + cp) * 8 + i] : tM[rp * 8 + i]; o1 = x1 * cs.x - x2 * cs.y; o2 = x2 * cs.x + x1 * cs.y; }
            KRR[(size_t)r * 32 + off + i] = f2bf(o1); KRR[(size_t)r * 32 + off + 8 + i] = f2bf(o2);
        }
        {
            const u32x2 w = *(const u32x2*)(zr + C_MLA_CQ + 4 * lane);
            const float a0 = lo_f(w.x), a1 = hi_f(w.x), a2 = lo_f(w.y), a3 = hi_f(w.y);
            const float rs = rsqrtf(wsum(a0 * a0 + a1 * a1 + a2 * a2 + a3 * a3) * (1.f / 256.f) + EPS);
            const float4 gg = *(const float4*)(gq + 4 * lane);
            u32x2 o; o.x = pk2(a0 * rs * gg.x, a1 * rs * gg.y); o.y = pk2(a2 * rs * gg.z, a3 * rs * gg.w);
            *(u32x2*)(CQN + (size_t)r * 256 + 4 * lane) = o;
        }
        {
            const unsigned w = *(const unsigned*)(zr + C_MLA_CKV + 2 * lane);
            const float a0 = lo_f(w), a1 = hi_f(w);
            const float rs = rsqrtf(wsum(a0 * a0 + a1 * a1) * (1.f / 128.f) + EPS);
            const float2 gg = *(const float2*)(gkv + 2 * lane);
            *(unsigned*)(CKVN + (size_t)r * 256 + 2 * lane) = pk2(a0 * rs * gg.x, a1 * rs * gg.y);
            *(unsigned*)(CKVN + (size_t)r * 256 + 128 + 2 * lane) = 0u;
        }
        {
            const u32x2 wu = *(const u32x2*)(zr + C_SGU + 4 * lane);
            u32x2 ou; ou.x = pk2(gelu_exact(lo_f(wu.x)), gelu_exact(hi_f(wu.x))); ou.y = pk2(gelu_exact(lo_f(wu.y)), gelu_exact(hi_f(wu.y)));
            *(u32x2*)(UG + (size_t)r * 256 + 4 * lane) = ou;
            const u32x2 wv = *(const u32x2*)(zr + C_SGU + 256 + 4 * lane);
            float a0 = gelu_exact(lo_f(wv.x)), a1 = gelu_exact(hi_f(wv.x)), a2 = gelu_exact(lo_f(wv.y)), a3 = gelu_exact(hi_f(wv.y));
            const float mu = wsum(a0 + a1 + a2 + a3) * (1.f / 256.f);
            a0 -= mu; a1 -= mu; a2 -= mu; a3 -= mu;
            const float rs = rsqrtf(wsum(a0 * a0 + a1 * a1 + a2 * a2 + a3 * a3) * (1.f / 256.f) + EPS);
            const float4 gg = *(const float4*)(sg + 4 * lane), bb = *(const float4*)(sb + 4 * lane);
            u32x2 ov; ov.x = pk2(a0 * rs * gg.x + bb.x, a1 * rs * gg.y + bb.y); ov.y = pk2(a2 * rs * gg.z + bb.z, a3 * rs * gg.w + bb.w);
            *(u32x2*)(VG + (size_t)r * 256 + 4 * lane) = ov;
        }
        {
            const int hw = 1 << (lane >> 4);
            int sbase, n, tt;
            if (lat) { sbase = r & ~(SEQ - 1); n = SEQ; tt = t; }
            else { sbase = NLAT + ((r - NLAT) & ~(CTXL - 1)); n = CTXL; tt = (r - NLAT) & (CTXL - 1); }
            const int lo = max(tt - hw, 0), hi = min(tt + hw, n);
            float s0 = 0.f, s1 = 0.f, s2 = 0.f, s3 = 0.f;
            for (int q = lo; q < hi; ++q) {
                const u32x2 w = *(const u32x2*)(Z + (size_t)(sbase + q) * DINP + 4 * lane);
                s0 += lo_f(w.x); s1 += hi_f(w.x); s2 += lo_f(w.y); s3 += hi_f(w.y);
            }
            const float inv = 1.f / (float)(hi - lo);
            const u32x2 wx = *(const u32x2*)(zr + 4 * lane);
            u32x2 o; o.x = pk2(s0 * inv - lo_f(wx.x), s1 * inv - hi_f(wx.x)); o.y = pk2(s2 * inv - lo_f(wx.y), s3 * inv - hi_f(wx.y));
            *(u32x2*)(DPOOL + (size_t)r * 256 + 4 * lane) = o;
        }
    }
}

DI void rot8_scale(u32x4& a, u32x4& b, const float2* tab, bool rope, float qs) {
#pragma unroll
    for (int e = 0; e < 4; ++e) {
        const float x1a = lo_f(a[e]), x1b = hi_f(a[e]), x2a = lo_f(b[e]), x2b = hi_f(b[e]);
        float y1a = x1a, y1b = x1b, y2a = x2a, y2b = x2b;
        if (rope) {
            const float2 ca = tab[2 * e], cb = tab[2 * e + 1];
            y1a = x1a * ca.x - x2a * ca.y; y2a = x2a * ca.x + x1a * ca.y;
            y1b = x1b * cb.x - x2b * cb.y; y2b = x2b * cb.x + x1b * cb.y;
        }
        a[e] = pk2(y1a * qs, y1b * qs); b[e] = pk2(y2a * qs, y2b * qs);
    }
}
DI void scale8(u32x4& a, float qs) {
#pragma unroll
    for (int e = 0; e < 4; ++e) a[e] = pk2(lo_f(a[e]) * qs, hi_f(a[e]) * qs);
}

template <int DQK>
DI void attn_item(unsigned char* smem, lds_ptr lds3, const float2* tabR, const float2* tabC,
                  const bf16_t* qbase, int ldq, bool rope, int t0, float qscale,
                  const bf16_t* k1, int ldk1, const bf16_t* k2, const bf16_t* vb, int ldv,
                  int rowA, int lenA, int posA, bool mask, int rowB, int lenB,
                  float m0, float l0, bf16_t* ob) {
    constexpr int QP = DQK * 2 + 16, VP = 144, NKS = DQK / 16, CPK = DQK / 8;
    constexpr int K_OFF = 256 * QP, KB = 64 * QP, V_OFF = K_OFF + 2 * KB, VB = 64 * VP;
    static_assert(V_OFF + 2 * VB <= LDS_BYTES, "attention LDS");
    const int tid = tid_(), wid = tid >> 6, lane = tid & 63, l31 = lane & 31, h = lane >> 5;
    {
        const int row = tid >> 1, hh = tid & 1;
        const bf16_t* qr = qbase + (size_t)row * ldq;
        unsigned char* qd = smem + row * QP;
        const int tq = t0 + row, rp = tq >> 6, cp = tq & 63;
        if constexpr (DQK == 64) {
            u32x4 c[4];
#pragma unroll
            for (int j = 0; j < 4; ++j) c[j] = *(const u32x4*)(qr + 32 * hh + 8 * j);
            const float2* tab = hh ? (tabC + cp * 16) : (tabR + rp * 16);
            rot8_scale(c[0], c[2], tab, rope, qscale);
            rot8_scale(c[1], c[3], tab + 8, rope, qscale);
#pragma unroll
            for (int j = 0; j < 4; ++j) *(u32x4*)(qd + (32 * hh + 8 * j) * 2) = c[j];
        } else {
            u32x4 c[6];
#pragma unroll
            for (int j = 0; j < 6; ++j) c[j] = *(const u32x4*)(qr + 48 * hh + 8 * j);
            if (hh) {
                scale8(c[0], qscale); scale8(c[1], qscale);
                rot8_scale(c[2], c[3], tabR + rp * 8, rope, qscale);
                rot8_scale(c[4], c[5], tabC + cp * 8, rope, qscale);
            } else {
#pragma unroll
                for (int j = 0; j < 6; ++j) scale8(c[j], qscale);
            }
#pragma unroll
            for (int j = 0; j < 6; ++j) *(u32x4*)(qd + (48 * hh + 8 * j) * 2) = c[j];
        }
    }
    __syncthreads();
    bf16x8 qf[NKS];
#pragma unroll
    for (int ks = 0; ks < NKS; ++ks) qf[ks] = *(const bf16x8*)(smem + (32 * wid + l31) * QP + (16 * ks + 8 * h) * 2);

    const int nA = lenA >> 6, nT = nA + (lenB >> 6);
    u32x4 kr0, kr1, vr;
    auto gload = [&](int j) {
        const int row0 = (j < nA) ? rowA + 64 * j : rowB + 64 * (j - nA);
        {
            const int key = tid / CPK, c = tid % CPK;
            const bf16_t* src = (c < 8) ? k1 + (size_t)(row0 + key) * ldk1 + 8 * c : k2 + (size_t)(row0 + key) * 32 + 8 * (c - 8);
            kr0 = *(const u32x4*)src;
        }
        if constexpr (DQK == 96) {
            if (tid < 256) {
                const int idx = tid + 512, key = idx / CPK, c = idx % CPK;
                const bf16_t* src = (c < 8) ? k1 + (size_t)(row0 + key) * ldk1 + 8 * c : k2 + (size_t)(row0 + key) * 32 + 8 * (c - 8);
                kr1 = *(const u32x4*)src;
            }
        }
        vr = *(const u32x4*)(vb + (size_t)(row0 + (tid >> 3)) * ldv + 8 * (tid & 7));
    };
    auto sstore = [&](int buf) {
        {
            const int key = tid / CPK, c = tid % CPK;
            *(u32x4*)(smem + K_OFF + buf * KB + key * QP + 16 * c) = kr0;
        }
        if constexpr (DQK == 96) {
            if (tid < 256) { const int idx = tid + 512, key = idx / CPK, c = idx % CPK; *(u32x4*)(smem + K_OFF + buf * KB + key * QP + 16 * c) = kr1; }
        }
        *(u32x4*)(smem + V_OFF + buf * VB + (tid >> 3) * VP + 16 * (tid & 7)) = vr;
    };

    f32x16 O0, O1;
#pragma unroll
    for (int i = 0; i < 16; ++i) { O0[i] = 0.f; O1[i] = 0.f; }
    float mrun = m0, lsum = l0 * (h == 0 ? 1.f : 0.f);
    const int qpos = t0 + 32 * wid + l31;
    const int q4 = (lane & 15) >> 2, p4 = lane & 3, blk = (lane >> 4) & 1;
    const int vlane = (4 * h + q4) * VP + 32 * blk + 8 * p4;

    gload(0); sstore(0);
    __syncthreads();
    for (int j = 0; j < nT; ++j) {
        const int buf = j & 1;
        if (j + 1 < nT) gload(j + 1);
        {
            const unsigned char* Kt = smem + K_OFF + buf * KB;
            f32x16 S0, S1;
#pragma unroll
            for (int i = 0; i < 16; ++i) { S0[i] = 0.f; S1[i] = 0.f; }
#pragma unroll
            for (int ks = 0; ks < NKS; ++ks) {
                const bf16x8 a0 = *(const bf16x8*)(Kt + l31 * QP + (16 * ks + 8 * h) * 2);
                const bf16x8 a1 = *(const bf16x8*)(Kt + (32 + l31) * QP + (16 * ks + 8 * h) * 2);
                S0 = MFMA32(a0, qf[ks], S0);
                S1 = MFMA32(a1, qf[ks], S1);
            }
            if (mask && j < nA) {
                const int d0 = posA + 64 * j - qpos;
#pragma unroll
                for (int i = 0; i < 16; ++i) {
                    const int dd = d0 + crow16(i, h);
                    if (dd > 128 || dd < -128) S0[i] = -1e30f;
                    if (dd + 32 > 128 || dd + 32 < -128) S1[i] = -1e30f;
                }
            }
            float mx = fmaxf(S0[0], S1[0]);
#pragma unroll
            for (int i = 1; i < 16; ++i) mx = fmaxf(mx, fmaxf(S0[i], S1[i]));
            mx = fmaxf(mx, __shfl_xor(mx, 32));
            const float mnew = fmaxf(mrun, mx);
            const float alpha = __builtin_amdgcn_exp2f(mrun - mnew);
            mrun = mnew;
            float ps = 0.f;
#pragma unroll
            for (int i = 0; i < 16; ++i) {
                S0[i] = __builtin_amdgcn_exp2f(S0[i] - mnew); S1[i] = __builtin_amdgcn_exp2f(S1[i] - mnew);
                ps += S0[i] + S1[i];
            }
            lsum = lsum * alpha + ps;
#pragma unroll
            for (int i = 0; i < 16; ++i) { O0[i] *= alpha; O1[i] *= alpha; }
            lds_ptr Vt = lds3 + V_OFF + buf * VB + vlane;
#pragma unroll
            for (int mt = 0; mt < 2; ++mt)
#pragma unroll
                for (int s = 0; s < 2; ++s) {
                    u32x4 pw;
                    if (mt == 0) { pw.x = pk2(S0[8 * s], S0[8 * s + 1]); pw.y = pk2(S0[8 * s + 2], S0[8 * s + 3]); pw.z = pk2(S0[8 * s + 4], S0[8 * s + 5]); pw.w = pk2(S0[8 * s + 6], S0[8 * s + 7]); }
                    else { pw.x = pk2(S1[8 * s], S1[8 * s + 1]); pw.y = pk2(S1[8 * s + 2], S1[8 * s + 3]); pw.z = pk2(S1[8 * s + 4], S1[8 * s + 5]); pw.w = pk2(S1[8 * s + 6], S1[8 * s + 7]); }
                    const bf16x8 pf = __builtin_bit_cast(bf16x8, pw);
                    const bf16x8 v0 = tr_pair(Vt + (32 * mt + 16 * s) * VP, 8 * VP);
                    const bf16x8 v1 = tr_pair(Vt + (32 * mt + 16 * s) * VP + 64, 8 * VP);
                    O0 = MFMA32(v0, pf, O0);
                    O1 = MFMA32(v1, pf, O1);
                }
        }
        if (j + 1 < nT) sstore(buf ^ 1);
        __syncthreads();
    }
    const float ltot = lsum + __shfl_xor(lsum, 32);
    const float inv = 1.f / ltot;
    bf16_t* orow = ob + (size_t)(32 * wid + l31) * 1024;
#pragma unroll
    for (int g4 = 0; g4 < 4; ++g4) {
        u32x2 o0, o1;
        o0.x = pk2(O0[4 * g4] * inv, O0[4 * g4 + 1] * inv); o0.y = pk2(O0[4 * g4 + 2] * inv, O0[4 * g4 + 3] * inv);
        o1.x = pk2(O1[4 * g4] * inv, O1[4 * g4 + 1] * inv); o1.y = pk2(O1[4 * g4 + 2] * inv, O1[4 * g4 + 3] * inv);
        *(u32x2*)(orow + 8 * g4 + 4 * h) = o0;
        *(u32x2*)(orow + 32 + 8 * g4 + 4 * h) = o1;
    }
}

DI void sgu_item(unsigned char* smem, lds_ptr lds3, const Params& p, int l, int c) {
    constexpr int VPB = 528;
    const int tid = tid_(), wid = tid >> 6, lane = tid & 63, l31 = lane & 31, h = lane >> 5;
    unsigned char* U = p.ws + WS_U;
    const bf16_t* VG = (const bf16_t*)(U + U_VG); const bf16_t* UG = (const bf16_t*)(U + U_UG);
    bf16_t* YC = (bf16_t*)(U + U_YCAT);
    const bf16_t* WSG = (const bf16_t*)(p.ws + W_SGU);
    const float* bs = p.in[17] + l * 512;
    const int row0 = c * 128;
#pragma unroll
    for (int i = 0; i < 8; ++i) {
        const int idx = tid + 512 * i, rr = idx >> 5, ch = idx & 31;
        const u32x4 v = *(const u32x4*)(VG + (size_t)(row0 + rr) * 256 + 8 * ch);
        *(u32x4*)(smem + rr * VPB + 16 * ch) = v;
    }
    __syncthreads();
    const int hd = wid >> 1, ph = wid & 1;
    f32x16 C00, C01, C10, C11;
#pragma unroll
    for (int i = 0; i < 16; ++i) { C00[i] = 0.f; C01[i] = 0.f; C10[i] = 0.f; C11[i] = 0.f; }
    const int q4 = (lane & 15) >> 2, p4 = lane & 3, blk = (lane >> 4) & 1;
    lds_ptr vbase = lds3 + (8 * h + q4) * VPB + (hd * 64 + 16 * blk) * 2 + 8 * p4;
    const bf16_t* wb = WSG + (size_t)(hd * 128 + 64 * ph + l31) * 128 + 8 * h;
#pragma unroll
    for (int ks = 0; ks < 8; ++ks) {
        const bf16x8 A0 = tr_pair(vbase + 16 * ks * VPB, 4 * VPB);
        const bf16x8 A1 = tr_pair(vbase + 16 * ks * VPB + 64, 4 * VPB);
        const bf16x8 B0 = *(const bf16x8*)(wb + 16 * ks);
        const bf16x8 B1 = *(const bf16x8*)(wb + 32 * 128 + 16 * ks);
        C00 = MFMA32(A0, B0, C00); C01 = MFMA32(A0, B1, C01);
        C10 = MFMA32(A1, B0, C10); C11 = MFMA32(A1, B1, C11);
    }
#pragma unroll
    for (int pt = 0; pt < 2; ++pt) {
        const int pp = 64 * ph + 32 * pt + l31, row = row0 + pp;
        const float bias = bs[hd * 128 + pp];
#pragma unroll
        for (int dt = 0; dt < 2; ++dt)
#pragma unroll
            for (int g4 = 0; g4 < 4; ++g4) {
                const int d0 = 32 * dt + 8 * g4 + 4 * h;
                const u32x2 uu = *(const u32x2*)(UG + (size_t)row * 256 + hd * 64 + d0);
                float c0, c1, c2, c3;
                if (dt == 0 && pt == 0) { c0 = C00[4 * g4]; c1 = C00[4 * g4 + 1]; c2 = C00[4 * g4 + 2]; c3 = C00[4 * g4 + 3]; }
                else if (dt == 0) { c0 = C01[4 * g4]; c1 = C01[4 * g4 + 1]; c2 = C01[4 * g4 + 2]; c3 = C01[4 * g4 + 3]; }
                else if (pt == 0) { c0 = C10[4 * g4]; c1 = C10[4 * g4 + 1]; c2 = C10[4 * g4 + 2]; c3 = C10[4 * g4 + 3]; }
                else { c0 = C11[4 * g4]; c1 = C11[4 * g4 + 1]; c2 = C11[4 * g4 + 2]; c3 = C11[4 * g4 + 3]; }
                u32x2 o;
                o.x = pk2((c0 + bias) * lo_f(uu.x), (c1 + bias) * hi_f(uu.x));
                o.y = pk2((c2 + bias) * lo_f(uu.y), (c3 + bias) * hi_f(uu.y));
                *(u32x2*)(YC + (size_t)row * 1024 + 768 + hd * 64 + d0) = o;
            }
    }
    __syncthreads();
}

DI void phase_mix(const Params& p, int l, unsigned char* smem, lds_ptr lds3) {
    const int G = nblk_(), bid = bid_();
    unsigned char* U = p.ws + WS_U;
    const bf16_t* Z = (const bf16_t*)(U + U_Z);
    const bf16_t* QRAW = (const bf16_t*)(U + U_QRAW); const bf16_t* KVRAW = (const bf16_t*)(U + U_KVRAW);
    const bf16_t* KSR = (const bf16_t*)(p.ws + WS_KSR); const bf16_t* KRR = (const bf16_t*)(p.ws + WS_KRR);
    bf16_t* YC = (bf16_t*)(U + U_YCAT);
    const float2* tS = (const float2*)(p.ws + WS_TAB); const float2* tM = tS + 320 * 16;
    const float mla_scale = 0.10206207261596575f * LOG2E;
    const float swa_scale = 0.125f * LOG2E;
    for (int i = bid; i < 520; i += G) {
        int b, hd, q0row, t0, rowA, lenA; bool rope;
        if (i < 512) { const int bh = i & 7, qt = i >> 3; b = bh >> 2; hd = bh & 3; t0 = qt * 256; q0row = b * SEQ + t0; rowA = b * SEQ; lenA = SEQ; rope = true; }
        else { const int k = i - 512; b = k >> 2; hd = k & 3; t0 = 0; q0row = NLAT + b * CTXL; rowA = 0; lenA = 0; rope = false; }
        attn_item<96>(smem, lds3, tM, tM + 256 * 8, QRAW + (size_t)q0row * 512 + hd * 96, 512, rope, t0, mla_scale,
                      KVRAW + hd * 128, 512, KRR, KVRAW + hd * 128 + 64, 512,
                      rowA, lenA, 0, false, NLAT + b * CTXL, CTXL, -1e30f, 0.f, YC + (size_t)q0row * 1024 + 512 + hd * 64);
    }
    for (int i = bid; i < 520; i += G) {
        int b, hd, q0row, t0, rowA, lenA, posA; bool rope;
        if (i < 512) {
            const int bh = i & 7, qt = i >> 3; b = bh >> 2; hd = bh & 3; t0 = qt * 256; q0row = b * SEQ + t0; rope = true;
            posA = max(t0 - 128, 0); const int endA = min(t0 + 384, SEQ); rowA = b * SEQ + posA; lenA = endA - posA;
        } else { const int k = i - 512; b = k >> 2; hd = k & 3; t0 = 0; q0row = NLAT + b * CTXL; rowA = 0; lenA = 0; posA = 0; rope = false; }
        const int kvh = hd >> 1;
        const float sink = p.in[9][l * 4 + hd] * LOG2E;
        attn_item<64>(smem, lds3, tS, tS + 256 * 16, Z + (size_t)q0row * DINP + C_SWA_Q + hd * 64, DINP, rope, t0, swa_scale,
                      KSR + kvh * 64, 128, nullptr, Z + C_SWA_V + kvh * 64, DINP,
                      rowA, lenA, posA, true, NLAT + b * CTXL, CTXL, sink, 1.f, YC + (size_t)q0row * 1024 + 256 + hd * 64);
    }
    for (int c = G - 1 - bid; c < 260; c += G) sgu_item(smem, lds3, p, l, c);
}

__global__ __launch_bounds__(512, 2) void fwd_megakernel(Params p_unused) {
    extern __shared__ __attribute__((aligned(16))) unsigned char smem[];
    cg::grid_group grid = cg::this_grid();
    lds_ptr lds3 = (lds_ptr)smem;
    {
        const Params& p = params_();
        phase_adaln(p, (float*)smem);
        phase_tables(p);
        convert_layer(p, 0, smem);
    }
    grid.sync();
    {
        const Params& p = params_();
        phase_ln(p, 0, nullptr, nullptr, (const float*)(p.ws + WS_MOD), 0);
    }
    grid.sync();
    for (int l = 0; l < DEPTH; ++l) {
        {
            const Params& p = params_(); unsigned char* U = p.ws + WS_U;
            pg8::EpiBf16<0> E; E.O = (bf16_t*)(U + U_Z); E.ldc = DINP; E.bias = nullptr; E.split_cols = 0; E.split_stride = 0;
            run_gemm(lds3, (const bf16_t*)(U + U_H), (const bf16_t*)(p.ws + W_IN), R, DINP, 1024, E);
        }
        grid.sync();
        phase_postz(params_(), l);
        grid.sync();
        {
            const Params& p = params_(); unsigned char* U = p.ws + WS_U;
            pg8::EpiBf16<0> E; E.bias = nullptr; E.split_cols = 0; E.split_stride = 0;
            E.O = (bf16_t*)(U + U_QRAW); E.ldc = 512;
            run_gemm(lds3, (const bf16_t*)(U + U_CQN), (const bf16_t*)(p.ws + W_UQ), R, 512, 256, E);
        }
        {
            const Params& p = params_(); unsigned char* U = p.ws + WS_U;
            pg8::EpiBf16<0> E; E.bias = nullptr; E.split_cols = 0; E.split_stride = 0;
            E.O = (bf16_t*)(U + U_KVRAW); E.ldc = 512;
            run_gemm(lds3, (const bf16_t*)(U + U_CKVN), (const bf16_t*)(p.ws + W_UKV), R, 512, 256, E);
        }
        {
            const Params& p = params_(); unsigned char* U = p.ws + WS_U;
            pg8::EpiBf16<0> E; E.bias = nullptr; E.split_cols = 0; E.split_stride = 0;
            E.O = (bf16_t*)(U + U_YCAT); E.ldc = 1024;
            run_gemm(lds3, (const bf16_t*)(U + U_DPOOL), (const bf16_t*)(p.ws + W_POOL), R, 256, 256, E);
        }
        grid.sync();
        phase_mix(params_(), l, smem, lds3);
        grid.sync();
        {
            const Params& p = params_(); unsigned char* U = p.ws + WS_U;
            EpiResid E; E.X = (float*)(p.ws + WS_X); E.modl = (const float*)(p.ws + WS_MOD) + (size_t)l * 3 * 6144; E.idx = 2;
            run_gemm(lds3, (const bf16_t*)(U + U_YCAT), (const bf16_t*)(p.ws + W_OUT), R, 1024, 1024, E);
        }
        grid.sync();
        {
            const Params& p = params_();
            phase_ln(p, 1, p.in[19] + l * 1024, p.in[20] + l * 1024, (const float*)(p.ws + WS_MOD) + (size_t)l * 3 * 6144, 3);
        }
        grid.sync();
        {
            const Params& p = params_(); unsigned char* U = p.ws + WS_U;
            EpiRelu2 E; E.O = (bf16_t*)(U + U_F1); E.ldc = 4096;
            run_gemm(lds3, (const bf16_t*)(U + U_H), (const bf16_t*)(p.ws + W_FF1), R, 4096, 1024, E);
        }
        grid.sync();
        {
            const Params& p = params_(); unsigned char* U = p.ws + WS_U;
            EpiResid E; E.X = (float*)(p.ws + WS_X); E.modl = (const float*)(p.ws + WS_MOD) + (size_t)l * 3 * 6144; E.idx = 5;
            run_gemm(lds3, (const bf16_t*)(U + U_F1), (const bf16_t*)(p.ws + W_FF2), R, 1024, 4096, E);
        }
        grid.sync();
        {
            const Params& p = params_();
            const float* modl = (const float*)(p.ws + WS_MOD) + (size_t)l * 3 * 6144;
            if (l + 1 < DEPTH) {
                phase_ln(p, 1, p.in[23] + l * 1024, p.in[24] + l * 1024, modl + 3 * 6144, 0);
                convert_layer(p, l + 1, smem);
            } else {
                phase_ln(p, 2, p.in[23] + l * 1024, p.in[24] + l * 1024, modl, 0);
            }
        }
        grid.sync();
    }
}

extern "C" void kernel_launch(void* const* d_in, const int* in_sizes, int n_in, void* d_out, int out_size, void* d_ws, size_t ws_size, hipStream_t stream) {
    static int grid_blocks = 0;
    if (!grid_blocks) {
        int dev = 0, cus = 0, per_cu = 0;
        hipGetDevice(&dev);
        hipDeviceGetAttribute(&cus, hipDeviceAttributeMultiprocessorCount, dev);
        if (hipFuncSetAttribute((const void*)fwd_megakernel, hipFuncAttributeMaxDynamicSharedMemorySize, LDS_BYTES) != hipSuccess)
            fprintf(stderr, "kernel_launch: hipFuncSetAttribute(%d B LDS) failed\n", LDS_BYTES);
        if (hipOccupancyMaxActiveBlocksPerMultiprocessor(&per_cu, (const void*)fwd_megakernel, 512, LDS_BYTES) != hipSuccess || per_cu < 1) per_cu = 1;
        (void)hipGetLastError();
        grid_blocks = cus * per_cu;
        if (ws_size < WS_END) fprintf(stderr, "kernel_launch: workspace %zu < needed %zu\n", ws_size, (size_t)WS_END);
    }
    Params p{};
    for (int i = 0; i < 25; ++i) p.in[i] = (const float*)d_in[i];
    p.out = (float*)d_out; p.ws = (unsigned char*)d_ws;
    void* args[] = {&p};
    hipError_t e = hipLaunchCooperativeKernel((const void*)fwd_megakernel, dim3(grid_blocks), dim3(512), args, LDS_BYTES, stream);
    if (e != hipSuccess) fprintf(stderr, "cooperative launch failed: %s (grid %d)\n", hipGetErrorString(e), grid_blocks);
}
```

```cpp
#include <hip/hip_runtime.h>
#include <hip/hip_cooperative_groups.h>
#include <cstdio>
namespace cg = cooperative_groups;
namespace pg8 {
#define PG8_LAS __attribute__((address_space(3)))
typedef unsigned short bf16_t;
typedef short bf16x8 __attribute__((ext_vector_type(8)));
typedef float f32x4 __attribute__((ext_vector_type(4)));
typedef unsigned u32x4 __attribute__((ext_vector_type(4)));
constexpr int BM = 256, BK = 64, HALF = 128, HTB = HALF * BK * 2  , STAGE_BYTES = 8 * HTB, NXCD = 8, WGM = 8;

__host__ __device__ __forceinline__ int lds_byte(int r, int c) { const int st = (r >> 4) * 2 + (c >> 5), rr = r & 15, cc = c & 31, ob = rr * 64 + cc * 2; return st * 1024 + (ob ^ (((ob >> 9) & 1) << 5)); }
__host__ __device__ __forceinline__ void stage_rc(int b, int& R, int& C) { const int st = b / 1024, sb = b % 1024, swz = sb ^ (((sb >> 9) & 1) << 5); R = (st >> 1) * 16 + swz / 64; C = (st & 1) * 32 + (swz % 64) / 2; }
__host__ __device__ __forceinline__ int perm32(int rho) { const int n = rho >> 4, i = rho & 15; return 8 * (i >> 2) + 4 * n + (i & 3); }

struct Unit { int pm, pn; };
struct Gemm { const bf16_t* A; const bf16_t* Bt; int M, N, K; };

struct StaticOrder {
    int nM, nN, nwg, G, c;
    __host__ __device__ void init(int M, int N, int G_, int c_) { nM = M / BM; nN = N / BM; nwg = nM * nN; G = G_; c = c_; }
    __host__ __device__ bool next(int i, Unit& u) const {
        const long L = (long)i * G + c; if (L >= nwg) return false;
        int wgid = (int)L; { const int q = nwg / NXCD, r = nwg % NXCD, xcd = wgid % NXCD, off = wgid / NXCD; wgid = (xcd < r ? xcd * (q + 1) : r * (q + 1) + (xcd - r) * q) + off; }
        const int nig = WGM * nN, gid = wgid / nig, fm = gid * WGM, gsz = (nM - fm) < WGM ? (nM - fm) : WGM;
        u.pm = fm + ((wgid % nig) % gsz); u.pn = (wgid % nig) / gsz; return true;
    }
    __device__ __forceinline__ void a_ready(const Unit&) const {}
    __device__ __forceinline__ void done(const Unit&) const {}
};
struct CountedOrder : StaticOrder {
    const unsigned* ready; unsigned need; unsigned* tmo;
    __device__ __forceinline__ void a_ready(const Unit& u) const {
        if (threadIdx.x < 64) {
            const unsigned long long t0 = __builtin_amdgcn_s_memrealtime(); unsigned polls = 0;
            while ((unsigned)__builtin_amdgcn_readfirstlane(__hip_atomic_load(ready + 64 * u.pm, __ATOMIC_RELAXED, __HIP_MEMORY_SCOPE_AGENT)) < need) {
                if ((++polls & 255u) == 0u && __builtin_amdgcn_readfirstlane(__hip_atomic_load(tmo, __ATOMIC_RELAXED, __HIP_MEMORY_SCOPE_AGENT)) != 0u) break;
                if (__builtin_amdgcn_s_memrealtime() - t0 > 2000000ull) {
                    if (threadIdx.x == 0) { unsigned expect = 0u; __hip_atomic_compare_exchange_strong(tmo + 1, &expect, 0x600u | (unsigned)(u.pm & 0xff), __ATOMIC_RELAXED, __ATOMIC_RELAXED, __HIP_MEMORY_SCOPE_AGENT); __hip_atomic_store(tmo, 1u, __ATOMIC_RELAXED, __HIP_MEMORY_SCOPE_AGENT); }
                    break; }
                __builtin_amdgcn_s_sleep(2); }
            __builtin_amdgcn_fence(__ATOMIC_ACQUIRE, "agent");
            asm volatile("s_waitcnt vmcnt(0)" ::: "memory");
        }
#if !defined(BROKEN_HOOK_NO_BARRIER)
        asm volatile("" ::: "memory"); __builtin_amdgcn_s_barrier(); asm volatile("" ::: "memory");
#endif
    }
};

__device__ __forceinline__ unsigned cvt_pk_bf16(float lo, float hi) { unsigned r; asm volatile("v_cvt_pk_bf16_f32 %0, %1, %2" : "=v"(r) : "v"(lo), "v"(hi)); return r; }
typedef float f32x2 __attribute__((ext_vector_type(2)));
__device__ __forceinline__ f32x2 gelu_pk(f32x2 v) {
    const f32x2 av = __builtin_elementwise_abs(v), d = av * 0.2316418882f + 1.0f;
    f32x2 t; t.x = __builtin_amdgcn_rcpf(d.x); t.y = __builtin_amdgcn_rcpf(d.y);
    f32x2 q = t * 0.5307027145f + (-0.7265760135f); q = q * t + 0.7107068705f; q = q * t + (-0.142248368f); q = q * t + 0.127414796f; q = q * t;
    const f32x2 s = (v * v) * (-0.72134752044f);
    f32x2 e; e.x = __builtin_amdgcn_exp2f(s.x); e.y = __builtin_amdgcn_exp2f(s.y);
    const f32x2 m = v * (q * e), r = v - m;
    f32x2 o; o.x = v.x < 0.f ? m.x : r.x; o.y = v.y < 0.f ? m.y : r.y; return o;
}

struct EpiF32 {
    static constexpr bool PERM = false, AFTER_DRAIN = false;
    float* C; int ldc; const float* bias;
    __device__ __forceinline__ void operator()(const f32x4 (&acc)[2][2][4][2], const Unit& u, int wr, int wc, int fr, int fq) const {
        const int row0 = u.pm * BM + wr * 64 + fr, col0 = u.pn * BM + wc * 32 + 4 * fq;
        f32x4 bv[2][2];
#pragma unroll
        for (int bj = 0; bj < 2; ++bj)
#pragma unroll
            for (int n = 0; n < 2; ++n) bv[bj][n] = bias ? *(const f32x4*)(bias + col0 + bj * HALF + n * 16) : (f32x4){0.f, 0.f, 0.f, 0.f};
#pragma unroll
        for (int ai = 0; ai < 2; ++ai)
#pragma unroll
            for (int m = 0; m < 4; ++m) { float* rowp = C + (size_t)(row0 + ai * HALF + m * 16) * ldc + col0;
#pragma unroll
                for (int bj = 0; bj < 2; ++bj)
#pragma unroll
                    for (int n = 0; n < 2; ++n) *(f32x4*)(rowp + bj * HALF + n * 16) = acc[ai][bj][m][n] + bv[bj][n]; }
    }
};
template <int ACT  > struct EpiBf16 {
    static constexpr bool PERM = true, AFTER_DRAIN = false;
    bf16_t* O; int ldc; const float* bias; int split_cols; size_t split_stride;
    __device__ __forceinline__ void operator()(const f32x4 (&acc)[2][2][4][2], const Unit& u, int wr, int wc, int fr, int fq) const {
        const int row0 = u.pm * BM + wr * 64 + fr; int colt = u.pn * BM; bf16_t* base = O;
        if (split_cols) { const int t = colt / split_cols; base += (size_t)t * split_stride; colt -= t * split_cols; }
        const int col0 = colt + wc * 32 + 8 * fq, bcol0 = u.pn * BM + wc * 32 + 8 * fq;
        f32x4 bv[2][2];
#pragma unroll
        for (int bj = 0; bj < 2; ++bj)
#pragma unroll
            for (int n = 0; n < 2; ++n) bv[bj][n] = bias ? *(const f32x4*)(bias + bcol0 + bj * HALF + 4 * n) : (f32x4){0.f, 0.f, 0.f, 0.f};
#pragma unroll
        for (int ai = 0; ai < 2; ++ai)
#pragma unroll
            for (int m = 0; m < 4; ++m) { bf16_t* rowp = base + (size_t)(row0 + ai * HALF + m * 16) * ldc + col0;
#pragma unroll
                for (int bj = 0; bj < 2; ++bj) { f32x4 v0 = acc[ai][bj][m][0] + bv[bj][0], v1 = acc[ai][bj][m][1] + bv[bj][1];
                    if (ACT == 1) { f32x2 a = gelu_pk((f32x2){v0[0], v0[1]}), b = gelu_pk((f32x2){v0[2], v0[3]}), c = gelu_pk((f32x2){v1[0], v1[1]}), d = gelu_pk((f32x2){v1[2], v1[3]});
                        v0 = (f32x4){a.x, a.y, b.x, b.y}; v1 = (f32x4){c.x, c.y, d.x, d.y}; }
                    if (ACT == 2) {
#pragma unroll
                        for (int j = 0; j < 4; ++j) { v0[j] = 0.5f * v0[j] * (1.0f + erff(v0[j] * 0.70710678f)); v1[j] = 0.5f * v1[j] * (1.0f + erff(v1[j] * 0.70710678f)); } }
                    u32x4 w; w.x = cvt_pk_bf16(v0[0], v0[1]); w.y = cvt_pk_bf16(v0[2], v0[3]); w.z = cvt_pk_bf16(v1[0], v1[1]); w.w = cvt_pk_bf16(v1[2], v1[3]);
                    *(u32x4*)(rowp + bj * HALF) = w; } }
    }
};
template <class Epi, class Sched, bool STAMP = false>
__device__ __forceinline__ void gemm_phase(PG8_LAS unsigned char* lds, const Gemm g, const Sched& S, const Epi& E, unsigned long long* stamps) {
    int tid_raw = threadIdx.x; asm volatile("" : "+v"(tid_raw)); const int tid = tid_raw, wid = __builtin_amdgcn_readfirstlane(tid >> 6), lane = tid & 63, wr = wid >> 2, wc = wid & 3, fr = lane & 15, fq = lane >> 4;
    const int K = g.K, nt = K / BK;
    int ts_lo = 0, ts_hi = 0, nts = 0; const unsigned long long rt_entry = STAMP ? (unsigned long long)wall_clock64() : 0ull;
#define PG8_STAMP() do { if (STAMP && wid == 0 && nts < 64) { const unsigned long long _c = (unsigned long long)clock64(); \
        ts_lo = (lane == nts) ? (int)(unsigned)_c : ts_lo; ts_hi = (lane == nts) ? (int)(unsigned)(_c >> 32) : ts_hi; ++nts; } } while (0)
    PG8_STAMP();
    unsigned voffA[2], voffB[2];
#pragma unroll
    for (int i = 0; i < 2; ++i) { int R, C; stage_rc(tid * 16 + i * 8192, R, C); const int Rb = Epi::PERM ? ((R & ~31) + perm32(R & 31)) : R;
        voffA[i] = (unsigned)(R * K + C) * 2u; voffB[i] = (unsigned)(Rb * K + C) * 2u; }
    const size_t kstep = (size_t)(BK * 2);
    const size_t hstep = (size_t)HALF * K * 2;
    const size_t tstep = 2 * hstep;
    const unsigned ldsw = (unsigned)wid * 1024u;
    const int aoff = lds_byte(wr * 64 + fr, fq * 8), boff = lds_byte(wc * 32 + fr, fq * 8);
#define PG8_SA(b, h) (((b) * 2 + (h)) * HTB)
#define PG8_SB(b, h) ((4 + (b) * 2 + (h)) * HTB)
#define PG8_STAGE(bufoff, gbase, voff) do { _Pragma("unroll") for (int _i = 0; _i < 2; ++_i) \
        __builtin_amdgcn_global_load_lds((const unsigned*)((const char*)(gbase) + (voff)[_i]), (PG8_LAS unsigned*)(lds + (bufoff) + ldsw + _i * 8192), 16, 0, 0); } while (0)
#define PG8_LDA(dst, b, h) do { _Pragma("unroll") for (int m = 0; m < 4; ++m) _Pragma("unroll") for (int k = 0; k < 2; ++k) dst[m][k] = *(const PG8_LAS bf16x8*)(lds + PG8_SA(b, h) + aoff + m * 2048 + k * 1024); } while (0)
#define PG8_LDB(dst, b, h) do { _Pragma("unroll") for (int n = 0; n < 2; ++n) _Pragma("unroll") for (int k = 0; k < 2; ++k) dst[n][k] = *(const PG8_LAS bf16x8*)(lds + PG8_SB(b, h) + boff + n * 2048 + k * 1024); } while (0)
#define PG8_MMA(ai, bj, At, Bt) do { __builtin_amdgcn_s_setprio(1); _Pragma("unroll") for (int m = 0; m < 4; ++m) _Pragma("unroll") for (int n = 0; n < 2; ++n) _Pragma("unroll") for (int k = 0; k < 2; ++k) \
        acc[ai][bj][m][n] = __builtin_amdgcn_mfma_f32_16x16x32_bf16(Bt[n][k], At[m][k], acc[ai][bj][m][n], 0, 0, 0); __builtin_amdgcn_s_setprio(0); } while (0)
#define PG8_WAIT_V(n) asm volatile("s_waitcnt vmcnt(" #n ")" ::: "memory")
#define PG8_WAIT_L(n) asm volatile("s_waitcnt lgkmcnt(" #n ")" ::: "memory")
#define PG8_BAR __builtin_amdgcn_s_barrier()
#define PG8_SCHED __builtin_amdgcn_sched_barrier(0)
    Unit cur, nxt; int ui = 0;
    if (!S.next(0, cur)) return;
    f32x4 acc[2][2][4][2];
#pragma unroll
    for (int a = 0; a < 2; ++a)
#pragma unroll
        for (int b = 0; b < 2; ++b)
#pragma unroll
            for (int m = 0; m < 4; ++m)
#pragma unroll
                for (int n = 0; n < 2; ++n) acc[a][b][m][n] = (f32x4){0.f, 0.f, 0.f, 0.f};
    bf16x8 At[4][2], B0[2][2], B1[2][2];
    const char* cA = (const char*)g.A + (size_t)cur.pm * tstep; const char* cB = (const char*)g.Bt + (size_t)cur.pn * tstep;
    S.a_ready(cur);
    PG8_STAGE(PG8_SB(0, 0), cB, voffB); PG8_STAGE(PG8_SA(0, 0), cA, voffA); PG8_STAGE(PG8_SB(0, 1), cB + hstep, voffB); PG8_STAGE(PG8_SA(0, 1), cA + hstep, voffA);
    if (wr == 1) PG8_BAR;
    PG8_WAIT_V(4); PG8_BAR;
    PG8_STAGE(PG8_SB(1, 0), cB + kstep, voffB); PG8_STAGE(PG8_SA(1, 0), cA + kstep, voffA); PG8_STAGE(PG8_SB(1, 1), cB + hstep + kstep, voffB);
    PG8_WAIT_V(6); PG8_BAR;
    PG8_STAMP();
    for (;;) {
        const bool has_next = S.next(ui + 1, nxt);
        const char* nA = has_next ? (const char*)g.A + (size_t)nxt.pm * tstep : cA; const char* nB = has_next ? (const char*)g.Bt + (size_t)nxt.pn * tstep : cB;
        for (int t = 0; t < nt; t += 2) {
            const bool last = (t == nt - 2);
            const char* a1 = cA + (size_t)(t + 1) * kstep;
            const char* a2 = last ? nA : cA + (size_t)(t + 2) * kstep; const char* b2 = last ? nB : cB + (size_t)(t + 2) * kstep;
            const char* a3 = a2 + kstep; const char* b3 = b2 + kstep;
            if (last && has_next) S.a_ready(nxt);
            PG8_LDB(B0, 0, 0); PG8_SCHED; PG8_LDA(At, 0, 0); PG8_STAGE(PG8_SA(1, 1), a1 + hstep, voffA);
            PG8_WAIT_L(8); PG8_BAR; PG8_WAIT_L(0); PG8_MMA(0, 0, At, B0); PG8_BAR; PG8_SCHED;
            PG8_LDB(B1, 0, 1); PG8_STAGE(PG8_SB(0, 0), b2, voffB);
            PG8_BAR; PG8_WAIT_L(0); PG8_MMA(0, 1, At, B1); PG8_BAR;
            PG8_LDA(At, 0, 1); PG8_STAGE(PG8_SA(0, 0), a2, voffA);
            PG8_BAR; PG8_WAIT_L(0); PG8_MMA(1, 0, At, B0); PG8_BAR; PG8_SCHED;
            PG8_STAGE(PG8_SB(0, 1), b2 + hstep, voffB);
            PG8_WAIT_V(6); PG8_BAR; PG8_MMA(1, 1, At, B1); PG8_BAR;
            PG8_LDB(B0, 1, 0); PG8_SCHED; PG8_LDA(At, 1, 0); PG8_STAGE(PG8_SA(0, 1), a2 + hstep, voffA);
            PG8_WAIT_L(8); PG8_BAR; PG8_WAIT_L(0); PG8_MMA(0, 0, At, B0); PG8_BAR; PG8_SCHED;
            PG8_LDB(B1, 1, 1); PG8_STAGE(PG8_SB(1, 0), b3, voffB);
            PG8_BAR; PG8_WAIT_L(0); PG8_MMA(0, 1, At, B1); PG8_BAR;
            PG8_LDA(At, 1, 1); PG8_STAGE(PG8_SA(1, 0), a3, voffA);
            PG8_BAR; PG8_WAIT_L(0); PG8_MMA(1, 0, At, B0); PG8_BAR; PG8_SCHED;
            PG8_STAGE(PG8_SB(1, 1), b3 + hstep, voffB);
            PG8_WAIT_V(6); PG8_BAR; PG8_MMA(1, 1, At, B1); PG8_BAR;
        }
        PG8_STAMP();
        if constexpr (!Epi::AFTER_DRAIN) { E(acc, cur, wr, wc, fr, fq); S.done(cur); }
        PG8_STAMP();
        if (!has_next) break;
#pragma unroll
        for (int a = 0; a < 2; ++a)
#pragma unroll
            for (int b = 0; b < 2; ++b)
#pragma unroll
                for (int m = 0; m < 4; ++m)
#pragma unroll
                    for (int n = 0; n < 2; ++n) acc[a][b][m][n] = (f32x4){0.f, 0.f, 0.f, 0.f};
        cur = nxt; cA = nA; cB = nB; ++ui;
    }
    PG8_WAIT_V(0);
    if (wr == 0) PG8_BAR;
    PG8_BAR;
    if constexpr (Epi::AFTER_DRAIN) { E.fused(acc, cur, wr, wc, fr, fq, lds, wid, lane); S.done(cur); }
    PG8_STAMP();
    if (STAMP && wid == 0) { stamps[lane] = lane < nts ? (((unsigned long long)(unsigned)ts_hi << 32) | (unsigned)ts_lo) : 0ull;
        if (lane == 62) stamps[62] = rt_entry; if (lane == 63) stamps[63] = (unsigned long long)wall_clock64(); }
#undef PG8_STAMP
#undef PG8_SA
#undef PG8_SB
#undef PG8_STAGE
#undef PG8_LDA
#undef PG8_LDB
#undef PG8_MMA
#undef PG8_WAIT_V
#undef PG8_WAIT_L
#undef PG8_BAR
#undef PG8_SCHED
}
}

#define DI __device__ __forceinline__
using pg8::bf16_t; using pg8::bf16x8; using pg8::f32x4; using pg8::u32x4;
typedef short s16x4 __attribute__((ext_vector_type(4)));
typedef float f32x16 __attribute__((ext_vector_type(16)));
typedef unsigned u32x2 __attribute__((ext_vector_type(2)));
typedef __bf16 bf2_t __attribute__((ext_vector_type(2)));
typedef float f32x2_t __attribute__((ext_vector_type(2)));
typedef PG8_LAS unsigned char* lds_ptr;

constexpr int D = 1024, NLAT = 32768, NCTX = 512, R = NLAT + NCTX, SEQ = 16384, CTXL = 256, DEPTH = 4;
constexpr int DIN = 1696, DINP = 1792;
constexpr int C_SWA_Q = 256, C_MLA_CQ = 512, C_SGU = 768, C_SWA_K = 1280, C_SWA_V = 1408, C_MLA_CKV = 1536, C_MLA_KR = 1664;
constexpr float EPS = 1e-6f;
constexpr float DN_ALPHA = 1.681792830507429f;
constexpr float LOG2E = 1.4426950408889634f;
constexpr int LDS_BYTES = 131072;
constexpr int LDS_ALLOC = LDS_BYTES + 16;

constexpr size_t W_IN = 0;
constexpr size_t W_OUT = W_IN + (size_t)DINP * 1024 * 2;
constexpr size_t W_FF1 = W_OUT + (size_t)1024 * 1024 * 2;
constexpr size_t W_FF2 = W_FF1 + (size_t)4096 * 1024 * 2;
constexpr size_t W_UQ = W_FF2 + (size_t)4096 * 1024 * 2;
constexpr size_t W_UKV = W_UQ + (size_t)512 * 256 * 2;
constexpr size_t W_POOL = W_UKV + (size_t)512 * 256 * 2;
constexpr size_t W_SGU = W_POOL + (size_t)256 * 256 * 2;
constexpr size_t WS_MOD = W_SGU + (size_t)4 * 128 * 128 * 2;
constexpr size_t WS_TAB = WS_MOD + (size_t)DEPTH * 3 * 6144 * 4;
constexpr size_t WS_X = WS_TAB + (size_t)(320 * 16 + 320 * 8) * 8;
constexpr size_t WS_U = WS_X + (size_t)R * 1024 * 4;
constexpr size_t U_Z = 0;
constexpr size_t U_QRAW = U_Z + (size_t)R * DINP * 2;
constexpr size_t U_KVRAW = U_QRAW + (size_t)R * 512 * 2;
constexpr size_t U_CQN = U_KVRAW + (size_t)R * 512 * 2;
constexpr size_t U_CKVN = U_CQN + (size_t)R * 256 * 2;
constexpr size_t U_DPOOL = U_CKVN + (size_t)R * 256 * 2;
constexpr size_t U_UG = U_DPOOL + (size_t)R * 256 * 2;
constexpr size_t U_VG = U_UG + (size_t)R * 256 * 2;
constexpr size_t U_F1 = 0;
constexpr size_t U_H = (size_t)R * 4096 * 2;
constexpr size_t U_YCAT = U_H;
constexpr size_t WS_KSR = WS_U + U_H + (size_t)R * 1024 * 2;
constexpr size_t WS_KRR = WS_KSR + (size_t)R * 128 * 2;
constexpr size_t WS_BAR = WS_KRR + (size_t)R * 32 * 2;
constexpr size_t WS_END = WS_BAR + 16384;
static_assert(U_VG + (size_t)R * 256 * 2 == U_H, "mixer-mode buffers must exactly fill the f1 slot");
static_assert(WS_END <= (size_t)536870912, "workspace too large");
static_assert(WS_X % 256 == 0 && WS_U % 256 == 0 && WS_MOD % 256 == 0 && WS_TAB % 256 == 0, "alignment");

struct Params { const float* in[25]; float* out; unsigned char* ws; };
DI int tid_() { int t = threadIdx.x; asm volatile("" : "+v"(t)); return t; }
DI int bid_() { int t = blockIdx.x; asm volatile("" : "+s"(t)); return t; }
DI int nblk_() { int t = gridDim.x; asm volatile("" : "+s"(t)); return t; }
DI const Params& params_() { auto k = __builtin_amdgcn_kernarg_segment_ptr(); asm volatile("" : "+s"(k)); return *(const Params*)k; }


DI float bf2f(bf16_t b) { return __uint_as_float(((unsigned)b) << 16); }
DI unsigned pk2(float a, float b) { f32x2_t v = {a, b}; bf2_t r = __builtin_convertvector(v, bf2_t); return __builtin_bit_cast(unsigned, r); }
DI bf16_t f2bf(float a) { return (bf16_t)(pk2(a, 0.f) & 0xffffu); }
DI float lo_f(unsigned u) { return __uint_as_float(u << 16); }
DI float hi_f(unsigned u) { return __uint_as_float(u & 0xffff0000u); }
DI float wsum(float v) {
#pragma unroll
    for (int m = 32; m >= 1; m >>= 1) v += __shfl_xor(v, m);
    return v;
}
DI float max3f(float a, float b, float c) { float r; asm("v_max3_f32 %0, %1, %2, %3" : "=v"(r) : "v"(a), "v"(b), "v"(c)); return r; }
DI int crow16(int i, int h) { return (i & 3) + 8 * (i >> 2) + 4 * h; }
#define MFMA32(a, b, c) __builtin_amdgcn_mfma_f32_32x32x16_bf16((a), (b), (c), 0, 0, 0)
DI bf16x8 tr_pair(lds_ptr lo_addr, int hi_delta) {
    const s16x4 lo = __builtin_amdgcn_ds_read_tr16_b64_v4i16((PG8_LAS s16x4*)lo_addr);
    const s16x4 hi = __builtin_amdgcn_ds_read_tr16_b64_v4i16((PG8_LAS s16x4*)(lo_addr + hi_delta));
    return __builtin_shufflevector(lo, hi, 0, 1, 2, 3, 4, 5, 6, 7);
}

struct EpiScaleBf16 {
    static constexpr bool PERM = true, AFTER_DRAIN = false;
    bf16_t* O; const float* modl; int idx; int pm0;
    DI void operator()(const f32x4 (&acc)[2][2][4][2], const pg8::Unit& u, int wr, int wc, int fr, int fq) const {
        const int row0 = u.pm * 256 + wr * 64 + fr, col0 = u.pn * 256 + wc * 32 + 8 * fq;
        const int pmg = u.pm + pm0, set = (pmg < 64) ? 0 : (pmg < 128 ? 1 : 2);
        const float* mp = modl + set * 6144 + idx * 1024 + col0;
        f32x4 mv[2][2];
#pragma unroll
        for (int bj = 0; bj < 2; ++bj)
#pragma unroll
            for (int n = 0; n < 2; ++n) mv[bj][n] = *(const f32x4*)(mp + bj * 128 + 4 * n);
#pragma unroll
        for (int ai = 0; ai < 2; ++ai)
#pragma unroll
            for (int m = 0; m < 4; ++m) {
                bf16_t* rowp = O + (size_t)(row0 + ai * 128 + m * 16) * 1024 + col0;
#pragma unroll
                for (int bj = 0; bj < 2; ++bj) {
                    const f32x4 v0 = acc[ai][bj][m][0] * mv[bj][0], v1 = acc[ai][bj][m][1] * mv[bj][1];
                    u32x4 w; w.x = pk2(v0[0], v0[1]); w.y = pk2(v0[2], v0[3]); w.z = pk2(v1[0], v1[1]); w.w = pk2(v1[2], v1[3]);
                    *(u32x4*)(rowp + bj * 128) = w;
                }
            }
    }
};
struct EpiRelu2 {
    static constexpr bool PERM = true, AFTER_DRAIN = false;
    bf16_t* O; int ldc;
    DI void operator()(const f32x4 (&acc)[2][2][4][2], const pg8::Unit& u, int wr, int wc, int fr, int fq) const {
        const int row0 = u.pm * 256 + wr * 64 + fr, col0 = u.pn * 256 + wc * 32 + 8 * fq;
#pragma unroll
        for (int ai = 0; ai < 2; ++ai)
#pragma unroll
            for (int m = 0; m < 4; ++m) {
                bf16_t* rowp = O + (size_t)(row0 + ai * 128 + m * 16) * ldc + col0;
#pragma unroll
                for (int bj = 0; bj < 2; ++bj) {
                    f32x4 v0 = acc[ai][bj][m][0], v1 = acc[ai][bj][m][1];
#pragma unroll
                    for (int j = 0; j < 4; ++j) { const float a = fmaxf(v0[j], 0.f), b = fmaxf(v1[j], 0.f); v0[j] = a * a; v1[j] = b * b; }
                    u32x4 w; w.x = pk2(v0[0], v0[1]); w.y = pk2(v0[2], v0[3]); w.z = pk2(v1[0], v1[1]); w.w = pk2(v1[2], v1[3]);
                    *(u32x4*)(rowp + bj * 128) = w;
                }
            }
    }
};

template <class Epi>
DI void run_gemm(lds_ptr lds3, const bf16_t* A, const bf16_t* Bt, int M, int N, int K, const Epi& E, int crot = 0) {
    pg8::Gemm g; g.A = A; g.Bt = Bt; g.M = M; g.N = N; g.K = K;
    const int G = nblk_(); int c = bid_() + crot; if (c >= G) c -= G;
    pg8::StaticOrder S; S.init(M, N, G, c);
    pg8::gemm_phase<Epi, pg8::StaticOrder, false>(lds3, g, S, E, nullptr);
}

DI void phase_adaln(const Params& p, float* lf) {
    for (int i = tid_(); i < 3072; i += 512) {
        const int s = i >> 10, k = i & 1023;
        const float v = (s < 2) ? p.in[1][s * 1024 + k] : p.in[3][k];
        lf[i] = v / (1.f + expf(-v));
    }
    __syncthreads();
    float* red = lf + 3072;
    const int wid = tid_() >> 6, lane = tid_() & 63;
    float* mod = (float*)(p.ws + WS_MOD);
    for (int item = bid_(); item < DEPTH * 96; item += nblk_()) {
        const int l = item / 96, jc = (item % 96) * 64;
        const float* w = p.in[4] + (size_t)l * 1024 * 6144 + jc + lane;
        float a0 = 0.f, a1 = 0.f, a2 = 0.f;
        const int i0 = wid * 128;
#pragma unroll 32
        for (int i = 0; i < 128; ++i) {
            const float wv = w[(size_t)(i0 + i) * 6144];
            a0 += lf[i0 + i] * wv; a1 += lf[1024 + i0 + i] * wv; a2 += lf[2048 + i0 + i] * wv;
        }
        red[(wid * 3 + 0) * 64 + lane] = a0; red[(wid * 3 + 1) * 64 + lane] = a1; red[(wid * 3 + 2) * 64 + lane] = a2;
        __syncthreads();
        if (tid_() < 192) {
            const int s = tid_() >> 6;
            float sum = 0.f;
#pragma unroll
            for (int w8 = 0; w8 < 8; ++w8) sum += red[(w8 * 3 + s) * 64 + lane];
            mod[((size_t)l * 3 + s) * 6144 + jc + lane] = sum + p.in[5][l * 6144 + jc + lane];
        }
        __syncthreads();
    }
}

DI void phase_tables(const Params& p) {
    float2* tS = (float2*)(p.ws + WS_TAB);
    float2* tM = tS + 320 * 16;
    const int gtid = bid_() * 512 + tid_(), gsz = nblk_() * 512;
    const float L2B = 13.287712379549449f;
    for (int i = gtid; i < 320 * 16 + 320 * 8; i += gsz) {
        int pos, f; float inv;
        if (i < 320 * 16) { pos = i >> 4; f = i & 15; inv = exp2f(-(float)(2 * f) * (1.f / 32.f) * L2B); }
        else { const int k = i - 320 * 16; pos = k >> 3; f = k & 7; inv = exp2f(-(float)(2 * f) * (1.f / 16.f) * L2B); }
        const float ang = (float)(pos < 256 ? pos : pos - 256) * inv;
        const double ad = (double)ang;
        const double kk = __builtin_rint(ad * 0.15915494309189535);
        const float rr = (float)(ad - kk * 6.283185307179586);
        tS[i] = make_float2(__cosf(rr), __sinf(rr));
    }
}

struct ConvJob { const float* src; bf16_t* dst; int K, N, KP, tk, tn; };
DI void conv_load(const ConvJob& c, int t, float4 (&v)[2]) {
#pragma unroll
    for (int rep = 0; rep < 2; ++rep) {
        const int k = c.tk * 64 + rep * 32 + (t >> 4), n = c.tn * 64 + (t & 15) * 4;
        v[rep] = make_float4(0.f, 0.f, 0.f, 0.f);
        if (k < c.K && n < c.N) v[rep] = *(const float4*)(c.src + (size_t)k * c.N + n);
    }
}
DI void conv_store(const ConvJob& c, int t, const float4 (&v)[2], bf16_t* tile) {
#pragma unroll
    for (int rep = 0; rep < 2; ++rep) {
        const int kl = rep * 32 + (t >> 4), nl = (t & 15) * 4;
        tile[(nl + 0) * 72 + kl] = f2bf(v[rep].x); tile[(nl + 1) * 72 + kl] = f2bf(v[rep].y);
        tile[(nl + 2) * 72 + kl] = f2bf(v[rep].z); tile[(nl + 3) * 72 + kl] = f2bf(v[rep].w);
    }
    __syncthreads();
    {
        const int nl = t >> 3, kl = (t & 7) * 8;
        const u32x4 w = *(const u32x4*)(tile + nl * 72 + kl);
        *(u32x4*)(c.dst + (size_t)(c.tn * 64 + nl) * c.KP + c.tk * 64 + kl) = w;
    }
    __syncthreads();
}

DI void convert_layer(const Params& p, int l, unsigned char* smem) {
    bf16_t* tile = (bf16_t*)smem;
    constexpr int T_IN = 16 * 28, T_OUT = 16 * 16, T_FF1 = 16 * 64, T_FF2 = 64 * 16, T_UQ = 4 * 8, T_UKV = 4 * 8;
    constexpr int T_ALL = T_IN + T_OUT + T_FF1 + T_FF2 + T_UQ + T_UKV;
    auto decode = [&](int t) {
        ConvJob c; int NT; size_t off; int tt = t;
        if (tt < T_IN) { c.src = p.in[6] + (size_t)l * 1024 * DIN; c.K = 1024; c.N = DIN; c.KP = 1024; NT = 28; off = W_IN; }
        else if ((tt -= T_IN) < T_OUT) { c.src = p.in[18] + (size_t)l * 1024 * 1024; c.K = 1024; c.N = 1024; c.KP = 1024; NT = 16; off = W_OUT; }
        else if ((tt -= T_OUT) < T_FF1) { c.src = p.in[21] + (size_t)l * 1024 * 4096; c.K = 1024; c.N = 4096; c.KP = 1024; NT = 64; off = W_FF1; }
        else if ((tt -= T_FF1) < T_FF2) { c.src = p.in[22] + (size_t)l * 4096 * 1024; c.K = 4096; c.N = 1024; c.KP = 4096; NT = 16; off = W_FF2; }
        else if ((tt -= T_FF2) < T_UQ) { c.src = p.in[11] + (size_t)l * 256 * 384; c.K = 256; c.N = 384; c.KP = 256; NT = 8; off = W_UQ; }
        else { tt -= T_UQ; c.src = p.in[13] + (size_t)l * 128 * 512; c.K = 128; c.N = 512; c.KP = 256; NT = 8; off = W_UKV; }
        c.dst = (bf16_t*)(p.ws + off); c.tk = tt / NT; c.tn = tt % NT;
        return c;
    };
    {
        const int t = tid_(), G = nblk_();
        int tix = bid_();
        float4 cur[2], nxt[2];
        if (tix < T_ALL) conv_load(decode(tix), t, cur);
        for (; tix < T_ALL; tix += G) {
            const bool more = tix + G < T_ALL;
            if (more) conv_load(decode(tix + G), t, nxt);
            conv_store(decode(tix), t, cur, tile);
            cur[0] = nxt[0]; cur[1] = nxt[1];
        }
    }
    const int gtid = bid_() * 512 + tid_(), gsz = nblk_() * 512;
    {
        bf16_t* dst = (bf16_t*)(p.ws + W_POOL);
        const float* pw = p.in[7] + (size_t)l * 4 * 64 * 64; const float* ps = p.in[8] + l * 256;
        for (int i = gtid; i < 65536; i += gsz) {
            const int row = i >> 8, col = i & 255, g = row >> 6, e = row & 63;
            float v = 0.f;
            if ((col >> 6) == g) v = pw[(g * 64 + (col & 63)) * 64 + e] * ps[row];
            dst[i] = f2bf(v);
        }
    }
    {
        bf16_t* dst = (bf16_t*)(p.ws + W_SGU);
        const float* sw = p.in[16] + (size_t)l * 65536;
        for (int i = gtid; i < 65536; i += gsz) dst[i] = f2bf(sw[i]);
    }
}

DI void wsum4(float& a, float& b, float& c, float& d) {
#pragma unroll
    for (int m = 32; m >= 1; m >>= 1) {
        const float ta = __shfl_xor(a, m), tb = __shfl_xor(b, m), tc = __shfl_xor(c, m), td = __shfl_xor(d, m);
        a += ta; b += tb; c += tc; d += td;
    }
}
DI void row_stats(const float4 (&v)[4], float& s, float& q) {
    s = 0.f; q = 0.f;
#pragma unroll
    for (int j = 0; j < 4; ++j) { s += v[j].x + v[j].y + v[j].z + v[j].w; q += v[j].x * v[j].x + v[j].y * v[j].y + v[j].z * v[j].z + v[j].w * v[j].w; }
}
DI void phase_ln(const Params& p, int mode, const float* g, const float* b, const float* modl, int i0, const bf16_t* Y = nullptr, int rlimit = R) {
    const int wid = tid_() >> 6, lane = tid_() & 63;
    bf16_t* XL = (bf16_t*)(p.ws + WS_X);
    float* XC = (float*)(p.ws + WS_X + (size_t)NLAT * 1024 * 2);
    bf16_t* H = (bf16_t*)(p.ws + WS_U + U_H);
    const int rmax = (mode == 2) ? NLAT : rlimit;
    const int rstride = nblk_() * 8;
    for (int ra = bid_() * 8 + wid; ra < rmax; ra += 2 * rstride) {
        const bool has_b = ra + rstride < rmax;
        const int rb = has_b ? ra + rstride : ra;
        float4 v[2][4];
#pragma unroll
        for (int k = 0; k < 2; ++k) {
            const int r = k ? rb : ra;
            if (mode != 0 && r < NLAT) {
#pragma unroll
                for (int j = 0; j < 4; ++j) {
                    const u32x2 w = *(const u32x2*)(XL + (size_t)r * 1024 + 4 * lane + 256 * j);
                    v[k][j] = make_float4(lo_f(w.x), hi_f(w.x), lo_f(w.y), hi_f(w.y));
                }
            } else {
                const float* src;
                if (mode == 0) src = (r < NLAT) ? p.in[0] + (size_t)r * 1024 : p.in[2] + (size_t)(r - NLAT) * 1024;
                else src = XC + (size_t)(r - NLAT) * 1024;
#pragma unroll
                for (int j = 0; j < 4; ++j) v[k][j] = *(const float4*)(src + 4 * lane + 256 * j);
            }
        }
        if (mode != 0) {
#pragma unroll
            for (int k = 0; k < 2; ++k) {
                const int r = k ? rb : ra;
                {
#pragma unroll
                    for (int j = 0; j < 4; ++j) {
                        const u32x2 yw = *(const u32x2*)(Y + (size_t)r * 1024 + 4 * lane + 256 * j);
                        v[k][j].x = v[k][j].x * DN_ALPHA + lo_f(yw.x); v[k][j].y = v[k][j].y * DN_ALPHA + hi_f(yw.x);
                        v[k][j].z = v[k][j].z * DN_ALPHA + lo_f(yw.y); v[k][j].w = v[k][j].w * DN_ALPHA + hi_f(yw.y);
                    }
                }
            }
            float s0, q0, s1, q1;
            row_stats(v[0], s0, q0); row_stats(v[1], s1, q1);
            wsum4(s0, q0, s1, q1);
#pragma unroll
            for (int k = 0; k < 2; ++k) {
                const float mu = (k ? s1 : s0) * (1.f / 1024.f);
                const float rs = rsqrtf(fmaxf((k ? q1 : q0) * (1.f / 1024.f) - mu * mu, 0.f) + EPS);
#pragma unroll
                for (int j = 0; j < 4; ++j) {
                    const float4 gg = *(const float4*)(g + 4 * lane + 256 * j), bb = *(const float4*)(b + 4 * lane + 256 * j);
                    v[k][j].x = (v[k][j].x - mu) * rs * gg.x + bb.x; v[k][j].y = (v[k][j].y - mu) * rs * gg.y + bb.y;
                    v[k][j].z = (v[k][j].z - mu) * rs * gg.z + bb.z; v[k][j].w = (v[k][j].w - mu) * rs * gg.w + bb.w;
                }
            }
        }
#pragma unroll
        for (int k = 0; k < 2; ++k) {
            const int r = k ? rb : ra;
            if (k == 0 || has_b) {
                if (mode != 2 && r < NLAT) {
#pragma unroll
                    for (int j = 0; j < 4; ++j) { u32x2 o; o.x = pk2(v[k][j].x, v[k][j].y); o.y = pk2(v[k][j].z, v[k][j].w); *(u32x2*)(XL + (size_t)r * 1024 + 4 * lane + 256 * j) = o; }
                } else {
                    float* dstx = (mode == 2) ? p.out + (size_t)r * 1024 : XC + (size_t)(r - NLAT) * 1024;
#pragma unroll
                    for (int j = 0; j < 4; ++j) *(float4*)(dstx + 4 * lane + 256 * j) = v[k][j];
                }
            }
        }
        if (mode != 2) {
            float s0, q0, s1, q1;
            row_stats(v[0], s0, q0); row_stats(v[1], s1, q1);
            wsum4(s0, q0, s1, q1);
#pragma unroll
            for (int k = 0; k < 2; ++k) {
                const int r = k ? rb : ra;
                if (k == 0 || has_b) {
                    const float mu = (k ? s1 : s0) * (1.f / 1024.f);
                    const float rs = rsqrtf(fmaxf((k ? q1 : q0) * (1.f / 1024.f) - mu * mu, 0.f) + EPS);
                    const int set = (r < SEQ) ? 0 : (r < NLAT ? 1 : 2);
                    const float* msh = modl + set * 6144 + i0 * 1024, *msc = msh + 1024;
#pragma unroll
                    for (int j = 0; j < 4; ++j) {
                        const float4 sh = *(const float4*)(msh + 4 * lane + 256 * j), sc = *(const float4*)(msc + 4 * lane + 256 * j);
                        u32x2 o;
                        o.x = pk2((v[k][j].x - mu) * rs * (1.f + sc.x) + sh.x, (v[k][j].y - mu) * rs * (1.f + sc.y) + sh.y);
                        o.y = pk2((v[k][j].z - mu) * rs * (1.f + sc.z) + sh.z, (v[k][j].w - mu) * rs * (1.f + sc.w) + sh.w);
                        *(u32x2*)(H + (size_t)r * 1024 + 4 * lane + 256 * j) = o;
                    }
                }
            }
        }
    }
}

DI float gelu_exact(float x) { return 0.5f * x * (1.f + erff(x * 0.70710678118654752f)); }

DI void phase_postz(const Params& p, int l) {
    const int wid = tid_() >> 6, lane = tid_() & 63;
    unsigned char* U = p.ws + WS_U;
    const bf16_t* Z = (const bf16_t*)(U + U_Z);
    bf16_t* KSR = (bf16_t*)(p.ws + WS_KSR); bf16_t* KRR = (bf16_t*)(p.ws + WS_KRR);
    bf16_t* CQN = (bf16_t*)(U + U_CQN); bf16_t* CKVN = (bf16_t*)(U + U_CKVN); bf16_t* DPOOL = (bf16_t*)(U + U_DPOOL);
    bf16_t* UG = (bf16_t*)(U + U_UG); bf16_t* VG = (bf16_t*)(U + U_VG);
    const float2* tS = (const float2*)(p.ws + WS_TAB); const float2* tM = tS + 320 * 16;
    const float* gq = p.in[10] + l * 256; const float* gkv = p.in[12] + l * 128;
    const float* sg = p.in[14] + l * 256; const float* sb = p.in[15] + l * 256;
    for (int r = bid_() * 8 + wid; r < R; r += nblk_() * 8) {
        const bf16_t* zr = Z + (size_t)r * DINP;
        const bool lat = r < NLAT;
        const int t = r & (SEQ - 1), rp = t >> 6, cp = t & 63;
        {
            const int hd = lane >> 5, pp = lane & 31, i = pp & 15, off = hd * 64 + ((pp & 16) ? 32 : 0);
            const float x1 = bf2f(zr[C_SWA_K + off + i]), x2 = bf2f(zr[C_SWA_K + off + 16 + i]);
            float o1 = x1, o2 = x2;
            if (lat) { const float2 cs = (pp & 16) ? tS[(256 + cp) * 16 + i] : tS[rp * 16 + i]; o1 = x1 * cs.x - x2 * cs.y; o2 = x2 * cs.x + x1 * cs.y; }
            KSR[(size_t)r * 128 + off + i] = f2bf(o1); KSR[(size_t)r * 128 + off + 16 + i] = f2bf(o2);
        }
        if (lane < 16) {
            const int i = lane & 7, off = (lane & 8) ? 16 : 0;
            const float x1 = bf2f(zr[C_MLA_KR + off + i]), x2 = bf2f(zr[C_MLA_KR + off + 8 + i]);
            float o1 = x1, o2 = x2;
            if (lat) { const float2 cs = (lane & 8) ? tM[(256 + cp) * 8 + i] : tM[rp * 8 + i]; o1 = x1 * cs.x - x2 * cs.y; o2 = x2 * cs.x + x1 * cs.y; }
            KRR[(size_t)r * 32 + off + i] = f2bf(o1); KRR[(size_t)r * 32 + off + 8 + i] = f2bf(o2);
        }
        {
            const u32x2 w = *(const u32x2*)(zr + C_MLA_CQ + 4 * lane);
            const float a0 = lo_f(w.x), a1 = hi_f(w.x), a2 = lo_f(w.y), a3 = hi_f(w.y);
            const float rs = rsqrtf(wsum(a0 * a0 + a1 * a1 + a2 * a2 + a3 * a3) * (1.f / 256.f) + EPS);
            const float4 gg = *(const float4*)(gq + 4 * lane);
            u32x2 o; o.x = pk2(a0 * rs * gg.x, a1 * rs * gg.y); o.y = pk2(a2 * rs * gg.z, a3 * rs * gg.w);
            *(u32x2*)(CQN + (size_t)r * 256 + 4 * lane) = o;
        }
        {
            const unsigned w = *(const unsigned*)(zr + C_MLA_CKV + 2 * lane);
            const float a0 = lo_f(w), a1 = hi_f(w);
            const float rs = rsqrtf(wsum(a0 * a0 + a1 * a1) * (1.f / 128.f) + EPS);
            const float2 gg = *(const float2*)(gkv + 2 * lane);
            *(unsigned*)(CKVN + (size_t)r * 256 + 2 * lane) = pk2(a0 * rs * gg.x, a1 * rs * gg.y);
            *(unsigned*)(CKVN + (size_t)r * 256 + 128 + 2 * lane) = 0u;
        }
        {
            const u32x2 wu = *(const u32x2*)(zr + C_SGU + 4 * lane);
            const pg8::f32x2 gu0 = pg8::gelu_pk((pg8::f32x2){lo_f(wu.x), hi_f(wu.x)}), gu1 = pg8::gelu_pk((pg8::f32x2){lo_f(wu.y), hi_f(wu.y)});
            u32x2 ou; ou.x = pk2(gu0.x, gu0.y); ou.y = pk2(gu1.x, gu1.y);
            *(u32x2*)(UG + (size_t)r * 256 + 4 * lane) = ou;
            const u32x2 wv = *(const u32x2*)(zr + C_SGU + 256 + 4 * lane);
            const pg8::f32x2 gv0 = pg8::gelu_pk((pg8::f32x2){lo_f(wv.x), hi_f(wv.x)}), gv1 = pg8::gelu_pk((pg8::f32x2){lo_f(wv.y), hi_f(wv.y)});
            float a0 = gv0.x, a1 = gv0.y, a2 = gv1.x, a3 = gv1.y;
            const float mu = wsum(a0 + a1 + a2 + a3) * (1.f / 256.f);
            a0 -= mu; a1 -= mu; a2 -= mu; a3 -= mu;
            const float rs = rsqrtf(wsum(a0 * a0 + a1 * a1 + a2 * a2 + a3 * a3) * (1.f / 256.f) + EPS);
            const float4 gg = *(const float4*)(sg + 4 * lane), bb = *(const float4*)(sb + 4 * lane);
            u32x2 ov; ov.x = pk2(a0 * rs * gg.x + bb.x, a1 * rs * gg.y + bb.y); ov.y = pk2(a2 * rs * gg.z + bb.z, a3 * rs * gg.w + bb.w);
            *(u32x2*)(VG + (size_t)r * 256 + 4 * lane) = ov;
        }
        {
            const int hw = 1 << (lane >> 4);
            int sbase, n, tt;
            if (lat) { sbase = r & ~(SEQ - 1); n = SEQ; tt = t; }
            else { sbase = NLAT + ((r - NLAT) & ~(CTXL - 1)); n = CTXL; tt = (r - NLAT) & (CTXL - 1); }
            const int lo = max(tt - hw, 0), hi = min(tt + hw, n);
            float s0 = 0.f, s1 = 0.f, s2 = 0.f, s3 = 0.f;
#pragma unroll
            for (int d = -8; d < 8; ++d) {
                const int q = tt + d;
                const float wgt = (q >= lo && q < hi) ? 1.f : 0.f;
                const int qc = min(max(q, 0), n - 1);
                const u32x2 w = *(const u32x2*)(Z + (size_t)(sbase + qc) * DINP + 4 * lane);
                s0 += wgt * lo_f(w.x); s1 += wgt * hi_f(w.x); s2 += wgt * lo_f(w.y); s3 += wgt * hi_f(w.y);
            }
            const float inv = 1.f / (float)(hi - lo);
            const u32x2 wx = *(const u32x2*)(zr + 4 * lane);
            u32x2 o; o.x = pk2(s0 * inv - lo_f(wx.x), s1 * inv - hi_f(wx.x)); o.y = pk2(s2 * inv - lo_f(wx.y), s3 * inv - hi_f(wx.y));
            *(u32x2*)(DPOOL + (size_t)r * 256 + 4 * lane) = o;
        }
    }
}

DI void rot8_scale(u32x4& a, u32x4& b, const float2* tab, bool rope, float qs) {
#pragma unroll
    for (int e = 0; e < 4; ++e) {
        const float x1a = lo_f(a[e]), x1b = hi_f(a[e]), x2a = lo_f(b[e]), x2b = hi_f(b[e]);
        float y1a = x1a, y1b = x1b, y2a = x2a, y2b = x2b;
        if (rope) {
            const float2 ca = tab[2 * e], cb = tab[2 * e + 1];
            y1a = x1a * ca.x - x2a * ca.y; y2a = x2a * ca.x + x1a * ca.y;
            y1b = x1b * cb.x - x2b * cb.y; y2b = x2b * cb.x + x1b * cb.y;
        }
        a[e] = pk2(y1a * qs, y1b * qs); b[e] = pk2(y2a * qs, y2b * qs);
    }
}
DI void scale8(u32x4& a, float qs) {
#pragma unroll
    for (int e = 0; e < 4; ++e) a[e] = pk2(lo_f(a[e]) * qs, hi_f(a[e]) * qs);
}

template <int DQK, bool MASK>
DI void attn_item(unsigned char* smem, lds_ptr lds3, const float2* tabR, const float2* tabC,
                  const bf16_t* qbase, int ldq, bool rope, int t0, float qscale,
                  const bf16_t* k1, int ldk1, const bf16_t* k2, const bf16_t* vb, int ldv,
                  int rowA, int lenA, int posA, int rowB, int lenB,
                  float m0, float l0, bool first_unclamped, bf16_t* ob) {
    constexpr int QP = DQK * 2 + 16, VP = 192, NKS = DQK / 16, CPK = DQK / 8;
    constexpr int K_OFF = 256 * QP, KB = 64 * QP, V_OFF = K_OFF + 2 * KB, VB = 64 * VP;
    constexpr float RESCALE_T = 8.f;
    static_assert(V_OFF + 2 * VB <= LDS_BYTES, "attention LDS");
    const int tid = tid_(), wid = tid >> 6, lane = tid & 63, l31 = lane & 31, h = lane >> 5;
    {
        const int row = tid >> 1, hh = tid & 1;
        const bf16_t* qr = qbase + (size_t)row * ldq;
        unsigned char* qd = smem + row * QP;
        const int tq = t0 + row, rp = tq >> 6, cp = tq & 63;
        if constexpr (DQK == 64) {
            u32x4 c[4];
#pragma unroll
            for (int j = 0; j < 4; ++j) c[j] = *(const u32x4*)(qr + 32 * hh + 8 * j);
            const float2* tab = hh ? (tabC + cp * 16) : (tabR + rp * 16);
            rot8_scale(c[0], c[2], tab, rope, qscale);
            rot8_scale(c[1], c[3], tab + 8, rope, qscale);
#pragma unroll
            for (int j = 0; j < 4; ++j) *(u32x4*)(qd + (32 * hh + 8 * j) * 2) = c[j];
        } else {
            u32x4 c[6];
#pragma unroll
            for (int j = 0; j < 6; ++j) c[j] = *(const u32x4*)(qr + 48 * hh + 8 * j);
            if (hh) {
                scale8(c[0], qscale); scale8(c[1], qscale);
                rot8_scale(c[2], c[3], tabR + rp * 8, rope, qscale);
                rot8_scale(c[4], c[5], tabC + cp * 8, rope, qscale);
            } else {
#pragma unroll
                for (int j = 0; j < 6; ++j) scale8(c[j], qscale);
            }
#pragma unroll
            for (int j = 0; j < 6; ++j) *(u32x4*)(qd + (48 * hh + 8 * j) * 2) = c[j];
        }
    }
    __syncthreads();
    const unsigned char* qlane = smem + (32 * wid + l31) * QP + 16 * h;

    const int nA = lenA >> 6, nT = nA + (lenB >> 6);
    u32x4 kr0, kr1, vr;
    const int kidx1 = min(tid + 512, 64 * CPK - 1);
    const int kkey0 = tid / CPK, kc0 = tid % CPK, kkey1 = kidx1 / CPK, kc1 = kidx1 % CPK;
    const int koff0 = (kc0 < 8) ? kkey0 * ldk1 + 8 * kc0 : kkey0 * 32 + 8 * (kc0 - 8);
    const int koff1 = (kc1 < 8) ? kkey1 * ldk1 + 8 * kc1 : kkey1 * 32 + 8 * (kc1 - 8);
    const int voff = (tid >> 3) * ldv + 8 * (tid & 7);
    auto gloadK = [&](int j) {
        const int jj = min(j, nT - 1);
        const int row0 = (jj < nA) ? rowA + 64 * jj : rowB + 64 * (jj - nA);
        const bf16_t* b1 = k1 + (size_t)row0 * ldk1; const bf16_t* b2 = k2 + (size_t)row0 * 32;
        kr0 = *(const u32x4*)(((kc0 < 8) ? b1 : b2) + koff0);
        if constexpr (DQK == 96) { if (tid < 256) kr1 = *(const u32x4*)(((kc1 < 8) ? b1 : b2) + koff1); }
    };
    auto gloadV = [&](int j) {
        const int jj = min(j, nT - 1);
        const int row0 = (jj < nA) ? rowA + 64 * jj : rowB + 64 * (jj - nA);
        vr = *(const u32x4*)(vb + (size_t)row0 * ldv + voff);
    };
    const int ksoff0 = kkey0 * QP + 16 * kc0, ksoff1 = kkey1 * QP + 16 * kc1, vsoff = (tid >> 3) * VP + 16 * (tid & 7);
    auto sstoreK = [&](int buf) {
        *(u32x4*)(smem + K_OFF + buf * KB + ksoff0) = kr0;
        if constexpr (DQK == 96) { if (tid < 256) *(u32x4*)(smem + K_OFF + buf * KB + ksoff1) = kr1; }
    };
    auto sstoreV = [&](int buf) { *(u32x4*)(smem + V_OFF + buf * VB + vsoff) = vr; };

    f32x16 O0, O1, negm;
    float mref = m0;
#pragma unroll
    for (int i = 0; i < 16; ++i) { O0[i] = 0.f; O1[i] = 0.f; negm[i] = -m0; }
    float lsum = l0 * (h == 0 ? 1.f : 0.f);
    const int qpos = t0 + 32 * wid + l31;
    const int q4 = (lane & 15) >> 2, p4 = lane & 3, blk = (lane >> 4) & 1;
    const int vlane = (4 * h + q4) * VP + 32 * blk + 8 * p4;
    const int klane = l31 * QP + 16 * h;

    auto kfrags = [&](int buf, bf16x8 (&kf0)[NKS], bf16x8 (&kf1)[NKS]) {
        const unsigned char* Kt = smem + K_OFF + buf * KB + klane;
#pragma unroll
        for (int ks = 0; ks < NKS; ++ks) { kf0[ks] = *(const bf16x8*)(Kt + 32 * ks); kf1[ks] = *(const bf16x8*)(Kt + 32 * QP + 32 * ks); }
    };
    auto qk = [&](const bf16x8 (&kf0)[NKS], const bf16x8 (&kf1)[NKS], int jt, f32x16& S0, f32x16& S1) {
#pragma unroll
        for (int ks = 0; ks < NKS; ++ks) {
            const bf16x8 qv = *(const bf16x8*)(qlane + 32 * ks);
            if (ks == 0) { S0 = MFMA32(kf0[0], qv, negm); S1 = MFMA32(kf1[0], qv, negm); }
            else { S0 = MFMA32(kf0[ks], qv, S0); S1 = MFMA32(kf1[ks], qv, S1); }
        }
        if constexpr (MASK) {
            const int d0 = (jt < nA) ? posA + 64 * jt - qpos : 0;
#pragma unroll
            for (int i = 0; i < 16; ++i) {
                const int dd = d0 + crow16(i, h);
                if (dd > 128 || dd < -128) S0[i] = -1e30f;
                if (dd + 32 > 128 || dd + 32 < -128) S1[i] = -1e30f;
            }
        }
    };

    gloadK(0); gloadV(0); sstoreK(0); sstoreV(0);
    gloadK(1); sstoreK(1);
    __syncthreads();
    f32x16 SA0, SA1, SB0, SB1;
    {
        bf16x8 kf0[NKS], kf1[NKS];
        kfrags(0, kf0, kf1);
        qk(kf0, kf1, 0, SA0, SA1);
    }
    asm volatile("s_nop 15\n\ts_nop 15" ::: "memory");
    auto iter = [&](int j, f32x16& S0, f32x16& S1, f32x16& N0, f32x16& N1) {
        gloadK(j + 2);
        gloadV(j + 1);
        bf16x8 kf0[NKS], kf1[NKS];
        kfrags((j + 1) & 1, kf0, kf1);
        __builtin_amdgcn_sched_barrier(0);
        float mx = max3f(S0[0], S1[0], S0[1]);
        mx = max3f(mx, S1[1], S0[2]); mx = max3f(mx, S1[2], S0[3]); mx = max3f(mx, S1[3], S0[4]); mx = max3f(mx, S1[4], S0[5]);
        mx = max3f(mx, S1[5], S0[6]); mx = max3f(mx, S1[6], S0[7]); mx = max3f(mx, S1[7], S0[8]); mx = max3f(mx, S1[8], S0[9]);
        mx = max3f(mx, S1[9], S0[10]); mx = max3f(mx, S1[10], S0[11]); mx = max3f(mx, S1[11], S0[12]); mx = max3f(mx, S1[12], S0[13]);
        mx = max3f(mx, S1[13], S0[14]); mx = max3f(mx, S1[14], S0[15]); mx = fmaxf(mx, S1[15]);
        const bool first = (j == 0) && first_unclamped;
        if (first || __any(mx > RESCALE_T)) {
            const float mxf = fmaxf(mx, __shfl_xor(mx, 32));
            const float delta = first ? mxf : fmaxf(mxf, 0.f);
            const float alpha = __builtin_amdgcn_exp2f(-delta);
            mref += delta; lsum *= alpha;
#pragma unroll
            for (int i = 0; i < 16; ++i) { O0[i] *= alpha; O1[i] *= alpha; S0[i] -= delta; S1[i] -= delta; negm[i] = -mref; }
        }
        qk(kf0, kf1, j + 1, N0, N1);
        float ps = 0.f;
#pragma unroll
        for (int i = 0; i < 16; ++i) {
            S0[i] = __builtin_amdgcn_exp2f(S0[i]); S1[i] = __builtin_amdgcn_exp2f(S1[i]);
            ps += S0[i] + S1[i];
        }
        lsum += ps;
        lds_ptr Vt = lds3 + V_OFF + (j & 1) * VB + vlane;
#pragma unroll
        for (int mt = 0; mt < 2; ++mt)
#pragma unroll
            for (int s = 0; s < 2; ++s) {
                u32x4 pw;
                if (mt == 0) { pw.x = pk2(S0[8 * s], S0[8 * s + 1]); pw.y = pk2(S0[8 * s + 2], S0[8 * s + 3]); pw.z = pk2(S0[8 * s + 4], S0[8 * s + 5]); pw.w = pk2(S0[8 * s + 6], S0[8 * s + 7]); }
                else { pw.x = pk2(S1[8 * s], S1[8 * s + 1]); pw.y = pk2(S1[8 * s + 2], S1[8 * s + 3]); pw.z = pk2(S1[8 * s + 4], S1[8 * s + 5]); pw.w = pk2(S1[8 * s + 6], S1[8 * s + 7]); }
                const bf16x8 pf = __builtin_bit_cast(bf16x8, pw);
                const bf16x8 v0 = tr_pair(Vt + (32 * mt + 16 * s) * VP, 8 * VP);
                const bf16x8 v1 = tr_pair(Vt + (32 * mt + 16 * s) * VP + 64, 8 * VP);
                O0 = MFMA32(v0, pf, O0);
                O1 = MFMA32(v1, pf, O1);
            }
        sstoreK(j & 1);
        sstoreV((j + 1) & 1);
        __syncthreads();
    };
    for (int j = 0; j < nT; j += 2) {
        iter(j, SA0, SA1, SB0, SB1);
        iter(j + 1, SB0, SB1, SA0, SA1);
    }
    const float ltot = lsum + __shfl_xor(lsum, 32);
    const float inv = 1.f / ltot;
    bf16_t* orow = ob + (size_t)(32 * wid + l31) * 1024;
#pragma unroll
    for (int g4 = 0; g4 < 4; ++g4) {
        u32x2 o0, o1;
        o0.x = pk2(O0[4 * g4] * inv, O0[4 * g4 + 1] * inv); o0.y = pk2(O0[4 * g4 + 2] * inv, O0[4 * g4 + 3] * inv);
        o1.x = pk2(O1[4 * g4] * inv, O1[4 * g4 + 1] * inv); o1.y = pk2(O1[4 * g4 + 2] * inv, O1[4 * g4 + 3] * inv);
        *(u32x2*)(orow + 8 * g4 + 4 * h) = o0;
        *(u32x2*)(orow + 32 + 8 * g4 + 4 * h) = o1;
    }
}

DI void sgu_item(unsigned char* smem, lds_ptr lds3, const Params& p, int l, int c) {
    constexpr int VPB = 576;
    const int tid = tid_(), wid = tid >> 6, lane = tid & 63, l31 = lane & 31, h = lane >> 5;
    unsigned char* U = p.ws + WS_U;
    const bf16_t* VG = (const bf16_t*)(U + U_VG); const bf16_t* UG = (const bf16_t*)(U + U_UG);
    bf16_t* YC = (bf16_t*)(U + U_YCAT);
    const bf16_t* WSG = (const bf16_t*)(p.ws + W_SGU);
    const float* bs = p.in[17] + l * 512;
    const int row0 = c * 128;
#pragma unroll
    for (int i = 0; i < 8; ++i) {
        const int idx = tid + 512 * i, rr = idx >> 5, ch = idx & 31;
        const u32x4 v = *(const u32x4*)(VG + (size_t)(row0 + rr) * 256 + 8 * ch);
        *(u32x4*)(smem + rr * VPB + 16 * ch) = v;
    }
    __syncthreads();
    const int hd = wid >> 1, ph = wid & 1;
    f32x16 C00, C01, C10, C11;
#pragma unroll
    for (int i = 0; i < 16; ++i) { C00[i] = 0.f; C01[i] = 0.f; C10[i] = 0.f; C11[i] = 0.f; }
    const int q4 = (lane & 15) >> 2, p4 = lane & 3, blk = (lane >> 4) & 1;
    lds_ptr vbase = lds3 + (8 * h + q4) * VPB + (hd * 64 + 16 * blk) * 2 + 8 * p4;
    const bf16_t* wb = WSG + (size_t)(hd * 128 + 64 * ph + l31) * 128 + 8 * h;
#pragma unroll
    for (int ks = 0; ks < 8; ++ks) {
        const bf16x8 A0 = tr_pair(vbase + 16 * ks * VPB, 4 * VPB);
        const bf16x8 A1 = tr_pair(vbase + 16 * ks * VPB + 64, 4 * VPB);
        const bf16x8 B0 = *(const bf16x8*)(wb + 16 * ks);
        const bf16x8 B1 = *(const bf16x8*)(wb + 32 * 128 + 16 * ks);
        C00 = MFMA32(A0, B0, C00); C01 = MFMA32(A0, B1, C01);
        C10 = MFMA32(A1, B0, C10); C11 = MFMA32(A1, B1, C11);
    }
#pragma unroll
    for (int pt = 0; pt < 2; ++pt) {
        const int pp = 64 * ph + 32 * pt + l31, row = row0 + pp;
        const float bias = bs[hd * 128 + pp];
#pragma unroll
        for (int dt = 0; dt < 2; ++dt)
#pragma unroll
            for (int g4 = 0; g4 < 4; ++g4) {
                const int d0 = 32 * dt + 8 * g4 + 4 * h;
                const u32x2 uu = *(const u32x2*)(UG + (size_t)row * 256 + hd * 64 + d0);
                float c0, c1, c2, c3;
                if (dt == 0 && pt == 0) { c0 = C00[4 * g4]; c1 = C00[4 * g4 + 1]; c2 = C00[4 * g4 + 2]; c3 = C00[4 * g4 + 3]; }
                else if (dt == 0) { c0 = C01[4 * g4]; c1 = C01[4 * g4 + 1]; c2 = C01[4 * g4 + 2]; c3 = C01[4 * g4 + 3]; }
                else if (pt == 0) { c0 = C10[4 * g4]; c1 = C10[4 * g4 + 1]; c2 = C10[4 * g4 + 2]; c3 = C10[4 * g4 + 3]; }
                else { c0 = C11[4 * g4]; c1 = C11[4 * g4 + 1]; c2 = C11[4 * g4 + 2]; c3 = C11[4 * g4 + 3]; }
                u32x2 o;
                o.x = pk2((c0 + bias) * lo_f(uu.x), (c1 + bias) * hi_f(uu.x));
                o.y = pk2((c2 + bias) * lo_f(uu.y), (c3 + bias) * hi_f(uu.y));
                *(u32x2*)(YC + (size_t)row * 1024 + 768 + hd * 64 + d0) = o;
            }
    }
    __syncthreads();
}

DI void phase_mix(const Params& p, int l, unsigned char* smem, lds_ptr lds3) {
    const int G = nblk_(), bid = bid_();
    unsigned char* U = p.ws + WS_U;
    const bf16_t* Z = (const bf16_t*)(U + U_Z);
    const bf16_t* QRAW = (const bf16_t*)(U + U_QRAW); const bf16_t* KVRAW = (const bf16_t*)(U + U_KVRAW);
    const bf16_t* KSR = (const bf16_t*)(p.ws + WS_KSR); const bf16_t* KRR = (const bf16_t*)(p.ws + WS_KRR);
    bf16_t* YC = (bf16_t*)(U + U_YCAT);
    const float2* tS = (const float2*)(p.ws + WS_TAB); const float2* tM = tS + 320 * 16;
    const float mla_scale = 0.10206207261596575f * LOG2E;
    const float swa_scale = 0.125f * LOG2E;
    for (int ii = bid; ii < 512 + G; ii += G) {
        const int i = (ii < 512) ? ii : ((ii - 512 >= G - 8) ? 512 + (ii - 512 - (G - 8)) : -1);
        if (i < 0) continue;
        int b, hd, q0row, t0, rowA, lenA; bool rope;
        if (i < 512) { const int bh = i & 7, qt = i >> 3; b = bh >> 2; hd = bh & 3; t0 = qt * 256; q0row = b * SEQ + t0; rowA = b * SEQ; lenA = SEQ; rope = true; }
        else { const int k = i - 512; b = k >> 2; hd = k & 3; t0 = 0; q0row = NLAT + b * CTXL; rowA = 0; lenA = 0; rope = false; }
        attn_item<96, false>(smem, lds3, tM, tM + 256 * 8, QRAW + (size_t)q0row * 512 + hd * 96, 512, rope, t0, mla_scale,
                      KVRAW + hd * 128, 512, KRR, KVRAW + hd * 128 + 64, 512,
                      rowA, lenA, 0, NLAT + b * CTXL, CTXL, 0.f, 0.f, true, YC + (size_t)q0row * 1024 + 512 + hd * 64);
    }
    for (int ii = bid; ii < 512 + G; ii += G) {
        const int i = (ii < 512) ? ii : ((ii - 512 >= G - 16 && ii - 512 < G - 8) ? 512 + (ii - 512 - (G - 16)) : -1);
        if (i < 0) continue;
        int b, hd, q0row, t0, rowA, lenA, posA; bool rope;
        if (i < 512) {
            const int bh = i & 7, qt = i >> 3; b = bh >> 2; hd = bh & 3; t0 = qt * 256; q0row = b * SEQ + t0; rope = true;
            posA = max(t0 - 128, 0); const int endA = min(t0 + 384, SEQ); rowA = b * SEQ + posA; lenA = endA - posA;
        } else { const int k = i - 512; b = k >> 2; hd = k & 3; t0 = 0; q0row = NLAT + b * CTXL; rowA = 0; lenA = 0; posA = 0; rope = false; }
        const int kvh = hd >> 1;
        const float sink = p.in[9][l * 4 + hd] * LOG2E;
        attn_item<64, true>(smem, lds3, tS, tS + 256 * 16, Z + (size_t)q0row * DINP + C_SWA_Q + hd * 64, DINP, rope, t0, swa_scale,
                      KSR + kvh * 64, 128, nullptr, Z + C_SWA_V + kvh * 64, DINP,
                      rowA, lenA, posA, NLAT + b * CTXL, CTXL, sink, 1.f, false, YC + (size_t)q0row * 1024 + 256 + hd * 64);
    }
    for (int c = bid; c < 260; c += G) sgu_item(smem, lds3, p, l, c);
}

#define XB_TMO      128
#define XB_XCNT(j)  (256  + 64 * (j))
#define XB_XSUB(j)  (1280 + 64 * (j))
#define XB_XGEN(j)  (2304 + 64 * (j))
#define XB_TOP      3328
#define XB_TOPGEN   3392
#define XCD_BAR_WORDS 3456
#define XB_SPIN_CAP (1u << 18)
#define LAS __attribute__((address_space(3)))

__device__ __forceinline__ unsigned xb_ld(unsigned* p)              { return __hip_atomic_load(p, __ATOMIC_RELAXED, __HIP_MEMORY_SCOPE_AGENT); }
__device__ __forceinline__ unsigned xb_add(unsigned* p, unsigned v) { return __hip_atomic_fetch_add(p, v, __ATOMIC_RELAXED, __HIP_MEMORY_SCOPE_AGENT); }
__device__ __forceinline__ unsigned xb_xcc_id() { return (unsigned)__builtin_amdgcn_s_getreg((3 << 11) | 20) & 0xFu; }
#define XB_SPIN(cond, bar) do { unsigned _sp = 0; while (cond) { __builtin_amdgcn_s_sleep(1); \
    if ((++_sp & 255u) == 0u) { if (xb_ld(&(bar)[XB_TMO])) break; if (_sp > XB_SPIN_CAP) { atomicAdd(&(bar)[XB_TMO], 1u); break; } } } } while (0)

struct XcdBarrier {
    unsigned* bar; unsigned x;
    volatile LAS unsigned* st;
};

__device__ __forceinline__ XcdBarrier xcd_barrier_post(unsigned* bar, volatile LAS unsigned* st) {
    XcdBarrier b; b.bar = bar; b.x = xb_xcc_id(); b.st = st;
    if (threadIdx.x == 0) (void)xb_add(&bar[XB_XCNT(b.x)], 1u);
    return b;
}
__device__ __forceinline__ void xcd_barrier_complete(unsigned* bar, unsigned x, unsigned& nloc, unsigned& nx) {
    const unsigned G = gridDim.x * gridDim.y * gridDim.z;
    unsigned sum, cnt, mine, sp = 0u;
    for (;;) {
        sum = 0u; cnt = 0u; mine = 0u;
#pragma unroll
        for (unsigned j = 0; j < 16; ++j) { const unsigned c = xb_ld(&bar[XB_XCNT(j)]); sum += c; cnt += (c > 0u) ? 1u : 0u; mine = (j == x) ? c : mine; }
        if (sum == G) break;
        __builtin_amdgcn_s_sleep(1);
        if ((++sp & 255u) == 0u) { if (xb_ld(&bar[XB_TMO])) break; if (sp > XB_SPIN_CAP) { atomicAdd(&bar[XB_TMO], 1u); break; } }
    }
    nloc = mine > 0u ? mine : 1u; nx = cnt > 0u ? cnt : 1u;
}

__device__ __forceinline__ void xcd_barrier(const XcdBarrier& b) {
    asm volatile("s_waitcnt vmcnt(0)" ::: "memory");
    __syncthreads();
    if (threadIdx.x == 0) {
        unsigned* bar = b.bar;
        __builtin_amdgcn_s_waitcnt(0);
        unsigned nloc = b.st[0], nx = b.st[1];
        if (nloc == 0u) { xcd_barrier_complete(bar, b.x, nloc, nx); b.st[0] = nloc; b.st[1] = nx; }
        const unsigned old = xb_add(&bar[XB_XSUB(b.x)], 1u);
        const unsigned gen = old / nloc;
        if (old + 1u == (gen + 1u) * nloc) {
            __builtin_amdgcn_fence(__ATOMIC_RELEASE, "agent");
            asm volatile("s_waitcnt vmcnt(0)" ::: "memory");
            const unsigned og = xb_add(&bar[XB_TOP], 1u);
            const unsigned tg = og / nx;
            if (og + 1u == (tg + 1u) * nx) xb_add(&bar[XB_TOPGEN], 1u);
            else XB_SPIN(xb_ld(&bar[XB_TOPGEN]) == tg, bar);
            __builtin_amdgcn_fence(__ATOMIC_ACQUIRE, "agent");
            xb_add(&bar[XB_XGEN(b.x)], 1u);
            asm volatile("s_waitcnt vmcnt(0)" ::: "memory");
        } else {
            XB_SPIN(xb_ld(&bar[XB_XGEN(b.x)]) == gen, bar);
            __builtin_amdgcn_fence(__ATOMIC_ACQUIRE, "agent");
            asm volatile("s_waitcnt vmcnt(0)" ::: "memory");
        }
    }
    __syncthreads();
}


__global__ __launch_bounds__(512, 2) void fwd_megakernel(Params p_unused) {
    extern __shared__ __attribute__((aligned(16))) unsigned char smem[];
    cg::grid_group grid = cg::this_grid();
    lds_ptr lds3 = (lds_ptr)smem;
    {
        const Params& p = params_();
        if (blockIdx.x == 0) { unsigned* bw = (unsigned*)(p.ws + WS_BAR); for (int i = threadIdx.x; i < XCD_BAR_WORDS; i += 512) bw[i] = 0u; }
        if (threadIdx.x == 0) { *(volatile LAS unsigned*)(lds3 + LDS_BYTES) = 0u; *(volatile LAS unsigned*)(lds3 + LDS_BYTES + 4) = 0u; }
        phase_adaln(p, (float*)smem);
        phase_tables(p);
        convert_layer(p, 0, smem);
    }
    grid.sync();
    const XcdBarrier xb = xcd_barrier_post((unsigned*)(params_().ws + WS_BAR), (volatile LAS unsigned*)(lds3 + LDS_BYTES));
    {
        const Params& p = params_();
        phase_ln(p, 0, nullptr, nullptr, (const float*)(p.ws + WS_MOD), 0);
    }
    xcd_barrier(xb);
    for (int l = 0; l < DEPTH; ++l) {
        {
            const Params& p = params_(); unsigned char* U = p.ws + WS_U;
            pg8::EpiBf16<0> E; E.O = (bf16_t*)(U + U_Z); E.ldc = DINP; E.bias = nullptr; E.split_cols = 0; E.split_stride = 0;
            run_gemm(lds3, (const bf16_t*)(U + U_H), (const bf16_t*)(p.ws + W_IN), R, DINP, 1024, E);
        }
        xcd_barrier(xb);
        phase_postz(params_(), l);
        xcd_barrier(xb);
        {
            const Params& p = params_(); unsigned char* U = p.ws + WS_U;
            pg8::EpiBf16<0> E; E.bias = nullptr; E.split_cols = 0; E.split_stride = 0;
            E.O = (bf16_t*)(U + U_QRAW); E.ldc = 512;
            run_gemm(lds3, (const bf16_t*)(U + U_CQN), (const bf16_t*)(p.ws + W_UQ), R, 512, 256, E);
        }
        {
            const Params& p = params_(); unsigned char* U = p.ws + WS_U;
            pg8::EpiBf16<0> E; E.bias = nullptr; E.split_cols = 0; E.split_stride = 0;
            E.O = (bf16_t*)(U + U_KVRAW); E.ldc = 512;
            run_gemm(lds3, (const bf16_t*)(U + U_CKVN), (const bf16_t*)(p.ws + W_UKV), R, 512, 256, E, nblk_() - 8);
        }
        {
            const Params& p = params_(); unsigned char* U = p.ws + WS_U;
            pg8::EpiBf16<0> E; E.bias = nullptr; E.split_cols = 0; E.split_stride = 0;
            E.O = (bf16_t*)(U + U_YCAT); E.ldc = 1024;
            run_gemm(lds3, (const bf16_t*)(U + U_DPOOL), (const bf16_t*)(p.ws + W_POOL), R, 256, 256, E, nblk_() - 16);
        }
        xcd_barrier(xb);
        phase_mix(params_(), l, smem, lds3);
        xcd_barrier(xb);
        {
            const Params& p = params_(); unsigned char* U = p.ws + WS_U;
            EpiScaleBf16 E; E.O = (bf16_t*)(U + U_Z); E.modl = (const float*)(p.ws + WS_MOD) + (size_t)l * 3 * 6144; E.idx = 2; E.pm0 = 0;
            run_gemm(lds3, (const bf16_t*)(U + U_YCAT), (const bf16_t*)(p.ws + W_OUT), (l + 1 < DEPTH) ? R : NLAT, 1024, 1024, E);
        }
        xcd_barrier(xb);
        {
            const Params& p = params_();
            phase_ln(p, 1, p.in[19] + l * 1024, p.in[20] + l * 1024, (const float*)(p.ws + WS_MOD) + (size_t)l * 3 * 6144, 3,
                     (const bf16_t*)(p.ws + WS_U + U_Z), (l + 1 < DEPTH) ? R : NLAT);
        }
        xcd_barrier(xb);
        for (int half = 0; half < 2; ++half) {
            const int r0 = half * SEQ, mrows = half ? (((l + 1 < DEPTH) ? R : NLAT) - SEQ) : SEQ;
            {
                const Params& p = params_(); unsigned char* U = p.ws + WS_U;
                EpiRelu2 E; E.O = (bf16_t*)(U + U_F1) + (size_t)r0 * 4096; E.ldc = 4096;
                run_gemm(lds3, (const bf16_t*)(U + U_H) + (size_t)r0 * 1024, (const bf16_t*)(p.ws + W_FF1), mrows, 4096, 1024, E);
            }
            xcd_barrier(xb);
            {
                const Params& p = params_(); unsigned char* U = p.ws + WS_U;
                EpiScaleBf16 E; E.O = (bf16_t*)(U + U_H) + (size_t)r0 * 1024; E.modl = (const float*)(p.ws + WS_MOD) + (size_t)l * 3 * 6144; E.idx = 5; E.pm0 = r0 / 256;
                run_gemm(lds3, (const bf16_t*)(U + U_F1) + (size_t)r0 * 4096, (const bf16_t*)(p.ws + W_FF2), mrows, 1024, 4096, E);
            }
            xcd_barrier(xb);
        }
        {
            const Params& p = params_();
            const float* modl = (const float*)(p.ws + WS_MOD) + (size_t)l * 3 * 6144;
            if (l + 1 < DEPTH) {
                phase_ln(p, 1, p.in[23] + l * 1024, p.in[24] + l * 1024, modl + 3 * 6144, 0, (const bf16_t*)(p.ws + WS_U + U_H));
                convert_layer(p, l + 1, smem);
            } else {
                phase_ln(p, 2, p.in[23] + l * 1024, p.in[24] + l * 1024, modl, 0, (const bf16_t*)(p.ws + WS_U + U_H));
            }
        }
        xcd_barrier(xb);
    }
}

extern "C" void kernel_launch(void* const* d_in, const int* in_sizes, int n_in, void* d_out, int out_size, void* d_ws, size_t ws_size, hipStream_t stream) {
    static int grid_blocks = 0;
    if (!grid_blocks) {
        int dev = 0, cus = 0, per_cu = 0;
        hipGetDevice(&dev);
        hipDeviceGetAttribute(&cus, hipDeviceAttributeMultiprocessorCount, dev);
        if (hipFuncSetAttribute((const void*)fwd_megakernel, hipFuncAttributeMaxDynamicSharedMemorySize, LDS_ALLOC) != hipSuccess)
            fprintf(stderr, "kernel_launch: hipFuncSetAttribute(%d B LDS) failed\n", LDS_BYTES);
        if (hipOccupancyMaxActiveBlocksPerMultiprocessor(&per_cu, (const void*)fwd_megakernel, 512, LDS_ALLOC) != hipSuccess || per_cu < 1) per_cu = 1;
        (void)hipGetLastError();
        grid_blocks = cus * per_cu;
        if (ws_size < WS_END) fprintf(stderr, "kernel_launch: workspace %zu < needed %zu\n", ws_size, (size_t)WS_END);
    }
    Params p{};
    for (int i = 0; i < 25; ++i) p.in[i] = (const float*)d_in[i];
    p.out = (float*)d_out; p.ws = (unsigned char*)d_ws;
    void* args[] = {&p};
    hipError_t e = hipLaunchCooperativeKernel((const void*)fwd_megakernel, dim3(grid_blocks), dim3(512), args, LDS_ALLOC, stream);
    if (e != hipSuccess) fprintf(stderr, "cooperative launch failed: %s (grid %d)\n", hipGetErrorString(e), grid_blocks);
}
```

```cpp
#include <hip/hip_runtime.h>
#include <hip/hip_cooperative_groups.h>
#include <cstdio>
namespace cg = cooperative_groups;
namespace pg8 {
#define PG8_LAS __attribute__((address_space(3)))
typedef unsigned short bf16_t;
typedef short bf16x8 __attribute__((ext_vector_type(8)));
typedef float f32x4 __attribute__((ext_vector_type(4)));
typedef unsigned u32x4 __attribute__((ext_vector_type(4)));
constexpr int BM = 256, BK = 64, HALF = 128, HTB = HALF * BK * 2  , STAGE_BYTES = 8 * HTB, NXCD = 8, WGM = 8;

__host__ __device__ __forceinline__ int lds_byte(int r, int c) { const int st = (r >> 4) * 2 + (c >> 5), rr = r & 15, cc = c & 31, ob = rr * 64 + cc * 2; return st * 1024 + (ob ^ (((ob >> 9) & 1) << 5)); }
__host__ __device__ __forceinline__ void stage_rc(int b, int& R, int& C) { const int st = b / 1024, sb = b % 1024, swz = sb ^ (((sb >> 9) & 1) << 5); R = (st >> 1) * 16 + swz / 64; C = (st & 1) * 32 + (swz % 64) / 2; }
__host__ __device__ __forceinline__ int perm32(int rho) { const int n = rho >> 4, i = rho & 15; return 8 * (i >> 2) + 4 * n + (i & 3); }

struct Unit { int pm, pn; };
struct Gemm { const bf16_t* A; const bf16_t* Bt; int M, N, K; };

struct StaticOrder {
    int nM, nN, nwg, G, c;
    __host__ __device__ void init(int M, int N, int G_, int c_) { nM = M / BM; nN = N / BM; nwg = nM * nN; G = G_; c = c_; }
    __host__ __device__ bool next(int i, Unit& u) const {
        const long L = (long)i * G + c; if (L >= nwg) return false;
        int wgid = (int)L; { const int q = nwg / NXCD, r = nwg % NXCD, xcd = wgid % NXCD, off = wgid / NXCD; wgid = (xcd < r ? xcd * (q + 1) : r * (q + 1) + (xcd - r) * q) + off; }
        const int nig = WGM * nN, gid = wgid / nig, fm = gid * WGM, gsz = (nM - fm) < WGM ? (nM - fm) : WGM;
        u.pm = fm + ((wgid % nig) % gsz); u.pn = (wgid % nig) / gsz; return true;
    }
    __device__ __forceinline__ void a_ready(const Unit&) const {}
    __device__ __forceinline__ void done(const Unit&) const {}
};
struct CountedOrder : StaticOrder {
    const unsigned* ready; unsigned need; unsigned* tmo;
    __device__ __forceinline__ void a_ready(const Unit& u) const {
        if (threadIdx.x < 64) {
            const unsigned long long t0 = __builtin_amdgcn_s_memrealtime(); unsigned polls = 0;
            while ((unsigned)__builtin_amdgcn_readfirstlane(__hip_atomic_load(ready + 64 * u.pm, __ATOMIC_RELAXED, __HIP_MEMORY_SCOPE_AGENT)) < need) {
                if ((++polls & 255u) == 0u && __builtin_amdgcn_readfirstlane(__hip_atomic_load(tmo, __ATOMIC_RELAXED, __HIP_MEMORY_SCOPE_AGENT)) != 0u) break;
                if (__builtin_amdgcn_s_memrealtime() - t0 > 2000000ull) {
                    if (threadIdx.x == 0) { unsigned expect = 0u; __hip_atomic_compare_exchange_strong(tmo + 1, &expect, 0x600u | (unsigned)(u.pm & 0xff), __ATOMIC_RELAXED, __ATOMIC_RELAXED, __HIP_MEMORY_SCOPE_AGENT); __hip_atomic_store(tmo, 1u, __ATOMIC_RELAXED, __HIP_MEMORY_SCOPE_AGENT); }
                    break; }
                __builtin_amdgcn_s_sleep(2); }
            __builtin_amdgcn_fence(__ATOMIC_ACQUIRE, "agent");
            asm volatile("s_waitcnt vmcnt(0)" ::: "memory");
        }
#if !defined(BROKEN_HOOK_NO_BARRIER)
        asm volatile("" ::: "memory"); __builtin_amdgcn_s_barrier(); asm volatile("" ::: "memory");
#endif
    }
};

__device__ __forceinline__ unsigned cvt_pk_bf16(float lo, float hi) { unsigned r; asm volatile("v_cvt_pk_bf16_f32 %0, %1, %2" : "=v"(r) : "v"(lo), "v"(hi)); return r; }
typedef float f32x2 __attribute__((ext_vector_type(2)));
__device__ __forceinline__ f32x2 gelu_pk(f32x2 v) {
    const f32x2 av = __builtin_elementwise_abs(v), d = av * 0.2316418882f + 1.0f;
    f32x2 t; t.x = __builtin_amdgcn_rcpf(d.x); t.y = __builtin_amdgcn_rcpf(d.y);
    f32x2 q = t * 0.5307027145f + (-0.7265760135f); q = q * t + 0.7107068705f; q = q * t + (-0.142248368f); q = q * t + 0.127414796f; q = q * t;
    const f32x2 s = (v * v) * (-0.72134752044f);
    f32x2 e; e.x = __builtin_amdgcn_exp2f(s.x); e.y = __builtin_amdgcn_exp2f(s.y);
    const f32x2 m = v * (q * e), r = v - m;
    f32x2 o; o.x = v.x < 0.f ? m.x : r.x; o.y = v.y < 0.f ? m.y : r.y; return o;
}

struct EpiF32 {
    static constexpr bool PERM = false, AFTER_DRAIN = false;
    float* C; int ldc; const float* bias;
    __device__ __forceinline__ void operator()(const f32x4 (&acc)[2][2][4][2], const Unit& u, int wr, int wc, int fr, int fq) const {
        const int row0 = u.pm * BM + wr * 64 + fr, col0 = u.pn * BM + wc * 32 + 4 * fq;
        f32x4 bv[2][2];
#pragma unroll
        for (int bj = 0; bj < 2; ++bj)
#pragma unroll
            for (int n = 0; n < 2; ++n) bv[bj][n] = bias ? *(const f32x4*)(bias + col0 + bj * HALF + n * 16) : (f32x4){0.f, 0.f, 0.f, 0.f};
#pragma unroll
        for (int ai = 0; ai < 2; ++ai)
#pragma unroll
            for (int m = 0; m < 4; ++m) { float* rowp = C + (size_t)(row0 + ai * HALF + m * 16) * ldc + col0;
#pragma unroll
                for (int bj = 0; bj < 2; ++bj)
#pragma unroll
                    for (int n = 0; n < 2; ++n) *(f32x4*)(rowp + bj * HALF + n * 16) = acc[ai][bj][m][n] + bv[bj][n]; }
    }
};
template <int ACT  > struct EpiBf16 {
    static constexpr bool PERM = true, AFTER_DRAIN = false;
    bf16_t* O; int ldc; const float* bias; int split_cols; size_t split_stride;
    __device__ __forceinline__ void operator()(const f32x4 (&acc)[2][2][4][2], const Unit& u, int wr, int wc, int fr, int fq) const {
        const int row0 = u.pm * BM + wr * 64 + fr; int colt = u.pn * BM; bf16_t* base = O;
        if (split_cols) { const int t = colt / split_cols; base += (size_t)t * split_stride; colt -= t * split_cols; }
        const int col0 = colt + wc * 32 + 8 * fq, bcol0 = u.pn * BM + wc * 32 + 8 * fq;
        f32x4 bv[2][2];
#pragma unroll
        for (int bj = 0; bj < 2; ++bj)
#pragma unroll
            for (int n = 0; n < 2; ++n) bv[bj][n] = bias ? *(const f32x4*)(bias + bcol0 + bj * HALF + 4 * n) : (f32x4){0.f, 0.f, 0.f, 0.f};
#pragma unroll
        for (int ai = 0; ai < 2; ++ai)
#pragma unroll
            for (int m = 0; m < 4; ++m) { bf16_t* rowp = base + (size_t)(row0 + ai * HALF + m * 16) * ldc + col0;
#pragma unroll
                for (int bj = 0; bj < 2; ++bj) { f32x4 v0 = acc[ai][bj][m][0] + bv[bj][0], v1 = acc[ai][bj][m][1] + bv[bj][1];
                    if (ACT == 1) { f32x2 a = gelu_pk((f32x2){v0[0], v0[1]}), b = gelu_pk((f32x2){v0[2], v0[3]}), c = gelu_pk((f32x2){v1[0], v1[1]}), d = gelu_pk((f32x2){v1[2], v1[3]});
                        v0 = (f32x4){a.x, a.y, b.x, b.y}; v1 = (f32x4){c.x, c.y, d.x, d.y}; }
                    if (ACT == 2) {
#pragma unroll
                        for (int j = 0; j < 4; ++j) { v0[j] = 0.5f * v0[j] * (1.0f + erff(v0[j] * 0.70710678f)); v1[j] = 0.5f * v1[j] * (1.0f + erff(v1[j] * 0.70710678f)); } }
                    u32x4 w; w.x = cvt_pk_bf16(v0[0], v0[1]); w.y = cvt_pk_bf16(v0[2], v0[3]); w.z = cvt_pk_bf16(v1[0], v1[1]); w.w = cvt_pk_bf16(v1[2], v1[3]);
                    *(u32x4*)(rowp + bj * HALF) = w; } }
    }
};
template <class Epi, class Sched, bool STAMP = false>
__device__ __forceinline__ void gemm_phase(PG8_LAS unsigned char* lds, const Gemm g, const Sched& S, const Epi& E, unsigned long long* stamps) {
    int tid_raw = threadIdx.x; asm volatile("" : "+v"(tid_raw)); const int tid = tid_raw, wid = __builtin_amdgcn_readfirstlane(tid >> 6), lane = tid & 63, wr = wid >> 2, wc = wid & 3, fr = lane & 15, fq = lane >> 4;
    const int K = g.K, nt = K / BK;
    int ts_lo = 0, ts_hi = 0, nts = 0; const unsigned long long rt_entry = STAMP ? (unsigned long long)wall_clock64() : 0ull;
#define PG8_STAMP() do { if (STAMP && wid == 0 && nts < 64) { const unsigned long long _c = (unsigned long long)clock64(); \
        ts_lo = (lane == nts) ? (int)(unsigned)_c : ts_lo; ts_hi = (lane == nts) ? (int)(unsigned)(_c >> 32) : ts_hi; ++nts; } } while (0)
    PG8_STAMP();
    unsigned voffA[2], voffB[2];
#pragma unroll
    for (int i = 0; i < 2; ++i) { int R, C; stage_rc(tid * 16 + i * 8192, R, C); const int Rb = Epi::PERM ? ((R & ~31) + perm32(R & 31)) : R;
        voffA[i] = (unsigned)(R * K + C) * 2u; voffB[i] = (unsigned)(Rb * K + C) * 2u; }
    const size_t kstep = (size_t)(BK * 2);
    const size_t hstep = (size_t)HALF * K * 2;
    const size_t tstep = 2 * hstep;
    const unsigned ldsw = (unsigned)wid * 1024u;
    const int aoff = lds_byte(wr * 64 + fr, fq * 8), boff = lds_byte(wc * 32 + fr, fq * 8);
#define PG8_SA(b, h) (((b) * 2 + (h)) * HTB)
#define PG8_SB(b, h) ((4 + (b) * 2 + (h)) * HTB)
#define PG8_STAGE(bufoff, gbase, voff) do { _Pragma("unroll") for (int _i = 0; _i < 2; ++_i) \
        __builtin_amdgcn_global_load_lds((const unsigned*)((const char*)(gbase) + (voff)[_i]), (PG8_LAS unsigned*)(lds + (bufoff) + ldsw + _i * 8192), 16, 0, 0); } while (0)
#define PG8_LDA(dst, b, h) do { _Pragma("unroll") for (int m = 0; m < 4; ++m) _Pragma("unroll") for (int k = 0; k < 2; ++k) dst[m][k] = *(const PG8_LAS bf16x8*)(lds + PG8_SA(b, h) + aoff + m * 2048 + k * 1024); } while (0)
#define PG8_LDB(dst, b, h) do { _Pragma("unroll") for (int n = 0; n < 2; ++n) _Pragma("unroll") for (int k = 0; k < 2; ++k) dst[n][k] = *(const PG8_LAS bf16x8*)(lds + PG8_SB(b, h) + boff + n * 2048 + k * 1024); } while (0)
#define PG8_MMA(ai, bj, At, Bt) do { __builtin_amdgcn_s_setprio(1); _Pragma("unroll") for (int m = 0; m < 4; ++m) _Pragma("unroll") for (int n = 0; n < 2; ++n) _Pragma("unroll") for (int k = 0; k < 2; ++k) \
        acc[ai][bj][m][n] = __builtin_amdgcn_mfma_f32_16x16x32_bf16(Bt[n][k], At[m][k], acc[ai][bj][m][n], 0, 0, 0); __builtin_amdgcn_s_setprio(0); } while (0)
#define PG8_WAIT_V(n) asm volatile("s_waitcnt vmcnt(" #n ")" ::: "memory")
#define PG8_WAIT_L(n) asm volatile("s_waitcnt lgkmcnt(" #n ")" ::: "memory")
#define PG8_BAR __builtin_amdgcn_s_barrier()
#define PG8_SCHED __builtin_amdgcn_sched_barrier(0)
    Unit cur, nxt; int ui = 0;
    if (!S.next(0, cur)) return;
    f32x4 acc[2][2][4][2];
#pragma unroll
    for (int a = 0; a < 2; ++a)
#pragma unroll
        for (int b = 0; b < 2; ++b)
#pragma unroll
            for (int m = 0; m < 4; ++m)
#pragma unroll
                for (int n = 0; n < 2; ++n) acc[a][b][m][n] = (f32x4){0.f, 0.f, 0.f, 0.f};
    bf16x8 At[4][2], B0[2][2], B1[2][2];
    const char* cA = (const char*)g.A + (size_t)cur.pm * tstep; const char* cB = (const char*)g.Bt + (size_t)cur.pn * tstep;
    S.a_ready(cur);
    PG8_STAGE(PG8_SB(0, 0), cB, voffB); PG8_STAGE(PG8_SA(0, 0), cA, voffA); PG8_STAGE(PG8_SB(0, 1), cB + hstep, voffB); PG8_STAGE(PG8_SA(0, 1), cA + hstep, voffA);
    if (wr == 1) PG8_BAR;
    PG8_WAIT_V(4); PG8_BAR;
    PG8_STAGE(PG8_SB(1, 0), cB + kstep, voffB); PG8_STAGE(PG8_SA(1, 0), cA + kstep, voffA); PG8_STAGE(PG8_SB(1, 1), cB + hstep + kstep, voffB);
    PG8_WAIT_V(6); PG8_BAR;
    PG8_STAMP();
    for (;;) {
        const bool has_next = S.next(ui + 1, nxt);
        const char* nA = has_next ? (const char*)g.A + (size_t)nxt.pm * tstep : cA; const char* nB = has_next ? (const char*)g.Bt + (size_t)nxt.pn * tstep : cB;
        for (int t = 0; t < nt; t += 2) {
            const bool last = (t == nt - 2);
            const char* a1 = cA + (size_t)(t + 1) * kstep;
            const char* a2 = last ? nA : cA + (size_t)(t + 2) * kstep; const char* b2 = last ? nB : cB + (size_t)(t + 2) * kstep;
            const char* a3 = a2 + kstep; const char* b3 = b2 + kstep;
            if (last && has_next) S.a_ready(nxt);
            PG8_LDB(B0, 0, 0); PG8_SCHED; PG8_LDA(At, 0, 0); PG8_STAGE(PG8_SA(1, 1), a1 + hstep, voffA);
            PG8_WAIT_L(8); PG8_BAR; PG8_WAIT_L(0); PG8_MMA(0, 0, At, B0); PG8_BAR; PG8_SCHED;
            PG8_LDB(B1, 0, 1); PG8_STAGE(PG8_SB(0, 0), b2, voffB);
            PG8_BAR; PG8_WAIT_L(0); PG8_MMA(0, 1, At, B1); PG8_BAR;
            PG8_LDA(At, 0, 1); PG8_STAGE(PG8_SA(0, 0), a2, voffA);
            PG8_BAR; PG8_WAIT_L(0); PG8_MMA(1, 0, At, B0); PG8_BAR; PG8_SCHED;
            PG8_STAGE(PG8_SB(0, 1), b2 + hstep, voffB);
            PG8_WAIT_V(6); PG8_BAR; PG8_MMA(1, 1, At, B1); PG8_BAR;
            PG8_LDB(B0, 1, 0); PG8_SCHED; PG8_LDA(At, 1, 0); PG8_STAGE(PG8_SA(0, 1), a2 + hstep, voffA);
            PG8_WAIT_L(8); PG8_BAR; PG8_WAIT_L(0); PG8_MMA(0, 0, At, B0); PG8_BAR; PG8_SCHED;
            PG8_LDB(B1, 1, 1); PG8_STAGE(PG8_SB(1, 0), b3, voffB);
            PG8_BAR; PG8_WAIT_L(0); PG8_MMA(0, 1, At, B1); PG8_BAR;
            PG8_LDA(At, 1, 1); PG8_STAGE(PG8_SA(1, 0), a3, voffA);
            PG8_BAR; PG8_WAIT_L(0); PG8_MMA(1, 0, At, B0); PG8_BAR; PG8_SCHED;
            PG8_STAGE(PG8_SB(1, 1), b3 + hstep, voffB);
            PG8_WAIT_V(6); PG8_BAR; PG8_MMA(1, 1, At, B1); PG8_BAR;
        }
        PG8_STAMP();
        if constexpr (!Epi::AFTER_DRAIN) { E(acc, cur, wr, wc, fr, fq); S.done(cur); }
        PG8_STAMP();
        if (!has_next) break;
#pragma unroll
        for (int a = 0; a < 2; ++a)
#pragma unroll
            for (int b = 0; b < 2; ++b)
#pragma unroll
                for (int m = 0; m < 4; ++m)
#pragma unroll
                    for (int n = 0; n < 2; ++n) acc[a][b][m][n] = (f32x4){0.f, 0.f, 0.f, 0.f};
        cur = nxt; cA = nA; cB = nB; ++ui;
    }
    PG8_WAIT_V(0);
    if (wr == 0) PG8_BAR;
    PG8_BAR;
    if constexpr (Epi::AFTER_DRAIN) { E.fused(acc, cur, wr, wc, fr, fq, lds, wid, lane); S.done(cur); }
    PG8_STAMP();
    if (STAMP && wid == 0) { stamps[lane] = lane < nts ? (((unsigned long long)(unsigned)ts_hi << 32) | (unsigned)ts_lo) : 0ull;
        if (lane == 62) stamps[62] = rt_entry; if (lane == 63) stamps[63] = (unsigned long long)wall_clock64(); }
#undef PG8_STAMP
#undef PG8_SA
#undef PG8_SB
#undef PG8_STAGE
#undef PG8_LDA
#undef PG8_LDB
#undef PG8_MMA
#undef PG8_WAIT_V
#undef PG8_WAIT_L
#undef PG8_BAR
#undef PG8_SCHED
}
}

#define DI __device__ __forceinline__
using pg8::bf16_t; using pg8::bf16x8; using pg8::f32x4; using pg8::u32x4;
typedef short s16x4 __attribute__((ext_vector_type(4)));
typedef float f32x16 __attribute__((ext_vector_type(16)));
typedef unsigned u32x2 __attribute__((ext_vector_type(2)));
typedef __bf16 bf2_t __attribute__((ext_vector_type(2)));
typedef float f32x2_t __attribute__((ext_vector_type(2)));
typedef PG8_LAS unsigned char* lds_ptr;

constexpr int D = 1024, NLAT = 32768, NCTX = 512, R = NLAT + NCTX, SEQ = 16384, CTXL = 256, DEPTH = 4;
constexpr int DIN = 1696, DINP = 1792;
constexpr int C_SWA_Q = 256, C_MLA_CQ = 512, C_SGU = 768, C_SWA_K = 1280, C_SWA_V = 1408, C_MLA_CKV = 1536, C_MLA_KR = 1664;
constexpr float EPS = 1e-6f;
constexpr float DN_ALPHA = 1.681792830507429f;
constexpr float LOG2E = 1.4426950408889634f;
constexpr int LDS_BYTES = 131072;
constexpr int LDS_ALLOC = LDS_BYTES + 16;

constexpr size_t W_IN = 0;
constexpr size_t W_OUT = W_IN + (size_t)DINP * 1024 * 2;
constexpr size_t W_FF1 = W_OUT + (size_t)1024 * 1024 * 2;
constexpr size_t W_FF2 = W_FF1 + (size_t)4096 * 1024 * 2;
constexpr size_t W_UQ = W_FF2 + (size_t)4096 * 1024 * 2;
constexpr size_t W_UKV = W_UQ + (size_t)512 * 256 * 2;
constexpr size_t W_POOL = W_UKV + (size_t)512 * 256 * 2;
constexpr size_t W_SGU = W_POOL + (size_t)256 * 256 * 2;
constexpr size_t WS_MOD = W_SGU + (size_t)4 * 128 * 128 * 2;
constexpr size_t WS_TAB = WS_MOD + (size_t)DEPTH * 3 * 6144 * 4;
constexpr size_t WS_X = WS_TAB + (size_t)(320 * 16 + 320 * 8) * 8;
constexpr size_t WS_U = WS_X + (size_t)R * 1024 * 4;
constexpr size_t U_Z = 0;
constexpr size_t U_QRAW = U_Z + (size_t)R * DINP * 2;
constexpr size_t U_KVRAW = U_QRAW + (size_t)R * 512 * 2;
constexpr size_t U_CQN = U_KVRAW + (size_t)R * 512 * 2;
constexpr size_t U_CKVN = U_CQN + (size_t)R * 256 * 2;
constexpr size_t U_DPOOL = U_CKVN + (size_t)R * 256 * 2;
constexpr size_t U_UG = U_DPOOL + (size_t)R * 256 * 2;
constexpr size_t U_VG = U_UG + (size_t)R * 256 * 2;
constexpr size_t U_F1 = 0;
constexpr size_t U_H = (size_t)R * 4096 * 2;
constexpr size_t U_YCAT = U_H;
constexpr size_t WS_KSR = WS_U + U_H + (size_t)R * 1024 * 2;
constexpr size_t WS_KRR = WS_KSR + (size_t)R * 128 * 2;
constexpr size_t WS_BAR = WS_KRR + (size_t)R * 32 * 2;
constexpr size_t WS_END = WS_BAR + 16384;
static_assert(U_VG + (size_t)R * 256 * 2 == U_H, "mixer-mode buffers must exactly fill the f1 slot");
static_assert(WS_END <= (size_t)536870912, "workspace too large");
static_assert(WS_X % 256 == 0 && WS_U % 256 == 0 && WS_MOD % 256 == 0 && WS_TAB % 256 == 0, "alignment");

struct Params { const float* in[25]; float* out; unsigned char* ws; };
DI int tid_() { int t = threadIdx.x; asm volatile("" : "+v"(t)); return t; }
DI int bid_() { int t = blockIdx.x; asm volatile("" : "+s"(t)); return t; }
DI int nblk_() { int t = gridDim.x; asm volatile("" : "+s"(t)); return t; }
DI const Params& params_() { auto k = __builtin_amdgcn_kernarg_segment_ptr(); asm volatile("" : "+s"(k)); return *(const Params*)k; }


DI float bf2f(bf16_t b) { return __uint_as_float(((unsigned)b) << 16); }
DI unsigned pk2(float a, float b) { f32x2_t v = {a, b}; bf2_t r = __builtin_convertvector(v, bf2_t); return __builtin_bit_cast(unsigned, r); }
DI bf16_t f2bf(float a) { return (bf16_t)(pk2(a, 0.f) & 0xffffu); }
DI float lo_f(unsigned u) { return __uint_as_float(u << 16); }
DI float hi_f(unsigned u) { return __uint_as_float(u & 0xffff0000u); }
DI float wsum(float v) {
#pragma unroll
    for (int m = 32; m >= 1; m >>= 1) v += __shfl_xor(v, m);
    return v;
}
DI float max3f(float a, float b, float c) { float r; asm("v_max3_f32 %0, %1, %2, %3" : "=v"(r) : "v"(a), "v"(b), "v"(c)); return r; }
DI int crow16(int i, int h) { return (i & 3) + 8 * (i >> 2) + 4 * h; }
#define MFMA32(a, b, c) __builtin_amdgcn_mfma_f32_32x32x16_bf16((a), (b), (c), 0, 0, 0)
DI bf16x8 tr_pair(lds_ptr lo_addr, int hi_delta) {
    const s16x4 lo = __builtin_amdgcn_ds_read_tr16_b64_v4i16((PG8_LAS s16x4*)lo_addr);
    const s16x4 hi = __builtin_amdgcn_ds_read_tr16_b64_v4i16((PG8_LAS s16x4*)(lo_addr + hi_delta));
    return __builtin_shufflevector(lo, hi, 0, 1, 2, 3, 4, 5, 6, 7);
}

struct EpiScaleBf16 {
    static constexpr bool PERM = true, AFTER_DRAIN = false;
    bf16_t* O; const float* modl; int idx;
    DI void operator()(const f32x4 (&acc)[2][2][4][2], const pg8::Unit& u, int wr, int wc, int fr, int fq) const {
        const int row0 = u.pm * 256 + wr * 64 + fr, col0 = u.pn * 256 + wc * 32 + 8 * fq;
        const int set = (u.pm < 64) ? 0 : (u.pm < 128 ? 1 : 2);
        const float* mp = modl + set * 6144 + idx * 1024 + col0;
        f32x4 mv[2][2];
#pragma unroll
        for (int bj = 0; bj < 2; ++bj)
#pragma unroll
            for (int n = 0; n < 2; ++n) mv[bj][n] = *(const f32x4*)(mp + bj * 128 + 4 * n);
#pragma unroll
        for (int ai = 0; ai < 2; ++ai)
#pragma unroll
            for (int m = 0; m < 4; ++m) {
                bf16_t* rowp = O + (size_t)(row0 + ai * 128 + m * 16) * 1024 + col0;
#pragma unroll
                for (int bj = 0; bj < 2; ++bj) {
                    const f32x4 v0 = acc[ai][bj][m][0] * mv[bj][0], v1 = acc[ai][bj][m][1] * mv[bj][1];
                    u32x4 w; w.x = pk2(v0[0], v0[1]); w.y = pk2(v0[2], v0[3]); w.z = pk2(v1[0], v1[1]); w.w = pk2(v1[2], v1[3]);
                    *(u32x4*)(rowp + bj * 128) = w;
                }
            }
    }
};
struct EpiRelu2 {
    static constexpr bool PERM = true, AFTER_DRAIN = false;
    bf16_t* O; int ldc;
    DI void operator()(const f32x4 (&acc)[2][2][4][2], const pg8::Unit& u, int wr, int wc, int fr, int fq) const {
        const int row0 = u.pm * 256 + wr * 64 + fr, col0 = u.pn * 256 + wc * 32 + 8 * fq;
#pragma unroll
        for (int ai = 0; ai < 2; ++ai)
#pragma unroll
            for (int m = 0; m < 4; ++m) {
                bf16_t* rowp = O + (size_t)(row0 + ai * 128 + m * 16) * ldc + col0;
#pragma unroll
                for (int bj = 0; bj < 2; ++bj) {
                    f32x4 v0 = acc[ai][bj][m][0], v1 = acc[ai][bj][m][1];
#pragma unroll
                    for (int j = 0; j < 4; ++j) { const float a = fmaxf(v0[j], 0.f), b = fmaxf(v1[j], 0.f); v0[j] = a * a; v1[j] = b * b; }
                    u32x4 w; w.x = pk2(v0[0], v0[1]); w.y = pk2(v0[2], v0[3]); w.z = pk2(v1[0], v1[1]); w.w = pk2(v1[2], v1[3]);
                    *(u32x4*)(rowp + bj * 128) = w;
                }
            }
    }
};

template <class Epi>
DI void run_gemm(lds_ptr lds3, const bf16_t* A, const bf16_t* Bt, int M, int N, int K, const Epi& E, int crot = 0) {
    pg8::Gemm g; g.A = A; g.Bt = Bt; g.M = M; g.N = N; g.K = K;
    const int G = nblk_(); int c = bid_() + crot; if (c >= G) c -= G;
    pg8::StaticOrder S; S.init(M, N, G, c);
    pg8::gemm_phase<Epi, pg8::StaticOrder, false>(lds3, g, S, E, nullptr);
}

DI void phase_adaln(const Params& p, float* lf) {
    for (int i = tid_(); i < 3072; i += 512) {
        const int s = i >> 10, k = i & 1023;
        const float v = (s < 2) ? p.in[1][s * 1024 + k] : p.in[3][k];
        lf[i] = v / (1.f + expf(-v));
    }
    __syncthreads();
    float* red = lf + 3072;
    const int wid = tid_() >> 6, lane = tid_() & 63;
    float* mod = (float*)(p.ws + WS_MOD);
    for (int item = bid_(); item < DEPTH * 96; item += nblk_()) {
        const int l = item / 96, jc = (item % 96) * 64;
        const float* w = p.in[4] + (size_t)l * 1024 * 6144 + jc + lane;
        float a0 = 0.f, a1 = 0.f, a2 = 0.f;
        const int i0 = wid * 128;
#pragma unroll 32
        for (int i = 0; i < 128; ++i) {
            const float wv = w[(size_t)(i0 + i) * 6144];
            a0 += lf[i0 + i] * wv; a1 += lf[1024 + i0 + i] * wv; a2 += lf[2048 + i0 + i] * wv;
        }
        red[(wid * 3 + 0) * 64 + lane] = a0; red[(wid * 3 + 1) * 64 + lane] = a1; red[(wid * 3 + 2) * 64 + lane] = a2;
        __syncthreads();
        if (tid_() < 192) {
            const int s = tid_() >> 6;
            float sum = 0.f;
#pragma unroll
            for (int w8 = 0; w8 < 8; ++w8) sum += red[(w8 * 3 + s) * 64 + lane];
            mod[((size_t)l * 3 + s) * 6144 + jc + lane] = sum + p.in[5][l * 6144 + jc + lane];
        }
        __syncthreads();
    }
}

DI void phase_tables(const Params& p) {
    float2* tS = (float2*)(p.ws + WS_TAB);
    float2* tM = tS + 320 * 16;
    const int gtid = bid_() * 512 + tid_(), gsz = nblk_() * 512;
    const float L2B = 13.287712379549449f;
    for (int i = gtid; i < 320 * 16 + 320 * 8; i += gsz) {
        int pos, f; float inv;
        if (i < 320 * 16) { pos = i >> 4; f = i & 15; inv = exp2f(-(float)(2 * f) * (1.f / 32.f) * L2B); }
        else { const int k = i - 320 * 16; pos = k >> 3; f = k & 7; inv = exp2f(-(float)(2 * f) * (1.f / 16.f) * L2B); }
        const float ang = (float)(pos < 256 ? pos : pos - 256) * inv;
        const double ad = (double)ang;
        const double kk = __builtin_rint(ad * 0.15915494309189535);
        const float rr = (float)(ad - kk * 6.283185307179586);
        tS[i] = make_float2(__cosf(rr), __sinf(rr));
    }
}

struct ConvJob { const float* src; bf16_t* dst; int K, N, KP, tk, tn; };
DI void conv_load(const ConvJob& c, int t, float4 (&v)[2]) {
#pragma unroll
    for (int rep = 0; rep < 2; ++rep) {
        const int k = c.tk * 64 + rep * 32 + (t >> 4), n = c.tn * 64 + (t & 15) * 4;
        v[rep] = make_float4(0.f, 0.f, 0.f, 0.f);
        if (k < c.K && n < c.N) v[rep] = *(const float4*)(c.src + (size_t)k * c.N + n);
    }
}
DI void conv_store(const ConvJob& c, int t, const float4 (&v)[2], bf16_t* tile) {
#pragma unroll
    for (int rep = 0; rep < 2; ++rep) {
        const int kl = rep * 32 + (t >> 4), nl = (t & 15) * 4;
        tile[(nl + 0) * 72 + kl] = f2bf(v[rep].x); tile[(nl + 1) * 72 + kl] = f2bf(v[rep].y);
        tile[(nl + 2) * 72 + kl] = f2bf(v[rep].z); tile[(nl + 3) * 72 + kl] = f2bf(v[rep].w);
    }
    __syncthreads();
    {
        const int nl = t >> 3, kl = (t & 7) * 8;
        const u32x4 w = *(const u32x4*)(tile + nl * 72 + kl);
        *(u32x4*)(c.dst + (size_t)(c.tn * 64 + nl) * c.KP + c.tk * 64 + kl) = w;
    }
    __syncthreads();
}

DI void convert_layer(const Params& p, int l, unsigned char* smem) {
    bf16_t* tile = (bf16_t*)smem;
    constexpr int T_IN = 16 * 28, T_OUT = 16 * 16, T_FF1 = 16 * 64, T_FF2 = 64 * 16, T_UQ = 4 * 8, T_UKV = 4 * 8;
    constexpr int T_ALL = T_IN + T_OUT + T_FF1 + T_FF2 + T_UQ + T_UKV;
    auto decode = [&](int t) {
        ConvJob c; int NT; size_t off; int tt = t;
        if (tt < T_IN) { c.src = p.in[6] + (size_t)l * 1024 * DIN; c.K = 1024; c.N = DIN; c.KP = 1024; NT = 28; off = W_IN; }
        else if ((tt -= T_IN) < T_OUT) { c.src = p.in[18] + (size_t)l * 1024 * 1024; c.K = 1024; c.N = 1024; c.KP = 1024; NT = 16; off = W_OUT; }
        else if ((tt -= T_OUT) < T_FF1) { c.src = p.in[21] + (size_t)l * 1024 * 4096; c.K = 1024; c.N = 4096; c.KP = 1024; NT = 64; off = W_FF1; }
        else if ((tt -= T_FF1) < T_FF2) { c.src = p.in[22] + (size_t)l * 4096 * 1024; c.K = 4096; c.N = 1024; c.KP = 4096; NT = 16; off = W_FF2; }
        else if ((tt -= T_FF2) < T_UQ) { c.src = p.in[11] + (size_t)l * 256 * 384; c.K = 256; c.N = 384; c.KP = 256; NT = 8; off = W_UQ; }
        else { tt -= T_UQ; c.src = p.in[13] + (size_t)l * 128 * 512; c.K = 128; c.N = 512; c.KP = 256; NT = 8; off = W_UKV; }
        c.dst = (bf16_t*)(p.ws + off); c.tk = tt / NT; c.tn = tt % NT;
        return c;
    };
    {
        const int t = tid_(), G = nblk_();
        int tix = bid_();
        float4 cur[2], nxt[2];
        if (tix < T_ALL) conv_load(decode(tix), t, cur);
        for (; tix < T_ALL; tix += G) {
            const bool more = tix + G < T_ALL;
            if (more) conv_load(decode(tix + G), t, nxt);
            conv_store(decode(tix), t, cur, tile);
            cur[0] = nxt[0]; cur[1] = nxt[1];
        }
    }
    const int gtid = bid_() * 512 + tid_(), gsz = nblk_() * 512;
    {
        bf16_t* dst = (bf16_t*)(p.ws + W_POOL);
        const float* pw = p.in[7] + (size_t)l * 4 * 64 * 64; const float* ps = p.in[8] + l * 256;
        for (int i = gtid; i < 65536; i += gsz) {
            const int row = i >> 8, col = i & 255, g = row >> 6, e = row & 63;
            float v = 0.f;
            if ((col >> 6) == g) v = pw[(g * 64 + (col & 63)) * 64 + e] * ps[row];
            dst[i] = f2bf(v);
        }
    }
    {
        bf16_t* dst = (bf16_t*)(p.ws + W_SGU);
        const float* sw = p.in[16] + (size_t)l * 65536;
        for (int i = gtid; i < 65536; i += gsz) dst[i] = f2bf(sw[i]);
    }
}

DI void wsum4(float& a, float& b, float& c, float& d) {
#pragma unroll
    for (int m = 32; m >= 1; m >>= 1) {
        const float ta = __shfl_xor(a, m), tb = __shfl_xor(b, m), tc = __shfl_xor(c, m), td = __shfl_xor(d, m);
        a += ta; b += tb; c += tc; d += td;
    }
}
DI void row_stats(const float4 (&v)[4], float& s, float& q) {
    s = 0.f; q = 0.f;
#pragma unroll
    for (int j = 0; j < 4; ++j) { s += v[j].x + v[j].y + v[j].z + v[j].w; q += v[j].x * v[j].x + v[j].y * v[j].y + v[j].z * v[j].z + v[j].w * v[j].w; }
}
DI void phase_ln(const Params& p, int mode, const float* g, const float* b, const float* modl, int i0, const bf16_t* Y = nullptr, int rlimit = R) {
    const int wid = tid_() >> 6, lane = tid_() & 63;
    bf16_t* XL = (bf16_t*)(p.ws + WS_X);
    float* XC = (float*)(p.ws + WS_X + (size_t)NLAT * 1024 * 2);
    bf16_t* H = (bf16_t*)(p.ws + WS_U + U_H);
    const int rmax = (mode == 2) ? NLAT : rlimit;
    const int rstride = nblk_() * 8;
    for (int ra = bid_() * 8 + wid; ra < rmax; ra += 2 * rstride) {
        const bool has_b = ra + rstride < rmax;
        const int rb = has_b ? ra + rstride : ra;
        float4 v[2][4];
#pragma unroll
        for (int k = 0; k < 2; ++k) {
            const int r = k ? rb : ra;
            if (mode != 0 && r < NLAT) {
#pragma unroll
                for (int j = 0; j < 4; ++j) {
                    const u32x2 w = *(const u32x2*)(XL + (size_t)r * 1024 + 4 * lane + 256 * j);
                    v[k][j] = make_float4(lo_f(w.x), hi_f(w.x), lo_f(w.y), hi_f(w.y));
                }
            } else {
                const float* src;
                if (mode == 0) src = (r < NLAT) ? p.in[0] + (size_t)r * 1024 : p.in[2] + (size_t)(r - NLAT) * 1024;
                else src = XC + (size_t)(r - NLAT) * 1024;
#pragma unroll
                for (int j = 0; j < 4; ++j) v[k][j] = *(const float4*)(src + 4 * lane + 256 * j);
            }
        }
        if (mode != 0) {
#pragma unroll
            for (int k = 0; k < 2; ++k) {
                const int r = k ? rb : ra;
                {
#pragma unroll
                    for (int j = 0; j < 4; ++j) {
                        const u32x2 yw = *(const u32x2*)(Y + (size_t)r * 1024 + 4 * lane + 256 * j);
                        v[k][j].x = v[k][j].x * DN_ALPHA + lo_f(yw.x); v[k][j].y = v[k][j].y * DN_ALPHA + hi_f(yw.x);
                        v[k][j].z = v[k][j].z * DN_ALPHA + lo_f(yw.y); v[k][j].w = v[k][j].w * DN_ALPHA + hi_f(yw.y);
                    }
                }
            }
            float s0, q0, s1, q1;
            row_stats(v[0], s0, q0); row_stats(v[1], s1, q1);
            wsum4(s0, q0, s1, q1);
#pragma unroll
            for (int k = 0; k < 2; ++k) {
                const float mu = (k ? s1 : s0) * (1.f / 1024.f);
                const float rs = rsqrtf(fmaxf((k ? q1 : q0) * (1.f / 1024.f) - mu * mu, 0.f) + EPS);
#pragma unroll
                for (int j = 0; j < 4; ++j) {
                    const float4 gg = *(const float4*)(g + 4 * lane + 256 * j), bb = *(const float4*)(b + 4 * lane + 256 * j);
                    v[k][j].x = (v[k][j].x - mu) * rs * gg.x + bb.x; v[k][j].y = (v[k][j].y - mu) * rs * gg.y + bb.y;
                    v[k][j].z = (v[k][j].z - mu) * rs * gg.z + bb.z; v[k][j].w = (v[k][j].w - mu) * rs * gg.w + bb.w;
                }
            }
        }
#pragma unroll
        for (int k = 0; k < 2; ++k) {
            const int r = k ? rb : ra;
            if (k == 0 || has_b) {
                if (mode != 2 && r < NLAT) {
#pragma unroll
                    for (int j = 0; j < 4; ++j) { u32x2 o; o.x = pk2(v[k][j].x, v[k][j].y); o.y = pk2(v[k][j].z, v[k][j].w); *(u32x2*)(XL + (size_t)r * 1024 + 4 * lane + 256 * j) = o; }
                } else {
                    float* dstx = (mode == 2) ? p.out + (size_t)r * 1024 : XC + (size_t)(r - NLAT) * 1024;
#pragma unroll
                    for (int j = 0; j < 4; ++j) *(float4*)(dstx + 4 * lane + 256 * j) = v[k][j];
                }
            }
        }
        if (mode != 2) {
            float s0, q0, s1, q1;
            row_stats(v[0], s0, q0); row_stats(v[1], s1, q1);
            wsum4(s0, q0, s1, q1);
#pragma unroll
            for (int k = 0; k < 2; ++k) {
                const int r = k ? rb : ra;
                if (k == 0 || has_b) {
                    const float mu = (k ? s1 : s0) * (1.f / 1024.f);
                    const float rs = rsqrtf(fmaxf((k ? q1 : q0) * (1.f / 1024.f) - mu * mu, 0.f) + EPS);
                    const int set = (r < SEQ) ? 0 : (r < NLAT ? 1 : 2);
                    const float* msh = modl + set * 6144 + i0 * 1024, *msc = msh + 1024;
#pragma unroll
                    for (int j = 0; j < 4; ++j) {
                        const float4 sh = *(const float4*)(msh + 4 * lane + 256 * j), sc = *(const float4*)(msc + 4 * lane + 256 * j);
                        u32x2 o;
                        o.x = pk2((v[k][j].x - mu) * rs * (1.f + sc.x) + sh.x, (v[k][j].y - mu) * rs * (1.f + sc.y) + sh.y);
                        o.y = pk2((v[k][j].z - mu) * rs * (1.f + sc.z) + sh.z, (v[k][j].w - mu) * rs * (1.f + sc.w) + sh.w);
                        *(u32x2*)(H + (size_t)r * 1024 + 4 * lane + 256 * j) = o;
                    }
                }
            }
        }
    }
}

DI float gelu_exact(float x) { return 0.5f * x * (1.f + erff(x * 0.70710678118654752f)); }

DI void phase_postz(const Params& p, int l) {
    const int wid = tid_() >> 6, lane = tid_() & 63;
    unsigned char* U = p.ws + WS_U;
    const bf16_t* Z = (const bf16_t*)(U + U_Z);
    bf16_t* KSR = (bf16_t*)(p.ws + WS_KSR); bf16_t* KRR = (bf16_t*)(p.ws + WS_KRR);
    bf16_t* CQN = (bf16_t*)(U + U_CQN); bf16_t* CKVN = (bf16_t*)(U + U_CKVN); bf16_t* DPOOL = (bf16_t*)(U + U_DPOOL);
    bf16_t* UG = (bf16_t*)(U + U_UG); bf16_t* VG = (bf16_t*)(U + U_VG);
    const float2* tS = (const float2*)(p.ws + WS_TAB); const float2* tM = tS + 320 * 16;
    const float* gq = p.in[10] + l * 256; const float* gkv = p.in[12] + l * 128;
    const float* sg = p.in[14] + l * 256; const float* sb = p.in[15] + l * 256;
    for (int r = bid_() * 8 + wid; r < R; r += nblk_() * 8) {
        const bf16_t* zr = Z + (size_t)r * DINP;
        const bool lat = r < NLAT;
        const int t = r & (SEQ - 1), rp = t >> 6, cp = t & 63;
        {
            const int hd = lane >> 5, pp = lane & 31, i = pp & 15, off = hd * 64 + ((pp & 16) ? 32 : 0);
            const float x1 = bf2f(zr[C_SWA_K + off + i]), x2 = bf2f(zr[C_SWA_K + off + 16 + i]);
            float o1 = x1, o2 = x2;
            if (lat) { const float2 cs = (pp & 16) ? tS[(256 + cp) * 16 + i] : tS[rp * 16 + i]; o1 = x1 * cs.x - x2 * cs.y; o2 = x2 * cs.x + x1 * cs.y; }
            KSR[(size_t)r * 128 + off + i] = f2bf(o1); KSR[(size_t)r * 128 + off + 16 + i] = f2bf(o2);
        }
        if (lane < 16) {
            const int i = lane & 7, off = (lane & 8) ? 16 : 0;
            const float x1 = bf2f(zr[C_MLA_KR + off + i]), x2 = bf2f(zr[C_MLA_KR + off + 8 + i]);
            float o1 = x1, o2 = x2;
            if (lat) { const float2 cs = (lane & 8) ? tM[(256 + cp) * 8 + i] : tM[rp * 8 + i]; o1 = x1 * cs.x - x2 * cs.y; o2 = x2 * cs.x + x1 * cs.y; }
            KRR[(size_t)r * 32 + off + i] = f2bf(o1); KRR[(size_t)r * 32 + off + 8 + i] = f2bf(o2);
        }
        {
            const u32x2 w = *(const u32x2*)(zr + C_MLA_CQ + 4 * lane);
            const float a0 = lo_f(w.x), a1 = hi_f(w.x), a2 = lo_f(w.y), a3 = hi_f(w.y);
            const float rs = rsqrtf(wsum(a0 * a0 + a1 * a1 + a2 * a2 + a3 * a3) * (1.f / 256.f) + EPS);
            const float4 gg = *(const float4*)(gq + 4 * lane);
            u32x2 o; o.x = pk2(a0 * rs * gg.x, a1 * rs * gg.y); o.y = pk2(a2 * rs * gg.z, a3 * rs * gg.w);
            *(u32x2*)(CQN + (size_t)r * 256 + 4 * lane) = o;
        }
        {
            const unsigned w = *(const unsigned*)(zr + C_MLA_CKV + 2 * lane);
            const float a0 = lo_f(w), a1 = hi_f(w);
            const float rs = rsqrtf(wsum(a0 * a0 + a1 * a1) * (1.f / 128.f) + EPS);
            const float2 gg = *(const float2*)(gkv + 2 * lane);
            *(unsigned*)(CKVN + (size_t)r * 256 + 2 * lane) = pk2(a0 * rs * gg.x, a1 * rs * gg.y);
            *(unsigned*)(CKVN + (size_t)r * 256 + 128 + 2 * lane) = 0u;
        }
        {
            const u32x2 wu = *(const u32x2*)(zr + C_SGU + 4 * lane);
            const pg8::f32x2 gu0 = pg8::gelu_pk((pg8::f32x2){lo_f(wu.x), hi_f(wu.x)}), gu1 = pg8::gelu_pk((pg8::f32x2){lo_f(wu.y), hi_f(wu.y)});
            u32x2 ou; ou.x = pk2(gu0.x, gu0.y); ou.y = pk2(gu1.x, gu1.y);
            *(u32x2*)(UG + (size_t)r * 256 + 4 * lane) = ou;
            const u32x2 wv = *(const u32x2*)(zr + C_SGU + 256 + 4 * lane);
            const pg8::f32x2 gv0 = pg8::gelu_pk((pg8::f32x2){lo_f(wv.x), hi_f(wv.x)}), gv1 = pg8::gelu_pk((pg8::f32x2){lo_f(wv.y), hi_f(wv.y)});
            float a0 = gv0.x, a1 = gv0.y, a2 = gv1.x, a3 = gv1.y;
            const float mu = wsum(a0 + a1 + a2 + a3) * (1.f / 256.f);
            a0 -= mu; a1 -= mu; a2 -= mu; a3 -= mu;
            const float rs = rsqrtf(wsum(a0 * a0 + a1 * a1 + a2 * a2 + a3 * a3) * (1.f / 256.f) + EPS);
            const float4 gg = *(const float4*)(sg + 4 * lane), bb = *(const float4*)(sb + 4 * lane);
            u32x2 ov; ov.x = pk2(a0 * rs * gg.x + bb.x, a1 * rs * gg.y + bb.y); ov.y = pk2(a2 * rs * gg.z + bb.z, a3 * rs * gg.w + bb.w);
            *(u32x2*)(VG + (size_t)r * 256 + 4 * lane) = ov;
        }
        {
            const int hw = 1 << (lane >> 4);
            int sbase, n, tt;
            if (lat) { sbase = r & ~(SEQ - 1); n = SEQ; tt = t; }
            else { sbase = NLAT + ((r - NLAT) & ~(CTXL - 1)); n = CTXL; tt = (r - NLAT) & (CTXL - 1); }
            const int lo = max(tt - hw, 0), hi = min(tt + hw, n);
            float s0 = 0.f, s1 = 0.f, s2 = 0.f, s3 = 0.f;
#pragma unroll
            for (int d = -8; d < 8; ++d) {
                const int q = tt + d;
                const float wgt = (q >= lo && q < hi) ? 1.f : 0.f;
                const int qc = min(max(q, 0), n - 1);
                const u32x2 w = *(const u32x2*)(Z + (size_t)(sbase + qc) * DINP + 4 * lane);
                s0 += wgt * lo_f(w.x); s1 += wgt * hi_f(w.x); s2 += wgt * lo_f(w.y); s3 += wgt * hi_f(w.y);
            }
            const float inv = 1.f / (float)(hi - lo);
            const u32x2 wx = *(const u32x2*)(zr + 4 * lane);
            u32x2 o; o.x = pk2(s0 * inv - lo_f(wx.x), s1 * inv - hi_f(wx.x)); o.y = pk2(s2 * inv - lo_f(wx.y), s3 * inv - hi_f(wx.y));
            *(u32x2*)(DPOOL + (size_t)r * 256 + 4 * lane) = o;
        }
    }
}

DI void rot8_scale(u32x4& a, u32x4& b, const float2* tab, bool rope, float qs) {
#pragma unroll
    for (int e = 0; e < 4; ++e) {
        const float x1a = lo_f(a[e]), x1b = hi_f(a[e]), x2a = lo_f(b[e]), x2b = hi_f(b[e]);
        float y1a = x1a, y1b = x1b, y2a = x2a, y2b = x2b;
        if (rope) {
            const float2 ca = tab[2 * e], cb = tab[2 * e + 1];
            y1a = x1a * ca.x - x2a * ca.y; y2a = x2a * ca.x + x1a * ca.y;
            y1b = x1b * cb.x - x2b * cb.y; y2b = x2b * cb.x + x1b * cb.y;
        }
        a[e] = pk2(y1a * qs, y1b * qs); b[e] = pk2(y2a * qs, y2b * qs);
    }
}
DI void scale8(u32x4& a, float qs) {
#pragma unroll
    for (int e = 0; e < 4; ++e) a[e] = pk2(lo_f(a[e]) * qs, hi_f(a[e]) * qs);
}

template <int DQK, bool MASK, bool FAST = false>
DI bool attn_item(unsigned char* smem, lds_ptr lds3, const float2* tabR, const float2* tabC,
                  const bf16_t* qbase, int ldq, bool rope, int t0, float qscale,
                  const bf16_t* k1, int ldk1, const bf16_t* k2, const bf16_t* vb, int ldv,
                  int rowA, int lenA, int posA, int rowB, int lenB,
                  float m0, float l0, bool first_unclamped, bf16_t* ob) {
    constexpr int QP = DQK * 2 + 16, VP = 192, NKS = DQK / 16, CPK = DQK / 8;
    constexpr int K_OFF = 256 * QP, KB = 64 * QP, V_OFF = K_OFF + 2 * KB, VB = 64 * VP;
    constexpr float RESCALE_T = 8.f;
    static_assert(V_OFF + 2 * VB <= LDS_BYTES, "attention LDS");
    const int tid = tid_(), wid = tid >> 6, lane = tid & 63, l31 = lane & 31, h = lane >> 5;
    {
        const int row = tid >> 1, hh = tid & 1;
        const bf16_t* qr = qbase + (size_t)row * ldq;
        unsigned char* qd = smem + row * QP;
        const int tq = t0 + row, rp = tq >> 6, cp = tq & 63;
        if constexpr (DQK == 64) {
            u32x4 c[4];
#pragma unroll
            for (int j = 0; j < 4; ++j) c[j] = *(const u32x4*)(qr + 32 * hh + 8 * j);
            const float2* tab = hh ? (tabC + cp * 16) : (tabR + rp * 16);
            rot8_scale(c[0], c[2], tab, rope, qscale);
            rot8_scale(c[1], c[3], tab + 8, rope, qscale);
#pragma unroll
            for (int j = 0; j < 4; ++j) *(u32x4*)(qd + (32 * hh + 8 * j) * 2) = c[j];
        } else {
            u32x4 c[6];
#pragma unroll
            for (int j = 0; j < 6; ++j) c[j] = *(const u32x4*)(qr + 48 * hh + 8 * j);
            if (hh) {
                scale8(c[0], qscale); scale8(c[1], qscale);
                rot8_scale(c[2], c[3], tabR + rp * 8, rope, qscale);
                rot8_scale(c[4], c[5], tabC + cp * 8, rope, qscale);
            } else {
#pragma unroll
                for (int j = 0; j < 6; ++j) scale8(c[j], qscale);
            }
#pragma unroll
            for (int j = 0; j < 6; ++j) *(u32x4*)(qd + (48 * hh + 8 * j) * 2) = c[j];
        }
    }
    __syncthreads();
    const unsigned char* qlane = smem + (32 * wid + l31) * QP + 16 * h;

    const int nA = lenA >> 6, nT = nA + (lenB >> 6);
    u32x4 kr0, kr1, vr;
    const int kidx1 = min(tid + 512, 64 * CPK - 1);
    const int kkey0 = tid / CPK, kc0 = tid % CPK, kkey1 = kidx1 / CPK, kc1 = kidx1 % CPK;
    const int koff0 = (kc0 < 8) ? kkey0 * ldk1 + 8 * kc0 : kkey0 * 32 + 8 * (kc0 - 8);
    const int koff1 = (kc1 < 8) ? kkey1 * ldk1 + 8 * kc1 : kkey1 * 32 + 8 * (kc1 - 8);
    const int voff = (tid >> 3) * ldv + 8 * (tid & 7);
    auto gloadK = [&](int j) {
        const int jj = min(j, nT - 1);
        const int row0 = (jj < nA) ? rowA + 64 * jj : rowB + 64 * (jj - nA);
        const bf16_t* b1 = k1 + (size_t)row0 * ldk1; const bf16_t* b2 = k2 + (size_t)row0 * 32;
        kr0 = *(const u32x4*)(((kc0 < 8) ? b1 : b2) + koff0);
        if constexpr (DQK == 96) { if (tid < 256) kr1 = *(const u32x4*)(((kc1 < 8) ? b1 : b2) + koff1); }
    };
    auto gloadV = [&](int j) {
        const int jj = min(j, nT - 1);
        const int row0 = (jj < nA) ? rowA + 64 * jj : rowB + 64 * (jj - nA);
        vr = *(const u32x4*)(vb + (size_t)row0 * ldv + voff);
    };
    const int ksoff0 = kkey0 * QP + 16 * kc0, ksoff1 = kkey1 * QP + 16 * kc1, vsoff = (tid >> 3) * VP + 16 * (tid & 7);
    auto sstoreK = [&](int buf) {
        *(u32x4*)(smem + K_OFF + buf * KB + ksoff0) = kr0;
        if constexpr (DQK == 96) { if (tid < 256) *(u32x4*)(smem + K_OFF + buf * KB + ksoff1) = kr1; }
    };
    auto sstoreV = [&](int buf) { *(u32x4*)(smem + V_OFF + buf * VB + vsoff) = vr; };

    f32x16 O0, O1, negm;
    float mref = m0;
#pragma unroll
    for (int i = 0; i < 16; ++i) { O0[i] = 0.f; O1[i] = 0.f; negm[i] = -m0; }
    float lsum = l0 * (h == 0 ? 1.f : 0.f);
    const int qpos = t0 + 32 * wid + l31;
    const int q4 = (lane & 15) >> 2, p4 = lane & 3, blk = (lane >> 4) & 1;
    const int vlane = (4 * h + q4) * VP + 32 * blk + 8 * p4;
    const int klane = l31 * QP + 16 * h;

    auto kfrags = [&](int buf, bf16x8 (&kf0)[NKS], bf16x8 (&kf1)[NKS]) {
        const unsigned char* Kt = smem + K_OFF + buf * KB + klane;
#pragma unroll
        for (int ks = 0; ks < NKS; ++ks) { kf0[ks] = *(const bf16x8*)(Kt + 32 * ks); kf1[ks] = *(const bf16x8*)(Kt + 32 * QP + 32 * ks); }
    };
    f32x16 zacc;
#pragma unroll
    for (int i = 0; i < 16; ++i) zacc[i] = 0.f;
    auto qk = [&](const bf16x8 (&kf0)[NKS], const bf16x8 (&kf1)[NKS], int jt, f32x16& S0, f32x16& S1) {
#pragma unroll
        for (int ks = 0; ks < NKS; ++ks) {
            const bf16x8 qv = *(const bf16x8*)(qlane + 32 * ks);
            if (ks == 0) { S0 = MFMA32(kf0[0], qv, FAST ? negm : zacc); S1 = MFMA32(kf1[0], qv, FAST ? negm : zacc); }
            else { S0 = MFMA32(kf0[ks], qv, S0); S1 = MFMA32(kf1[ks], qv, S1); }
        }
        if constexpr (MASK) {
            const int d0 = (jt < nA) ? posA + 64 * jt - qpos : 0;
#pragma unroll
            for (int i = 0; i < 16; ++i) {
                const int dd = d0 + crow16(i, h);
                if (dd > 128 || dd < -128) S0[i] = -1e30f;
                if (dd + 32 > 128 || dd + 32 < -128) S1[i] = -1e30f;
            }
        }
    };

    gloadK(0); gloadV(0); sstoreK(0); sstoreV(0);
    gloadK(1); sstoreK(1);
    __syncthreads();
    f32x16 LS; bf16x8 ones8;
#pragma unroll
    for (int i = 0; i < 16; ++i) LS[i] = 0.f;
#pragma unroll
    for (int i = 0; i < 8; ++i) ones8[i] = (short)0x3F80;
    f32x16 SA0, SA1, SB0, SB1;
    {
        bf16x8 kf0[NKS], kf1[NKS];
        kfrags(0, kf0, kf1);
        qk(kf0, kf1, 0, SA0, SA1);
    }
    asm volatile("s_nop 15\n\ts_nop 15" ::: "memory");
    auto iter = [&](int j, f32x16& S0, f32x16& S1, f32x16& N0, f32x16& N1) {
        gloadK(j + 2);
        gloadV(j + 1);
        bf16x8 kf0[NKS], kf1[NKS];
        kfrags((j + 1) & 1, kf0, kf1);
        __builtin_amdgcn_sched_barrier(0);
        const bool first = (j == 0) && first_unclamped;
        float ps = 0.f;
        if constexpr (FAST) {
            if (first) {
                float mx = max3f(S0[0], S1[0], S0[1]);
                mx = max3f(mx, S1[1], S0[2]); mx = max3f(mx, S1[2], S0[3]); mx = max3f(mx, S1[3], S0[4]); mx = max3f(mx, S1[4], S0[5]);
                mx = max3f(mx, S1[5], S0[6]); mx = max3f(mx, S1[6], S0[7]); mx = max3f(mx, S1[7], S0[8]); mx = max3f(mx, S1[8], S0[9]);
                mx = max3f(mx, S1[9], S0[10]); mx = max3f(mx, S1[10], S0[11]); mx = max3f(mx, S1[11], S0[12]); mx = max3f(mx, S1[12], S0[13]);
                mx = max3f(mx, S1[13], S0[14]); mx = max3f(mx, S1[14], S0[15]); mx = fmaxf(mx, S1[15]);
                const float delta = fmaxf(mx, __shfl_xor(mx, 32)) + 10.f;
                mref += delta;
#pragma unroll
                for (int i = 0; i < 16; ++i) { S0[i] -= delta; S1[i] -= delta; negm[i] = -mref; }
            }
#pragma unroll
            for (int i = 0; i < 16; ++i) S0[i] = __builtin_amdgcn_exp2f(S0[i]);
            __builtin_amdgcn_sched_barrier(0);
            qk(kf0, kf1, j + 1, N0, N1);
#pragma unroll
            for (int i = 0; i < 16; ++i) S1[i] = __builtin_amdgcn_exp2f(S1[i]);
        } else {
            float mx = max3f(S0[0], S1[0], S0[1]);
            mx = max3f(mx, S1[1], S0[2]); mx = max3f(mx, S1[2], S0[3]); mx = max3f(mx, S1[3], S0[4]); mx = max3f(mx, S1[4], S0[5]);
            mx = max3f(mx, S1[5], S0[6]); mx = max3f(mx, S1[6], S0[7]); mx = max3f(mx, S1[7], S0[8]); mx = max3f(mx, S1[8], S0[9]);
            mx = max3f(mx, S1[9], S0[10]); mx = max3f(mx, S1[10], S0[11]); mx = max3f(mx, S1[11], S0[12]); mx = max3f(mx, S1[12], S0[13]);
            mx = max3f(mx, S1[13], S0[14]); mx = max3f(mx, S1[14], S0[15]); mx = fmaxf(mx, S1[15]);
            if (first || __any(mx - mref > RESCALE_T)) {
                const float mxf = fmaxf(mx, __shfl_xor(mx, 32));
                const float mnew = first ? mxf : fmaxf(mxf, mref);
                const float alpha = __builtin_amdgcn_exp2f(mref - mnew);
                mref = mnew; lsum *= alpha;
#pragma unroll
                for (int i = 0; i < 16; ++i) { O0[i] *= alpha; O1[i] *= alpha; }
            }
            qk(kf0, kf1, j + 1, N0, N1);
#pragma unroll
            for (int i = 0; i < 16; ++i) { S0[i] = __builtin_amdgcn_exp2f(S0[i] - mref); S1[i] = __builtin_amdgcn_exp2f(S1[i] - mref); ps += S0[i] + S1[i]; }
        }
        lsum += ps;
        lds_ptr Vt = lds3 + V_OFF + (j & 1) * VB + vlane;
#pragma unroll
        for (int mt = 0; mt < 2; ++mt)
#pragma unroll
            for (int s = 0; s < 2; ++s) {
                u32x4 pw;
                if (mt == 0) { pw.x = pk2(S0[8 * s], S0[8 * s + 1]); pw.y = pk2(S0[8 * s + 2], S0[8 * s + 3]); pw.z = pk2(S0[8 * s + 4], S0[8 * s + 5]); pw.w = pk2(S0[8 * s + 6], S0[8 * s + 7]); }
                else { pw.x = pk2(S1[8 * s], S1[8 * s + 1]); pw.y = pk2(S1[8 * s + 2], S1[8 * s + 3]); pw.z = pk2(S1[8 * s + 4], S1[8 * s + 5]); pw.w = pk2(S1[8 * s + 6], S1[8 * s + 7]); }
                const bf16x8 pf = __builtin_bit_cast(bf16x8, pw);
                const bf16x8 v0 = tr_pair(Vt + (32 * mt + 16 * s) * VP, 8 * VP);
                const bf16x8 v1 = tr_pair(Vt + (32 * mt + 16 * s) * VP + 64, 8 * VP);
                O0 = MFMA32(v0, pf, O0);
                O1 = MFMA32(v1, pf, O1);
                if constexpr (FAST) LS = MFMA32(ones8, pf, LS);
            }
        sstoreK(j & 1);
        sstoreV((j + 1) & 1);
        __syncthreads();
    };
    for (int j = 0; j < nT; j += 2) {
        iter(j, SA0, SA1, SB0, SB1);
        iter(j + 1, SB0, SB1, SA0, SA1);
    }
    float ltot;
    if constexpr (FAST) {
        ltot = LS[0];
        if (__syncthreads_or((int)!(ltot < 1e30f))) return false;
    } else {
        ltot = lsum + __shfl_xor(lsum, 32);
    }
    const float inv = 1.f / ltot;
    bf16_t* orow = ob + (size_t)(32 * wid + l31) * 1024;
#pragma unroll
    for (int g4 = 0; g4 < 4; ++g4) {
        u32x2 o0, o1;
        o0.x = pk2(O0[4 * g4] * inv, O0[4 * g4 + 1] * inv); o0.y = pk2(O0[4 * g4 + 2] * inv, O0[4 * g4 + 3] * inv);
        o1.x = pk2(O1[4 * g4] * inv, O1[4 * g4 + 1] * inv); o1.y = pk2(O1[4 * g4 + 2] * inv, O1[4 * g4 + 3] * inv);
        *(u32x2*)(orow + 8 * g4 + 4 * h) = o0;
        *(u32x2*)(orow + 32 + 8 * g4 + 4 * h) = o1;
    }
    return true;
}

DI void sgu_item(unsigned char* smem, lds_ptr lds3, const Params& p, int l, int c) {
    constexpr int VPB = 576;
    const int tid = tid_(), wid = tid >> 6, lane = tid & 63, l31 = lane & 31, h = lane >> 5;
    unsigned char* U = p.ws + WS_U;
    const bf16_t* VG = (const bf16_t*)(U + U_VG); const bf16_t* UG = (const bf16_t*)(U + U_UG);
    bf16_t* YC = (bf16_t*)(U + U_YCAT);
    const bf16_t* WSG = (const bf16_t*)(p.ws + W_SGU);
    const float* bs = p.in[17] + l * 512;
    const int row0 = c * 128;
#pragma unroll
    for (int i = 0; i < 8; ++i) {
        const int idx = tid + 512 * i, rr = idx >> 5, ch = idx & 31;
        const u32x4 v = *(const u32x4*)(VG + (size_t)(row0 + rr) * 256 + 8 * ch);
        *(u32x4*)(smem + rr * VPB + 16 * ch) = v;
    }
    __syncthreads();
    const int hd = wid >> 1, ph = wid & 1;
    f32x16 C00, C01, C10, C11;
#pragma unroll
    for (int i = 0; i < 16; ++i) { C00[i] = 0.f; C01[i] = 0.f; C10[i] = 0.f; C11[i] = 0.f; }
    const int q4 = (lane & 15) >> 2, p4 = lane & 3, blk = (lane >> 4) & 1;
    lds_ptr vbase = lds3 + (8 * h + q4) * VPB + (hd * 64 + 16 * blk) * 2 + 8 * p4;
    const bf16_t* wb = WSG + (size_t)(hd * 128 + 64 * ph + l31) * 128 + 8 * h;
#pragma unroll
    for (int ks = 0; ks < 8; ++ks) {
        const bf16x8 A0 = tr_pair(vbase + 16 * ks * VPB, 4 * VPB);
        const bf16x8 A1 = tr_pair(vbase + 16 * ks * VPB + 64, 4 * VPB);
        const bf16x8 B0 = *(const bf16x8*)(wb + 16 * ks);
        const bf16x8 B1 = *(const bf16x8*)(wb + 32 * 128 + 16 * ks);
        C00 = MFMA32(A0, B0, C00); C01 = MFMA32(A0, B1, C01);
        C10 = MFMA32(A1, B0, C10); C11 = MFMA32(A1, B1, C11);
    }
#pragma unroll
    for (int pt = 0; pt < 2; ++pt) {
        const int pp = 64 * ph + 32 * pt + l31, row = row0 + pp;
        const float bias = bs[hd * 128 + pp];
#pragma unroll
        for (int dt = 0; dt < 2; ++dt)
#pragma unroll
            for (int g4 = 0; g4 < 4; ++g4) {
                const int d0 = 32 * dt + 8 * g4 + 4 * h;
                const u32x2 uu = *(const u32x2*)(UG + (size_t)row * 256 + hd * 64 + d0);
                float c0, c1, c2, c3;
                if (dt == 0 && pt == 0) { c0 = C00[4 * g4]; c1 = C00[4 * g4 + 1]; c2 = C00[4 * g4 + 2]; c3 = C00[4 * g4 + 3]; }
                else if (dt == 0) { c0 = C01[4 * g4]; c1 = C01[4 * g4 + 1]; c2 = C01[4 * g4 + 2]; c3 = C01[4 * g4 + 3]; }
                else if (pt == 0) { c0 = C10[4 * g4]; c1 = C10[4 * g4 + 1]; c2 = C10[4 * g4 + 2]; c3 = C10[4 * g4 + 3]; }
                else { c0 = C11[4 * g4]; c1 = C11[4 * g4 + 1]; c2 = C11[4 * g4 + 2]; c3 = C11[4 * g4 + 3]; }
                u32x2 o;
                o.x = pk2((c0 + bias) * lo_f(uu.x), (c1 + bias) * hi_f(uu.x));
                o.y = pk2((c2 + bias) * lo_f(uu.y), (c3 + bias) * hi_f(uu.y));
                *(u32x2*)(YC + (size_t)row * 1024 + 768 + hd * 64 + d0) = o;
            }
    }
    __syncthreads();
}

DI void phase_mix(const Params& p, int l, unsigned char* smem, lds_ptr lds3) {
    const int G = nblk_(), bid = bid_();
    unsigned char* U = p.ws + WS_U;
    const bf16_t* Z = (const bf16_t*)(U + U_Z);
    const bf16_t* QRAW = (const bf16_t*)(U + U_QRAW); const bf16_t* KVRAW = (const bf16_t*)(U + U_KVRAW);
    const bf16_t* KSR = (const bf16_t*)(p.ws + WS_KSR); const bf16_t* KRR = (const bf16_t*)(p.ws + WS_KRR);
    bf16_t* YC = (bf16_t*)(U + U_YCAT);
    const float2* tS = (const float2*)(p.ws + WS_TAB); const float2* tM = tS + 320 * 16;
    const float mla_scale = 0.10206207261596575f * LOG2E;
    const float swa_scale = 0.125f * LOG2E;
    unsigned failmask = 0u;
    for (int pass = 0; pass < 2; ++pass) {
        int slot = 0;
        for (int ii = bid; ii < 512 + G; ii += G, ++slot) {
            const int i = (ii < 512) ? ii : ((ii - 512 >= G - 8) ? 512 + (ii - 512 - (G - 8)) : -1);
            if (i < 0) continue;
            if (pass == 1 && !((failmask >> slot) & 1u)) continue;
            int b, hd, q0row, t0, rowA, lenA; bool rope;
            if (i < 512) { const int bh = i & 7, qt = i >> 3; b = bh >> 2; hd = bh & 3; t0 = qt * 256; q0row = b * SEQ + t0; rowA = b * SEQ; lenA = SEQ; rope = true; }
            else { const int k = i - 512; b = k >> 2; hd = k & 3; t0 = 0; q0row = NLAT + b * CTXL; rowA = 0; lenA = 0; rope = false; }
            if (pass == 0) {
                const bool ok = attn_item<96, false, true>(smem, lds3, tM, tM + 256 * 8, QRAW + (size_t)q0row * 512 + hd * 96, 512, rope, t0, mla_scale,
                              KVRAW + hd * 128, 512, KRR, KVRAW + hd * 128 + 64, 512,
                              rowA, lenA, 0, NLAT + b * CTXL, CTXL, 0.f, 0.f, true, YC + (size_t)q0row * 1024 + 512 + hd * 64);
                if (!ok) failmask |= 1u << slot;
            } else {
                attn_item<96, false, false>(smem, lds3, tM, tM + 256 * 8, QRAW + (size_t)q0row * 512 + hd * 96, 512, rope, t0, mla_scale,
                              KVRAW + hd * 128, 512, KRR, KVRAW + hd * 128 + 64, 512,
                              rowA, lenA, 0, NLAT + b * CTXL, CTXL, 0.f, 0.f, true, YC + (size_t)q0row * 1024 + 512 + hd * 64);
            }
        }
        if (failmask == 0u) break;
    }
    for (int ii = bid; ii < 512 + G; ii += G) {
        const int i = (ii < 512) ? ii : ((ii - 512 >= G - 16 && ii - 512 < G - 8) ? 512 + (ii - 512 - (G - 16)) : -1);
        if (i < 0) continue;
        int b, hd, q0row, t0, rowA, lenA, posA; bool rope;
        if (i < 512) {
            const int bh = i & 7, qt = i >> 3; b = bh >> 2; hd = bh & 3; t0 = qt * 256; q0row = b * SEQ + t0; rope = true;
            posA = max(t0 - 128, 0); const int endA = min(t0 + 384, SEQ); rowA = b * SEQ + posA; lenA = endA - posA;
        } else { const int k = i - 512; b = k >> 2; hd = k & 3; t0 = 0; q0row = NLAT + b * CTXL; rowA = 0; lenA = 0; posA = 0; rope = false; }
        const int kvh = hd >> 1;
        const float sink = p.in[9][l * 4 + hd] * LOG2E;
        attn_item<64, true>(smem, lds3, tS, tS + 256 * 16, Z + (size_t)q0row * DINP + C_SWA_Q + hd * 64, DINP, rope, t0, swa_scale,
                      KSR + kvh * 64, 128, nullptr, Z + C_SWA_V + kvh * 64, DINP,
                      rowA, lenA, posA, NLAT + b * CTXL, CTXL, sink, 1.f, false, YC + (size_t)q0row * 1024 + 256 + hd * 64);
    }
    for (int c = bid; c < 260; c += G) sgu_item(smem, lds3, p, l, c);
}

#define XB_TMO      128
#define XB_XCNT(j)  (256  + 64 * (j))
#define XB_XSUB(j)  (1280 + 64 * (j))
#define XB_XGEN(j)  (2304 + 64 * (j))
#define XB_TOP      3328
#define XB_TOPGEN   3392
#define XCD_BAR_WORDS 3456
#define XB_SPIN_CAP (1u << 18)
#define LAS __attribute__((address_space(3)))

__device__ __forceinline__ unsigned xb_ld(unsigned* p)              { return __hip_atomic_load(p, __ATOMIC_RELAXED, __HIP_MEMORY_SCOPE_AGENT); }
__device__ __forceinline__ unsigned xb_add(unsigned* p, unsigned v) { return __hip_atomic_fetch_add(p, v, __ATOMIC_RELAXED, __HIP_MEMORY_SCOPE_AGENT); }
__device__ __forceinline__ unsigned xb_xcc_id() { return (unsigned)__builtin_amdgcn_s_getreg((3 << 11) | 20) & 0xFu; }
#define XB_SPIN(cond, bar) do { unsigned _sp = 0; while (cond) { __builtin_amdgcn_s_sleep(1); \
    if ((++_sp & 255u) == 0u) { if (xb_ld(&(bar)[XB_TMO])) break; if (_sp > XB_SPIN_CAP) { atomicAdd(&(bar)[XB_TMO], 1u); break; } } } } while (0)

struct XcdBarrier {
    unsigned* bar; unsigned x;
    volatile LAS unsigned* st;
};

__device__ __forceinline__ XcdBarrier xcd_barrier_post(unsigned* bar, volatile LAS unsigned* st) {
    XcdBarrier b; b.bar = bar; b.x = xb_xcc_id(); b.st = st;
    if (threadIdx.x == 0) (void)xb_add(&bar[XB_XCNT(b.x)], 1u);
    return b;
}
__device__ __forceinline__ void xcd_barrier_complete(unsigned* bar, unsigned x, unsigned& nloc, unsigned& nx) {
    const unsigned G = gridDim.x * gridDim.y * gridDim.z;
    unsigned sum, cnt, mine, sp = 0u;
    for (;;) {
        sum = 0u; cnt = 0u; mine = 0u;
#pragma unroll
        for (unsigned j = 0; j < 16; ++j) { const unsigned c = xb_ld(&bar[XB_XCNT(j)]); sum += c; cnt += (c > 0u) ? 1u : 0u; mine = (j == x) ? c : mine; }
        if (sum == G) break;
        __builtin_amdgcn_s_sleep(1);
        if ((++sp & 255u) == 0u) { if (xb_ld(&bar[XB_TMO])) break; if (sp > XB_SPIN_CAP) { atomicAdd(&bar[XB_TMO], 1u); break; } }
    }
    nloc = mine > 0u ? mine : 1u; nx = cnt > 0u ? cnt : 1u;
}

__device__ __forceinline__ void xcd_barrier(const XcdBarrier& b) {
    asm volatile("s_waitcnt vmcnt(0)" ::: "memory");
    __syncthreads();
    if (threadIdx.x == 0) {
        unsigned* bar = b.bar;
        __builtin_amdgcn_s_waitcnt(0);
        unsigned nloc = b.st[0], nx = b.st[1];
        if (nloc == 0u) { xcd_barrier_complete(bar, b.x, nloc, nx); b.st[0] = nloc; b.st[1] = nx; }
        const unsigned old = xb_add(&bar[XB_XSUB(b.x)], 1u);
        const unsigned gen = old / nloc;
        if (old + 1u == (gen + 1u) * nloc) {
            __builtin_amdgcn_fence(__ATOMIC_RELEASE, "agent");
            asm volatile("s_waitcnt vmcnt(0)" ::: "memory");
            const unsigned og = xb_add(&bar[XB_TOP], 1u);
            const unsigned tg = og / nx;
            if (og + 1u == (tg + 1u) * nx) xb_add(&bar[XB_TOPGEN], 1u);
            else XB_SPIN(xb_ld(&bar[XB_TOPGEN]) == tg, bar);
            __builtin_amdgcn_fence(__ATOMIC_ACQUIRE, "agent");
            xb_add(&bar[XB_XGEN(b.x)], 1u);
            asm volatile("s_waitcnt vmcnt(0)" ::: "memory");
        } else {
            XB_SPIN(xb_ld(&bar[XB_XGEN(b.x)]) == gen, bar);
            __builtin_amdgcn_fence(__ATOMIC_ACQUIRE, "agent");
            asm volatile("s_waitcnt vmcnt(0)" ::: "memory");
        }
    }
    __syncthreads();
}


DI void grid_bar(lds_ptr lds3) {
    XcdBarrier b; b.bar = (unsigned*)(params_().ws + WS_BAR); b.x = xb_xcc_id(); b.st = (volatile LAS unsigned*)(lds3 + LDS_BYTES);
    xcd_barrier(b);
}

__global__ __launch_bounds__(512, 2) void fwd_megakernel(Params p_unused) {
    extern __shared__ __attribute__((aligned(16))) unsigned char smem[];
    cg::grid_group grid = cg::this_grid();
    lds_ptr lds3 = (lds_ptr)smem;
    {
        const Params& p = params_();
        if (blockIdx.x == 0) { unsigned* bw = (unsigned*)(p.ws + WS_BAR); for (int i = threadIdx.x; i < XCD_BAR_WORDS; i += 512) bw[i] = 0u; }
        if (threadIdx.x == 0) { *(volatile LAS unsigned*)(lds3 + LDS_BYTES) = 0u; *(volatile LAS unsigned*)(lds3 + LDS_BYTES + 4) = 0u; }
        phase_adaln(p, (float*)smem);
        phase_tables(p);
        convert_layer(p, 0, smem);
    }
    grid.sync();
    (void)xcd_barrier_post((unsigned*)(params_().ws + WS_BAR), (volatile LAS unsigned*)(lds3 + LDS_BYTES));
    {
        const Params& p = params_();
        phase_ln(p, 0, nullptr, nullptr, (const float*)(p.ws + WS_MOD), 0);
    }
    grid_bar(lds3);
    for (int l = 0; l < DEPTH; ++l) {
        {
            const Params& p = params_(); unsigned char* U = p.ws + WS_U;
            pg8::EpiBf16<0> E; E.O = (bf16_t*)(U + U_Z); E.ldc = DINP; E.bias = nullptr; E.split_cols = 0; E.split_stride = 0;
            run_gemm(lds3, (const bf16_t*)(U + U_H), (const bf16_t*)(p.ws + W_IN), R, DINP, 1024, E);
        }
        grid_bar(lds3);
        phase_postz(params_(), l);
        grid_bar(lds3);
        {
            const Params& p = params_(); unsigned char* U = p.ws + WS_U;
            pg8::EpiBf16<0> E; E.bias = nullptr; E.split_cols = 0; E.split_stride = 0;
            E.O = (bf16_t*)(U + U_QRAW); E.ldc = 512;
            run_gemm(lds3, (const bf16_t*)(U + U_CQN), (const bf16_t*)(p.ws + W_UQ), R, 512, 256, E);
        }
        {
            const Params& p = params_(); unsigned char* U = p.ws + WS_U;
            pg8::EpiBf16<0> E; E.bias = nullptr; E.split_cols = 0; E.split_stride = 0;
            E.O = (bf16_t*)(U + U_KVRAW); E.ldc = 512;
            run_gemm(lds3, (const bf16_t*)(U + U_CKVN), (const bf16_t*)(p.ws + W_UKV), R, 512, 256, E, nblk_() - 8);
        }
        {
            const Params& p = params_(); unsigned char* U = p.ws + WS_U;
            pg8::EpiBf16<0> E; E.bias = nullptr; E.split_cols = 0; E.split_stride = 0;
            E.O = (bf16_t*)(U + U_YCAT); E.ldc = 1024;
            run_gemm(lds3, (const bf16_t*)(U + U_DPOOL), (const bf16_t*)(p.ws + W_POOL), R, 256, 256, E, nblk_() - 16);
        }
        grid_bar(lds3);
        phase_mix(params_(), l, smem, lds3);
        grid_bar(lds3);
        {
            const Params& p = params_(); unsigned char* U = p.ws + WS_U;
            EpiScaleBf16 E; E.O = (bf16_t*)(U + U_Z); E.modl = (const float*)(p.ws + WS_MOD) + (size_t)l * 3 * 6144; E.idx = 2;
            run_gemm(lds3, (const bf16_t*)(U + U_YCAT), (const bf16_t*)(p.ws + W_OUT), (l + 1 < DEPTH) ? R : NLAT, 1024, 1024, E);
        }
        grid_bar(lds3);
        {
            const Params& p = params_();
            phase_ln(p, 1, p.in[19] + l * 1024, p.in[20] + l * 1024, (const float*)(p.ws + WS_MOD) + (size_t)l * 3 * 6144, 3,
                     (const bf16_t*)(p.ws + WS_U + U_Z), (l + 1 < DEPTH) ? R : NLAT);
        }
        grid_bar(lds3);
        {
            const Params& p = params_(); unsigned char* U = p.ws + WS_U;
            EpiRelu2 E; E.O = (bf16_t*)(U + U_F1); E.ldc = 4096;
            run_gemm(lds3, (const bf16_t*)(U + U_H), (const bf16_t*)(p.ws + W_FF1), (l + 1 < DEPTH) ? R : NLAT, 4096, 1024, E);
        }
        grid_bar(lds3);
        {
            const Params& p = params_(); unsigned char* U = p.ws + WS_U;
            EpiScaleBf16 E; E.O = (bf16_t*)(U + U_H); E.modl = (const float*)(p.ws + WS_MOD) + (size_t)l * 3 * 6144; E.idx = 5;
            run_gemm(lds3, (const bf16_t*)(U + U_F1), (const bf16_t*)(p.ws + W_FF2), (l + 1 < DEPTH) ? R : NLAT, 1024, 4096, E);
        }
        grid_bar(lds3);
        {
            const Params& p = params_();
            const float* modl = (const float*)(p.ws + WS_MOD) + (size_t)l * 3 * 6144;
            if (l + 1 < DEPTH) {
                phase_ln(p, 1, p.in[23] + l * 1024, p.in[24] + l * 1024, modl + 3 * 6144, 0, (const bf16_t*)(p.ws + WS_U + U_H));
                convert_layer(p, l + 1, smem);
            } else {
                phase_ln(p, 2, p.in[23] + l * 1024, p.in[24] + l * 1024, modl, 0, (const bf16_t*)(p.ws + WS_U + U_H));
            }
        }
        grid_bar(lds3);
    }
}

extern "C" void kernel_launch(void* const* d_in, const int* in_sizes, int n_in, void* d_out, int out_size, void* d_ws, size_t ws_size, hipStream_t stream) {
    static int grid_blocks = 0;
    if (!grid_blocks) {
        int dev = 0, cus = 0, per_cu = 0;
        hipGetDevice(&dev);
        hipDeviceGetAttribute(&cus, hipDeviceAttributeMultiprocessorCount, dev);
        if (hipFuncSetAttribute((const void*)fwd_megakernel, hipFuncAttributeMaxDynamicSharedMemorySize, LDS_ALLOC) != hipSuccess)
            fprintf(stderr, "kernel_launch: hipFuncSetAttribute(%d B LDS) failed\n", LDS_BYTES);
        if (hipOccupancyMaxActiveBlocksPerMultiprocessor(&per_cu, (const void*)fwd_megakernel, 512, LDS_ALLOC) != hipSuccess || per_cu < 1) per_cu = 1;
        (void)hipGetLastError();
        grid_blocks = cus * per_cu;
        if (ws_size < WS_END) fprintf(stderr, "kernel_launch: workspace %zu < needed %zu\n", ws_size, (size_t)WS_END);
    }
    Params p{};
    for (int i = 0; i < 25; ++i) p.in[i] = (const float*)d_in[i];
    p.out = (float*)d_out; p.ws = (unsigned char*)d_ws;
    void* args[] = {&p};
    hipError_t e = hipLaunchCooperativeKernel((const void*)fwd_megakernel, dim3(grid_blocks), dim3(512), args, LDS_ALLOC, stream);
    if (e != hipSuccess) fprintf(stderr, "cooperative launch failed: %s (grid %d)\n", hipGetErrorString(e), grid_blocks);
}
```

```cpp
#include <hip/hip_runtime.h>
#include <hip/hip_cooperative_groups.h>
#include <cstdio>
namespace cg = cooperative_groups;
namespace pg8 {
#define PG8_LAS __attribute__((address_space(3)))
typedef unsigned short bf16_t;
typedef short bf16x8 __attribute__((ext_vector_type(8)));
typedef float f32x4 __attribute__((ext_vector_type(4)));
typedef unsigned u32x4 __attribute__((ext_vector_type(4)));
constexpr int BM = 256, BK = 64, HALF = 128, HTB = HALF * BK * 2  , STAGE_BYTES = 8 * HTB, NXCD = 8, WGM = 8;

__host__ __device__ __forceinline__ int lds_byte(int r, int c) { const int st = (r >> 4) * 2 + (c >> 5), rr = r & 15, cc = c & 31, ob = rr * 64 + cc * 2; return st * 1024 + (ob ^ (((ob >> 9) & 1) << 5)); }
__host__ __device__ __forceinline__ void stage_rc(int b, int& R, int& C) { const int st = b / 1024, sb = b % 1024, swz = sb ^ (((sb >> 9) & 1) << 5); R = (st >> 1) * 16 + swz / 64; C = (st & 1) * 32 + (swz % 64) / 2; }
__host__ __device__ __forceinline__ int perm32(int rho) { const int n = rho >> 4, i = rho & 15; return 8 * (i >> 2) + 4 * n + (i & 3); }

struct Unit { int pm, pn; };
struct Gemm { const bf16_t* A; const bf16_t* Bt; int M, N, K; };

struct StaticOrder {
    int nM, nN, nwg, G, c;
    __host__ __device__ void init(int M, int N, int G_, int c_) { nM = M / BM; nN = N / BM; nwg = nM * nN; G = G_; c = c_; }
    __host__ __device__ bool next(int i, Unit& u) const {
        const long L = (long)i * G + c; if (L >= nwg) return false;
        int wgid = (int)L; { const int q = nwg / NXCD, r = nwg % NXCD, xcd = wgid % NXCD, off = wgid / NXCD; wgid = (xcd < r ? xcd * (q + 1) : r * (q + 1) + (xcd - r) * q) + off; }
        const int nig = WGM * nN, gid = wgid / nig, fm = gid * WGM, gsz = (nM - fm) < WGM ? (nM - fm) : WGM;
        u.pm = fm + ((wgid % nig) % gsz); u.pn = (wgid % nig) / gsz; return true;
    }
    __device__ __forceinline__ void a_ready(const Unit&) const {}
    __device__ __forceinline__ void done(const Unit&) const {}
};
struct CountedOrder : StaticOrder {
    const unsigned* ready; unsigned need; unsigned* tmo;
    __device__ __forceinline__ void a_ready(const Unit& u) const {
        if (threadIdx.x < 64) {
            const unsigned long long t0 = __builtin_amdgcn_s_memrealtime(); unsigned polls = 0;
            while ((unsigned)__builtin_amdgcn_readfirstlane(__hip_atomic_load(ready + 64 * u.pm, __ATOMIC_RELAXED, __HIP_MEMORY_SCOPE_AGENT)) < need) {
                if ((++polls & 255u) == 0u && __builtin_amdgcn_readfirstlane(__hip_atomic_load(tmo, __ATOMIC_RELAXED, __HIP_MEMORY_SCOPE_AGENT)) != 0u) break;
                if (__builtin_amdgcn_s_memrealtime() - t0 > 2000000ull) {
                    if (threadIdx.x == 0) { unsigned expect = 0u; __hip_atomic_compare_exchange_strong(tmo + 1, &expect, 0x600u | (unsigned)(u.pm & 0xff), __ATOMIC_RELAXED, __ATOMIC_RELAXED, __HIP_MEMORY_SCOPE_AGENT); __hip_atomic_store(tmo, 1u, __ATOMIC_RELAXED, __HIP_MEMORY_SCOPE_AGENT); }
                    break; }
                __builtin_amdgcn_s_sleep(2); }
            __builtin_amdgcn_fence(__ATOMIC_ACQUIRE, "agent");
            asm volatile("s_waitcnt vmcnt(0)" ::: "memory");
        }
#if !defined(BROKEN_HOOK_NO_BARRIER)
        asm volatile("" ::: "memory"); __builtin_amdgcn_s_barrier(); asm volatile("" ::: "memory");
#endif
    }
};

__device__ __forceinline__ unsigned cvt_pk_bf16(float lo, float hi) { unsigned r; asm volatile("v_cvt_pk_bf16_f32 %0, %1, %2" : "=v"(r) : "v"(lo), "v"(hi)); return r; }
typedef float f32x2 __attribute__((ext_vector_type(2)));
__device__ __forceinline__ f32x2 gelu_pk(f32x2 v) {
    const f32x2 av = __builtin_elementwise_abs(v), d = av * 0.2316418882f + 1.0f;
    f32x2 t; t.x = __builtin_amdgcn_rcpf(d.x); t.y = __builtin_amdgcn_rcpf(d.y);
    f32x2 q = t * 0.5307027145f + (-0.7265760135f); q = q * t + 0.7107068705f; q = q * t + (-0.142248368f); q = q * t + 0.127414796f; q = q * t;
    const f32x2 s = (v * v) * (-0.72134752044f);
    f32x2 e; e.x = __builtin_amdgcn_exp2f(s.x); e.y = __builtin_amdgcn_exp2f(s.y);
    const f32x2 m = v * (q * e), r = v - m;
    f32x2 o; o.x = v.x < 0.f ? m.x : r.x; o.y = v.y < 0.f ? m.y : r.y; return o;
}

struct EpiF32 {
    static constexpr bool PERM = false, AFTER_DRAIN = false;
    float* C; int ldc; const float* bias;
    __device__ __forceinline__ void operator()(const f32x4 (&acc)[2][2][4][2], const Unit& u, int wr, int wc, int fr, int fq) const {
        const int row0 = u.pm * BM + wr * 64 + fr, col0 = u.pn * BM + wc * 32 + 4 * fq;
        f32x4 bv[2][2];
#pragma unroll
        for (int bj = 0; bj < 2; ++bj)
#pragma unroll
            for (int n = 0; n < 2; ++n) bv[bj][n] = bias ? *(const f32x4*)(bias + col0 + bj * HALF + n * 16) : (f32x4){0.f, 0.f, 0.f, 0.f};
#pragma unroll
        for (int ai = 0; ai < 2; ++ai)
#pragma unroll
            for (int m = 0; m < 4; ++m) { float* rowp = C + (size_t)(row0 + ai * HALF + m * 16) * ldc + col0;
#pragma unroll
                for (int bj = 0; bj < 2; ++bj)
#pragma unroll
                    for (int n = 0; n < 2; ++n) *(f32x4*)(rowp + bj * HALF + n * 16) = acc[ai][bj][m][n] + bv[bj][n]; }
    }
};
template <int ACT  > struct EpiBf16 {
    static constexpr bool PERM = true, AFTER_DRAIN = false;
    bf16_t* O; int ldc; const float* bias; int split_cols; size_t split_stride;
    __device__ __forceinline__ void operator()(const f32x4 (&acc)[2][2][4][2], const Unit& u, int wr, int wc, int fr, int fq) const {
        const int row0 = u.pm * BM + wr * 64 + fr; int colt = u.pn * BM; bf16_t* base = O;
        if (split_cols) { const int t = colt / split_cols; base += (size_t)t * split_stride; colt -= t * split_cols; }
        const int col0 = colt + wc * 32 + 8 * fq, bcol0 = u.pn * BM + wc * 32 + 8 * fq;
        f32x4 bv[2][2];
#pragma unroll
        for (int bj = 0; bj < 2; ++bj)
#pragma unroll
            for (int n = 0; n < 2; ++n) bv[bj][n] = bias ? *(const f32x4*)(bias + bcol0 + bj * HALF + 4 * n) : (f32x4){0.f, 0.f, 0.f, 0.f};
#pragma unroll
        for (int ai = 0; ai < 2; ++ai)
#pragma unroll
            for (int m = 0; m < 4; ++m) { bf16_t* rowp = base + (size_t)(row0 + ai * HALF + m * 16) * ldc + col0;
#pragma unroll
                for (int bj = 0; bj < 2; ++bj) { f32x4 v0 = acc[ai][bj][m][0] + bv[bj][0], v1 = acc[ai][bj][m][1] + bv[bj][1];
                    if (ACT == 1) { f32x2 a = gelu_pk((f32x2){v0[0], v0[1]}), b = gelu_pk((f32x2){v0[2], v0[3]}), c = gelu_pk((f32x2){v1[0], v1[1]}), d = gelu_pk((f32x2){v1[2], v1[3]});
                        v0 = (f32x4){a.x, a.y, b.x, b.y}; v1 = (f32x4){c.x, c.y, d.x, d.y}; }
                    if (ACT == 2) {
#pragma unroll
                        for (int j = 0; j < 4; ++j) { v0[j] = 0.5f * v0[j] * (1.0f + erff(v0[j] * 0.70710678f)); v1[j] = 0.5f * v1[j] * (1.0f + erff(v1[j] * 0.70710678f)); } }
                    u32x4 w; w.x = cvt_pk_bf16(v0[0], v0[1]); w.y = cvt_pk_bf16(v0[2], v0[3]); w.z = cvt_pk_bf16(v1[0], v1[1]); w.w = cvt_pk_bf16(v1[2], v1[3]);
                    *(u32x4*)(rowp + bj * HALF) = w; } }
    }
};
template <class Epi, class Sched, bool STAMP = false>
__device__ __forceinline__ void gemm_phase(PG8_LAS unsigned char* lds, const Gemm g, const Sched& S, const Epi& E, unsigned long long* stamps) {
    int tid_raw = threadIdx.x; asm volatile("" : "+v"(tid_raw)); const int tid = tid_raw, wid = __builtin_amdgcn_readfirstlane(tid >> 6), lane = tid & 63, wr = wid >> 2, wc = wid & 3, fr = lane & 15, fq = lane >> 4;
    const int K = g.K, nt = K / BK;
    int ts_lo = 0, ts_hi = 0, nts = 0; const unsigned long long rt_entry = STAMP ? (unsigned long long)wall_clock64() : 0ull;
#define PG8_STAMP() do { if (STAMP && wid == 0 && nts < 64) { const unsigned long long _c = (unsigned long long)clock64(); \
        ts_lo = (lane == nts) ? (int)(unsigned)_c : ts_lo; ts_hi = (lane == nts) ? (int)(unsigned)(_c >> 32) : ts_hi; ++nts; } } while (0)
    PG8_STAMP();
    unsigned voffA[2], voffB[2];
#pragma unroll
    for (int i = 0; i < 2; ++i) { int R, C; stage_rc(tid * 16 + i * 8192, R, C); const int Rb = Epi::PERM ? ((R & ~31) + perm32(R & 31)) : R;
        voffA[i] = (unsigned)(R * K + C) * 2u; voffB[i] = (unsigned)(Rb * K + C) * 2u; }
    const size_t kstep = (size_t)(BK * 2);
    const size_t hstep = (size_t)HALF * K * 2;
    const size_t tstep = 2 * hstep;
    const unsigned ldsw = (unsigned)wid * 1024u;
    const int aoff = lds_byte(wr * 64 + fr, fq * 8), boff = lds_byte(wc * 32 + fr, fq * 8);
#define PG8_SA(b, h) (((b) * 2 + (h)) * HTB)
#define PG8_SB(b, h) ((4 + (b) * 2 + (h)) * HTB)
#define PG8_STAGE(bufoff, gbase, voff) do { _Pragma("unroll") for (int _i = 0; _i < 2; ++_i) \
        __builtin_amdgcn_global_load_lds((const unsigned*)((const char*)(gbase) + (voff)[_i]), (PG8_LAS unsigned*)(lds + (bufoff) + ldsw + _i * 8192), 16, 0, 0); } while (0)
#define PG8_LDA(dst, b, h) do { _Pragma("unroll") for (int m = 0; m < 4; ++m) _Pragma("unroll") for (int k = 0; k < 2; ++k) dst[m][k] = *(const PG8_LAS bf16x8*)(lds + PG8_SA(b, h) + aoff + m * 2048 + k * 1024); } while (0)
#define PG8_LDB(dst, b, h) do { _Pragma("unroll") for (int n = 0; n < 2; ++n) _Pragma("unroll") for (int k = 0; k < 2; ++k) dst[n][k] = *(const PG8_LAS bf16x8*)(lds + PG8_SB(b, h) + boff + n * 2048 + k * 1024); } while (0)
#define PG8_MMA(ai, bj, At, Bt) do { __builtin_amdgcn_s_setprio(1); _Pragma("unroll") for (int m = 0; m < 4; ++m) _Pragma("unroll") for (int n = 0; n < 2; ++n) _Pragma("unroll") for (int k = 0; k < 2; ++k) \
        acc[ai][bj][m][n] = __builtin_amdgcn_mfma_f32_16x16x32_bf16(Bt[n][k], At[m][k], acc[ai][bj][m][n], 0, 0, 0); __builtin_amdgcn_s_setprio(0); } while (0)
#define PG8_WAIT_V(n) asm volatile("s_waitcnt vmcnt(" #n ")" ::: "memory")
#define PG8_WAIT_L(n) asm volatile("s_waitcnt lgkmcnt(" #n ")" ::: "memory")
#define PG8_BAR __builtin_amdgcn_s_barrier()
#define PG8_SCHED __builtin_amdgcn_sched_barrier(0)
    Unit cur, nxt; int ui = 0;
    if (!S.next(0, cur)) return;
    f32x4 acc[2][2][4][2];
#pragma unroll
    for (int a = 0; a < 2; ++a)
#pragma unroll
        for (int b = 0; b < 2; ++b)
#pragma unroll
            for (int m = 0; m < 4; ++m)
#pragma unroll
                for (int n = 0; n < 2; ++n) acc[a][b][m][n] = (f32x4){0.f, 0.f, 0.f, 0.f};
    bf16x8 At[4][2], B0[2][2], B1[2][2];
    const char* cA = (const char*)g.A + (size_t)cur.pm * tstep; const char* cB = (const char*)g.Bt + (size_t)cur.pn * tstep;
    S.a_ready(cur);
    PG8_STAGE(PG8_SB(0, 0), cB, voffB); PG8_STAGE(PG8_SA(0, 0), cA, voffA); PG8_STAGE(PG8_SB(0, 1), cB + hstep, voffB); PG8_STAGE(PG8_SA(0, 1), cA + hstep, voffA);
    if (wr == 1) PG8_BAR;
    PG8_WAIT_V(4); PG8_BAR;
    PG8_STAGE(PG8_SB(1, 0), cB + kstep, voffB); PG8_STAGE(PG8_SA(1, 0), cA + kstep, voffA); PG8_STAGE(PG8_SB(1, 1), cB + hstep + kstep, voffB);
    PG8_WAIT_V(6); PG8_BAR;
    PG8_STAMP();
    for (;;) {
        const bool has_next = S.next(ui + 1, nxt);
        const char* nA = has_next ? (const char*)g.A + (size_t)nxt.pm * tstep : cA; const char* nB = has_next ? (const char*)g.Bt + (size_t)nxt.pn * tstep : cB;
        for (int t = 0; t < nt; t += 2) {
            const bool last = (t == nt - 2);
            const char* a1 = cA + (size_t)(t + 1) * kstep;
            const char* a2 = last ? nA : cA + (size_t)(t + 2) * kstep; const char* b2 = last ? nB : cB + (size_t)(t + 2) * kstep;
            const char* a3 = a2 + kstep; const char* b3 = b2 + kstep;
            if (last && has_next) S.a_ready(nxt);
            PG8_LDB(B0, 0, 0); PG8_SCHED; PG8_LDA(At, 0, 0); PG8_STAGE(PG8_SA(1, 1), a1 + hstep, voffA);
            PG8_WAIT_L(8); PG8_BAR; PG8_WAIT_L(0); PG8_MMA(0, 0, At, B0); PG8_BAR; PG8_SCHED;
            PG8_LDB(B1, 0, 1); PG8_STAGE(PG8_SB(0, 0), b2, voffB);
            PG8_BAR; PG8_WAIT_L(0); PG8_MMA(0, 1, At, B1); PG8_BAR;
            PG8_LDA(At, 0, 1); PG8_STAGE(PG8_SA(0, 0), a2, voffA);
            PG8_BAR; PG8_WAIT_L(0); PG8_MMA(1, 0, At, B0); PG8_BAR; PG8_SCHED;
            PG8_STAGE(PG8_SB(0, 1), b2 + hstep, voffB);
            PG8_WAIT_V(6); PG8_BAR; PG8_MMA(1, 1, At, B1); PG8_BAR;
            PG8_LDB(B0, 1, 0); PG8_SCHED; PG8_LDA(At, 1, 0); PG8_STAGE(PG8_SA(0, 1), a2 + hstep, voffA);
            PG8_WAIT_L(8); PG8_BAR; PG8_WAIT_L(0); PG8_MMA(0, 0, At, B0); PG8_BAR; PG8_SCHED;
            PG8_LDB(B1, 1, 1); PG8_STAGE(PG8_SB(1, 0), b3, voffB);
            PG8_BAR; PG8_WAIT_L(0); PG8_MMA(0, 1, At, B1); PG8_BAR;
            PG8_LDA(At, 1, 1); PG8_STAGE(PG8_SA(1, 0), a3, voffA);
            PG8_BAR; PG8_WAIT_L(0); PG8_MMA(1, 0, At, B0); PG8_BAR; PG8_SCHED;
            PG8_STAGE(PG8_SB(1, 1), b3 + hstep, voffB);
            PG8_WAIT_V(6); PG8_BAR; PG8_MMA(1, 1, At, B1); PG8_BAR;
        }
        PG8_STAMP();
        if constexpr (!Epi::AFTER_DRAIN) { E(acc, cur, wr, wc, fr, fq); S.done(cur); }
        PG8_STAMP();
        if (!has_next) break;
#pragma unroll
        for (int a = 0; a < 2; ++a)
#pragma unroll
            for (int b = 0; b < 2; ++b)
#pragma unroll
                for (int m = 0; m < 4; ++m)
#pragma unroll
                    for (int n = 0; n < 2; ++n) acc[a][b][m][n] = (f32x4){0.f, 0.f, 0.f, 0.f};
        cur = nxt; cA = nA; cB = nB; ++ui;
    }
    PG8_WAIT_V(0);
    if (wr == 0) PG8_BAR;
    PG8_BAR;
    if constexpr (Epi::AFTER_DRAIN) { E.fused(acc, cur, wr, wc, fr, fq, lds, wid, lane); S.done(cur); }
    PG8_STAMP();
    if (STAMP && wid == 0) { stamps[lane] = lane < nts ? (((unsigned long long)(unsigned)ts_hi << 32) | (unsigned)ts_lo) : 0ull;
        if (lane == 62) stamps[62] = rt_entry; if (lane == 63) stamps[63] = (unsigned long long)wall_clock64(); }
#undef PG8_STAMP
#undef PG8_SA
#undef PG8_SB
#undef PG8_STAGE
#undef PG8_LDA
#undef PG8_LDB
#undef PG8_MMA
#undef PG8_WAIT_V
#undef PG8_WAIT_L
#undef PG8_BAR
#undef PG8_SCHED
}
}

#define DI __device__ __forceinline__
using pg8::bf16_t; using pg8::bf16x8; using pg8::f32x4; using pg8::u32x4;
typedef short s16x4 __attribute__((ext_vector_type(4)));
typedef float f32x16 __attribute__((ext_vector_type(16)));
typedef unsigned u32x2 __attribute__((ext_vector_type(2)));
typedef __bf16 bf2_t __attribute__((ext_vector_type(2)));
typedef float f32x2_t __attribute__((ext_vector_type(2)));
typedef PG8_LAS unsigned char* lds_ptr;

constexpr int D = 1024, NLAT = 32768, NCTX = 512, R = NLAT + NCTX, SEQ = 16384, CTXL = 256, DEPTH = 4;
constexpr int DIN = 1696, DINP = 1792;
constexpr int C_SWA_Q = 256, C_MLA_CQ = 512, C_SGU = 768, C_SWA_K = 1280, C_SWA_V = 1408, C_MLA_CKV = 1536, C_MLA_KR = 1664;
constexpr float EPS = 1e-6f;
constexpr float DN_ALPHA = 1.681792830507429f;
constexpr float LOG2E = 1.4426950408889634f;
constexpr int LDS_BYTES = 131072;
constexpr int LDS_ALLOC = LDS_BYTES + 16;

constexpr size_t W_IN = 0;
constexpr size_t W_OUT = W_IN + (size_t)DINP * 1024 * 2;
constexpr size_t W_FF1 = W_OUT + (size_t)1024 * 1024 * 2;
constexpr size_t W_FF2 = W_FF1 + (size_t)4096 * 1024 * 2;
constexpr size_t W_UQ = W_FF2 + (size_t)4096 * 1024 * 2;
constexpr size_t W_UKV = W_UQ + (size_t)512 * 256 * 2;
constexpr size_t W_POOL = W_UKV + (size_t)512 * 256 * 2;
constexpr size_t W_SGU = W_POOL + (size_t)256 * 256 * 2;
constexpr size_t WS_MOD = W_SGU + (size_t)4 * 128 * 128 * 2;
constexpr size_t WS_TAB = WS_MOD + (size_t)DEPTH * 3 * 6144 * 4;
constexpr size_t WS_X = WS_TAB + (size_t)(320 * 16 + 320 * 8) * 8;
constexpr size_t WS_U = WS_X + (size_t)R * 1024 * 4;
constexpr size_t U_Z = 0;
constexpr size_t U_QRAW = U_Z + (size_t)R * DINP * 2;
constexpr size_t U_KVRAW = U_QRAW + (size_t)R * 512 * 2;
constexpr size_t U_CQN = U_KVRAW + (size_t)R * 512 * 2;
constexpr size_t U_CKVN = U_CQN + (size_t)R * 256 * 2;
constexpr size_t U_DPOOL = U_CKVN + (size_t)R * 256 * 2;
constexpr size_t U_UG = U_DPOOL + (size_t)R * 256 * 2;
constexpr size_t U_VG = U_UG + (size_t)R * 256 * 2;
constexpr size_t U_F1 = 0;
constexpr size_t U_H = (size_t)R * 4096 * 2;
constexpr size_t U_YCAT = U_H;
constexpr size_t WS_KSR = WS_U + U_H + (size_t)R * 1024 * 2;
constexpr size_t WS_KRR = WS_KSR + (size_t)R * 128 * 2;
constexpr size_t WS_BAR = WS_KRR + (size_t)R * 32 * 2;
constexpr size_t WS_END = WS_BAR + 16384;
static_assert(U_VG + (size_t)R * 256 * 2 == U_H, "mixer-mode buffers must exactly fill the f1 slot");
static_assert(WS_END <= (size_t)536870912, "workspace too large");
static_assert(WS_X % 256 == 0 && WS_U % 256 == 0 && WS_MOD % 256 == 0 && WS_TAB % 256 == 0, "alignment");

struct Params { const float* in[25]; float* out; unsigned char* ws; };
DI int tid_() { int t = threadIdx.x; asm volatile("" : "+v"(t)); return t; }
DI int bid_() { int t = blockIdx.x; asm volatile("" : "+s"(t)); return t; }
DI int nblk_() { int t = gridDim.x; asm volatile("" : "+s"(t)); return t; }
DI const Params& params_() { auto k = __builtin_amdgcn_kernarg_segment_ptr(); asm volatile("" : "+s"(k)); return *(const Params*)k; }


DI float bf2f(bf16_t b) { return __uint_as_float(((unsigned)b) << 16); }
DI unsigned pk2(float a, float b) { f32x2_t v = {a, b}; bf2_t r = __builtin_convertvector(v, bf2_t); return __builtin_bit_cast(unsigned, r); }
DI bf16_t f2bf(float a) { return (bf16_t)(pk2(a, 0.f) & 0xffffu); }
DI float lo_f(unsigned u) { return __uint_as_float(u << 16); }
DI float hi_f(unsigned u) { return __uint_as_float(u & 0xffff0000u); }
DI float wsum(float v) {
#pragma unroll
    for (int m = 32; m >= 1; m >>= 1) v += __shfl_xor(v, m);
    return v;
}
DI float max3f(float a, float b, float c) { float r; asm("v_max3_f32 %0, %1, %2, %3" : "=v"(r) : "v"(a), "v"(b), "v"(c)); return r; }
DI int crow16(int i, int h) { return (i & 3) + 8 * (i >> 2) + 4 * h; }
#define MFMA32(a, b, c) __builtin_amdgcn_mfma_f32_32x32x16_bf16((a), (b), (c), 0, 0, 0)
DI bf16x8 tr_pair(lds_ptr lo_addr, int hi_delta) {
    const s16x4 lo = __builtin_amdgcn_ds_read_tr16_b64_v4i16((PG8_LAS s16x4*)lo_addr);
    const s16x4 hi = __builtin_amdgcn_ds_read_tr16_b64_v4i16((PG8_LAS s16x4*)(lo_addr + hi_delta));
    return __builtin_shufflevector(lo, hi, 0, 1, 2, 3, 4, 5, 6, 7);
}

struct EpiScaleBf16 {
    static constexpr bool PERM = true, AFTER_DRAIN = false;
    bf16_t* O; const float* modl; int idx;
    DI void operator()(const f32x4 (&acc)[2][2][4][2], const pg8::Unit& u, int wr, int wc, int fr, int fq) const {
        const int row0 = u.pm * 256 + wr * 64 + fr, col0 = u.pn * 256 + wc * 32 + 8 * fq;
        const int set = (u.pm < 64) ? 0 : (u.pm < 128 ? 1 : 2);
        const float* mp = modl + set * 6144 + idx * 1024 + col0;
        f32x4 mv[2][2];
#pragma unroll
        for (int bj = 0; bj < 2; ++bj)
#pragma unroll
            for (int n = 0; n < 2; ++n) mv[bj][n] = *(const f32x4*)(mp + bj * 128 + 4 * n);
#pragma unroll
        for (int ai = 0; ai < 2; ++ai)
#pragma unroll
            for (int m = 0; m < 4; ++m) {
                bf16_t* rowp = O + (size_t)(row0 + ai * 128 + m * 16) * 1024 + col0;
#pragma unroll
                for (int bj = 0; bj < 2; ++bj) {
                    const f32x4 v0 = acc[ai][bj][m][0] * mv[bj][0], v1 = acc[ai][bj][m][1] * mv[bj][1];
                    u32x4 w; w.x = pk2(v0[0], v0[1]); w.y = pk2(v0[2], v0[3]); w.z = pk2(v1[0], v1[1]); w.w = pk2(v1[2], v1[3]);
                    *(u32x4*)(rowp + bj * 128) = w;
                }
            }
    }
};
struct EpiRelu2 {
    static constexpr bool PERM = true, AFTER_DRAIN = false;
    bf16_t* O; int ldc;
    DI void operator()(const f32x4 (&acc)[2][2][4][2], const pg8::Unit& u, int wr, int wc, int fr, int fq) const {
        const int row0 = u.pm * 256 + wr * 64 + fr, col0 = u.pn * 256 + wc * 32 + 8 * fq;
#pragma unroll
        for (int ai = 0; ai < 2; ++ai)
#pragma unroll
            for (int m = 0; m < 4; ++m) {
                bf16_t* rowp = O + (size_t)(row0 + ai * 128 + m * 16) * ldc + col0;
#pragma unroll
                for (int bj = 0; bj < 2; ++bj) {
                    f32x4 v0 = acc[ai][bj][m][0], v1 = acc[ai][bj][m][1];
#pragma unroll
                    for (int j = 0; j < 4; ++j) { const float a = fmaxf(v0[j], 0.f), b = fmaxf(v1[j], 0.f); v0[j] = a * a; v1[j] = b * b; }
                    u32x4 w; w.x = pk2(v0[0], v0[1]); w.y = pk2(v0[2], v0[3]); w.z = pk2(v1[0], v1[1]); w.w = pk2(v1[2], v1[3]);
                    *(u32x4*)(rowp + bj * 128) = w;
                }
            }
    }
};

template <class Epi>
DI void run_gemm(lds_ptr lds3, const bf16_t* A, const bf16_t* Bt, int M, int N, int K, const Epi& E, int crot = 0) {
    pg8::Gemm g; g.A = A; g.Bt = Bt; g.M = M; g.N = N; g.K = K;
    const int G = nblk_(); int c = bid_() + crot; if (c >= G) c -= G;
    pg8::StaticOrder S; S.init(M, N, G, c);
    pg8::gemm_phase<Epi, pg8::StaticOrder, false>(lds3, g, S, E, nullptr);
}

DI void phase_adaln(const Params& p, float* lf) {
    for (int i = tid_(); i < 3072; i += 512) {
        const int s = i >> 10, k = i & 1023;
        const float v = (s < 2) ? p.in[1][s * 1024 + k] : p.in[3][k];
        lf[i] = v / (1.f + expf(-v));
    }
    __syncthreads();
    float* red = lf + 3072;
    const int wid = tid_() >> 6, lane = tid_() & 63;
    float* mod = (float*)(p.ws + WS_MOD);
    for (int item = bid_(); item < DEPTH * 96; item += nblk_()) {
        const int l = item / 96, jc = (item % 96) * 64;
        const float* w = p.in[4] + (size_t)l * 1024 * 6144 + jc + lane;
        float a0 = 0.f, a1 = 0.f, a2 = 0.f;
        const int i0 = wid * 128;
#pragma unroll 32
        for (int i = 0; i < 128; ++i) {
            const float wv = w[(size_t)(i0 + i) * 6144];
            a0 += lf[i0 + i] * wv; a1 += lf[1024 + i0 + i] * wv; a2 += lf[2048 + i0 + i] * wv;
        }
        red[(wid * 3 + 0) * 64 + lane] = a0; red[(wid * 3 + 1) * 64 + lane] = a1; red[(wid * 3 + 2) * 64 + lane] = a2;
        __syncthreads();
        if (tid_() < 192) {
            const int s = tid_() >> 6;
            float sum = 0.f;
#pragma unroll
            for (int w8 = 0; w8 < 8; ++w8) sum += red[(w8 * 3 + s) * 64 + lane];
            mod[((size_t)l * 3 + s) * 6144 + jc + lane] = sum + p.in[5][l * 6144 + jc + lane];
        }
        __syncthreads();
    }
}

DI void phase_tables(const Params& p) {
    float2* tS = (float2*)(p.ws + WS_TAB);
    float2* tM = tS + 320 * 16;
    const int gtid = bid_() * 512 + tid_(), gsz = nblk_() * 512;
    const float L2B = 13.287712379549449f;
    for (int i = gtid; i < 320 * 16 + 320 * 8; i += gsz) {
        int pos, f; float inv;
        if (i < 320 * 16) { pos = i >> 4; f = i & 15; inv = exp2f(-(float)(2 * f) * (1.f / 32.f) * L2B); }
        else { const int k = i - 320 * 16; pos = k >> 3; f = k & 7; inv = exp2f(-(float)(2 * f) * (1.f / 16.f) * L2B); }
        const float ang = (float)(pos < 256 ? pos : pos - 256) * inv;
        const double ad = (double)ang;
        const double kk = __builtin_rint(ad * 0.15915494309189535);
        const float rr = (float)(ad - kk * 6.283185307179586);
        tS[i] = make_float2(__cosf(rr), __sinf(rr));
    }
}

struct ConvJob { const float* src; bf16_t* dst; int K, N, KP, tk, tn; };
DI void conv_load(const ConvJob& c, int t, float4 (&v)[2]) {
#pragma unroll
    for (int rep = 0; rep < 2; ++rep) {
        const int k = c.tk * 64 + rep * 32 + (t >> 4), n = c.tn * 64 + (t & 15) * 4;
        v[rep] = make_float4(0.f, 0.f, 0.f, 0.f);
        if (k < c.K && n < c.N) v[rep] = *(const float4*)(c.src + (size_t)k * c.N + n);
    }
}
DI void conv_store(const ConvJob& c, int t, const float4 (&v)[2], bf16_t* tile) {
#pragma unroll
    for (int rep = 0; rep < 2; ++rep) {
        const int kl = rep * 32 + (t >> 4), nl = (t & 15) * 4;
        tile[(nl + 0) * 72 + kl] = f2bf(v[rep].x); tile[(nl + 1) * 72 + kl] = f2bf(v[rep].y);
        tile[(nl + 2) * 72 + kl] = f2bf(v[rep].z); tile[(nl + 3) * 72 + kl] = f2bf(v[rep].w);
    }
    __syncthreads();
    {
        const int nl = t >> 3, kl = (t & 7) * 8;
        const u32x4 w = *(const u32x4*)(tile + nl * 72 + kl);
        *(u32x4*)(c.dst + (size_t)(c.tn * 64 + nl) * c.KP + c.tk * 64 + kl) = w;
    }
    __syncthreads();
}

DI void convert_layer(const Params& p, int l, unsigned char* smem) {
    bf16_t* tile = (bf16_t*)smem;
    constexpr int T_IN = 16 * 28, T_OUT = 16 * 16, T_FF1 = 16 * 64, T_FF2 = 64 * 16, T_UQ = 4 * 8, T_UKV = 4 * 8;
    constexpr int T_ALL = T_IN + T_OUT + T_FF1 + T_FF2 + T_UQ + T_UKV;
    auto decode = [&](int t) {
        ConvJob c; int NT; size_t off; int tt = t;
        if (tt < T_IN) { c.src = p.in[6] + (size_t)l * 1024 * DIN; c.K = 1024; c.N = DIN; c.KP = 1024; NT = 28; off = W_IN; }
        else if ((tt -= T_IN) < T_OUT) { c.src = p.in[18] + (size_t)l * 1024 * 1024; c.K = 1024; c.N = 1024; c.KP = 1024; NT = 16; off = W_OUT; }
        else if ((tt -= T_OUT) < T_FF1) { c.src = p.in[21] + (size_t)l * 1024 * 4096; c.K = 1024; c.N = 4096; c.KP = 1024; NT = 64; off = W_FF1; }
        else if ((tt -= T_FF1) < T_FF2) { c.src = p.in[22] + (size_t)l * 4096 * 1024; c.K = 4096; c.N = 1024; c.KP = 4096; NT = 16; off = W_FF2; }
        else if ((tt -= T_FF2) < T_UQ) { c.src = p.in[11] + (size_t)l * 256 * 384; c.K = 256; c.N = 384; c.KP = 256; NT = 8; off = W_UQ; }
        else { tt -= T_UQ; c.src = p.in[13] + (size_t)l * 128 * 512; c.K = 128; c.N = 512; c.KP = 256; NT = 8; off = W_UKV; }
        c.dst = (bf16_t*)(p.ws + off); c.tk = tt / NT; c.tn = tt % NT;
        return c;
    };
    {
        const int t = tid_(), G = nblk_();
        int tix = bid_();
        float4 cur[2], nxt[2];
        if (tix < T_ALL) conv_load(decode(tix), t, cur);
        for (; tix < T_ALL; tix += G) {
            const bool more = tix + G < T_ALL;
            if (more) conv_load(decode(tix + G), t, nxt);
            conv_store(decode(tix), t, cur, tile);
            cur[0] = nxt[0]; cur[1] = nxt[1];
        }
    }
    const int gtid = bid_() * 512 + tid_(), gsz = nblk_() * 512;
    {
        bf16_t* dst = (bf16_t*)(p.ws + W_POOL);
        const float* pw = p.in[7] + (size_t)l * 4 * 64 * 64; const float* ps = p.in[8] + l * 256;
        for (int i = gtid; i < 65536; i += gsz) {
            const int row = i >> 8, col = i & 255, g = row >> 6, e = row & 63;
            float v = 0.f;
            if ((col >> 6) == g) v = pw[(g * 64 + (col & 63)) * 64 + e] * ps[row];
            dst[i] = f2bf(v);
        }
    }
    {
        bf16_t* dst = (bf16_t*)(p.ws + W_SGU);
        const float* sw = p.in[16] + (size_t)l * 65536;
        for (int i = gtid; i < 65536; i += gsz) dst[i] = f2bf(sw[i]);
    }
}

DI void wsum4(float& a, float& b, float& c, float& d) {
#pragma unroll
    for (int m = 32; m >= 1; m >>= 1) {
        const float ta = __shfl_xor(a, m), tb = __shfl_xor(b, m), tc = __shfl_xor(c, m), td = __shfl_xor(d, m);
        a += ta; b += tb; c += tc; d += td;
    }
}
DI void row_stats(const float4 (&v)[4], float& s, float& q) {
    s = 0.f; q = 0.f;
#pragma unroll
    for (int j = 0; j < 4; ++j) { s += v[j].x + v[j].y + v[j].z + v[j].w; q += v[j].x * v[j].x + v[j].y * v[j].y + v[j].z * v[j].z + v[j].w * v[j].w; }
}
DI void phase_ln(const Params& p, int mode, const float* g, const float* b, const float* modl, int i0, const bf16_t* Y = nullptr, int rlimit = R) {
    const int wid = tid_() >> 6, lane = tid_() & 63;
    bf16_t* XL = (bf16_t*)(p.ws + WS_X);
    float* XC = (float*)(p.ws + WS_X + (size_t)NLAT * 1024 * 2);
    bf16_t* H = (bf16_t*)(p.ws + WS_U + U_H);
    const int rmax = (mode == 2) ? NLAT : rlimit;
    const int rstride = nblk_() * 8;
    for (int ra = bid_() * 8 + wid; ra < rmax; ra += 2 * rstride) {
        const bool has_b = ra + rstride < rmax;
        const int rb = has_b ? ra + rstride : ra;
        float4 v[2][4];
#pragma unroll
        for (int k = 0; k < 2; ++k) {
            const int r = k ? rb : ra;
            if (mode != 0 && r < NLAT) {
#pragma unroll
                for (int j = 0; j < 4; ++j) {
                    const u32x2 w = *(const u32x2*)(XL + (size_t)r * 1024 + 4 * lane + 256 * j);
                    v[k][j] = make_float4(lo_f(w.x), hi_f(w.x), lo_f(w.y), hi_f(w.y));
                }
            } else {
                const float* src;
                if (mode == 0) src = (r < NLAT) ? p.in[0] + (size_t)r * 1024 : p.in[2] + (size_t)(r - NLAT) * 1024;
                else src = XC + (size_t)(r - NLAT) * 1024;
#pragma unroll
                for (int j = 0; j < 4; ++j) v[k][j] = *(const float4*)(src + 4 * lane + 256 * j);
            }
        }
        if (mode != 0) {
#pragma unroll
            for (int k = 0; k < 2; ++k) {
                const int r = k ? rb : ra;
                {
#pragma unroll
                    for (int j = 0; j < 4; ++j) {
                        const u32x2 yw = *(const u32x2*)(Y + (size_t)r * 1024 + 4 * lane + 256 * j);
                        v[k][j].x = v[k][j].x * DN_ALPHA + lo_f(yw.x); v[k][j].y = v[k][j].y * DN_ALPHA + hi_f(yw.x);
                        v[k][j].z = v[k][j].z * DN_ALPHA + lo_f(yw.y); v[k][j].w = v[k][j].w * DN_ALPHA + hi_f(yw.y);
                    }
                }
            }
            float s0, q0, s1, q1;
            row_stats(v[0], s0, q0); row_stats(v[1], s1, q1);
            wsum4(s0, q0, s1, q1);
#pragma unroll
            for (int k = 0; k < 2; ++k) {
                const float mu = (k ? s1 : s0) * (1.f / 1024.f);
                const float rs = rsqrtf(fmaxf((k ? q1 : q0) * (1.f / 1024.f) - mu * mu, 0.f) + EPS);
#pragma unroll
                for (int j = 0; j < 4; ++j) {
                    const float4 gg = *(const float4*)(g + 4 * lane + 256 * j), bb = *(const float4*)(b + 4 * lane + 256 * j);
                    v[k][j].x = (v[k][j].x - mu) * rs * gg.x + bb.x; v[k][j].y = (v[k][j].y - mu) * rs * gg.y + bb.y;
                    v[k][j].z = (v[k][j].z - mu) * rs * gg.z + bb.z; v[k][j].w = (v[k][j].w - mu) * rs * gg.w + bb.w;
                }
            }
        }
#pragma unroll
        for (int k = 0; k < 2; ++k) {
            const int r = k ? rb : ra;
            if (k == 0 || has_b) {
                if (mode != 2 && r < NLAT) {
#pragma unroll
                    for (int j = 0; j < 4; ++j) { u32x2 o; o.x = pk2(v[k][j].x, v[k][j].y); o.y = pk2(v[k][j].z, v[k][j].w); *(u32x2*)(XL + (size_t)r * 1024 + 4 * lane + 256 * j) = o; }
                } else {
                    float* dstx = (mode == 2) ? p.out + (size_t)r * 1024 : XC + (size_t)(r - NLAT) * 1024;
#pragma unroll
                    for (int j = 0; j < 4; ++j) *(float4*)(dstx + 4 * lane + 256 * j) = v[k][j];
                }
            }
        }
        if (mode != 2) {
            float s0, q0, s1, q1;
            row_stats(v[0], s0, q0); row_stats(v[1], s1, q1);
            wsum4(s0, q0, s1, q1);
#pragma unroll
            for (int k = 0; k < 2; ++k) {
                const int r = k ? rb : ra;
                if (k == 0 || has_b) {
                    const float mu = (k ? s1 : s0) * (1.f / 1024.f);
                    const float rs = rsqrtf(fmaxf((k ? q1 : q0) * (1.f / 1024.f) - mu * mu, 0.f) + EPS);
                    const int set = (r < SEQ) ? 0 : (r < NLAT ? 1 : 2);
                    const float* msh = modl + set * 6144 + i0 * 1024, *msc = msh + 1024;
#pragma unroll
                    for (int j = 0; j < 4; ++j) {
                        const float4 sh = *(const float4*)(msh + 4 * lane + 256 * j), sc = *(const float4*)(msc + 4 * lane + 256 * j);
                        u32x2 o;
                        o.x = pk2((v[k][j].x - mu) * rs * (1.f + sc.x) + sh.x, (v[k][j].y - mu) * rs * (1.f + sc.y) + sh.y);
                        o.y = pk2((v[k][j].z - mu) * rs * (1.f + sc.z) + sh.z, (v[k][j].w - mu) * rs * (1.f + sc.w) + sh.w);
                        *(u32x2*)(H + (size_t)r * 1024 + 4 * lane + 256 * j) = o;
                    }
                }
            }
        }
    }
}

DI float gelu_exact(float x) { return 0.5f * x * (1.f + erff(x * 0.70710678118654752f)); }

DI void phase_postz(const Params& p, int l) {
    const int wid = tid_() >> 6, lane = tid_() & 63;
    unsigned char* U = p.ws + WS_U;
    const bf16_t* Z = (const bf16_t*)(U + U_Z);
    bf16_t* KSR = (bf16_t*)(p.ws + WS_KSR); bf16_t* KRR = (bf16_t*)(p.ws + WS_KRR);
    bf16_t* CQN = (bf16_t*)(U + U_CQN); bf16_t* CKVN = (bf16_t*)(U + U_CKVN); bf16_t* DPOOL = (bf16_t*)(U + U_DPOOL);
    bf16_t* UG = (bf16_t*)(U + U_UG); bf16_t* VG = (bf16_t*)(U + U_VG);
    const float2* tS = (const float2*)(p.ws + WS_TAB); const float2* tM = tS + 320 * 16;
    const float* gq = p.in[10] + l * 256; const float* gkv = p.in[12] + l * 128;
    const float* sg = p.in[14] + l * 256; const float* sb = p.in[15] + l * 256;
    for (int r = bid_() * 8 + wid; r < R; r += nblk_() * 8) {
        const bf16_t* zr = Z + (size_t)r * DINP;
        const bool lat = r < NLAT;
        const int t = r & (SEQ - 1), rp = t >> 6, cp = t & 63;
        {
            const int hd = lane >> 5, pp = lane & 31, i = pp & 15, off = hd * 64 + ((pp & 16) ? 32 : 0);
            const float x1 = bf2f(zr[C_SWA_K + off + i]), x2 = bf2f(zr[C_SWA_K + off + 16 + i]);
            float o1 = x1, o2 = x2;
            if (lat) { const float2 cs = (pp & 16) ? tS[(256 + cp) * 16 + i] : tS[rp * 16 + i]; o1 = x1 * cs.x - x2 * cs.y; o2 = x2 * cs.x + x1 * cs.y; }
            KSR[(size_t)r * 128 + off + i] = f2bf(o1); KSR[(size_t)r * 128 + off + 16 + i] = f2bf(o2);
        }
        if (lane < 16) {
            const int i = lane & 7, off = (lane & 8) ? 16 : 0;
            const float x1 = bf2f(zr[C_MLA_KR + off + i]), x2 = bf2f(zr[C_MLA_KR + off + 8 + i]);
            float o1 = x1, o2 = x2;
            if (lat) { const float2 cs = (lane & 8) ? tM[(256 + cp) * 8 + i] : tM[rp * 8 + i]; o1 = x1 * cs.x - x2 * cs.y; o2 = x2 * cs.x + x1 * cs.y; }
            KRR[(size_t)r * 32 + off + i] = f2bf(o1); KRR[(size_t)r * 32 + off + 8 + i] = f2bf(o2);
        }
        {
            const u32x2 w = *(const u32x2*)(zr + C_MLA_CQ + 4 * lane);
            const float a0 = lo_f(w.x), a1 = hi_f(w.x), a2 = lo_f(w.y), a3 = hi_f(w.y);
            const float rs = rsqrtf(wsum(a0 * a0 + a1 * a1 + a2 * a2 + a3 * a3) * (1.f / 256.f) + EPS);
            const float4 gg = *(const float4*)(gq + 4 * lane);
            u32x2 o; o.x = pk2(a0 * rs * gg.x, a1 * rs * gg.y); o.y = pk2(a2 * rs * gg.z, a3 * rs * gg.w);
            *(u32x2*)(CQN + (size_t)r * 256 + 4 * lane) = o;
        }
        {
            const unsigned w = *(const unsigned*)(zr + C_MLA_CKV + 2 * lane);
            const float a0 = lo_f(w), a1 = hi_f(w);
            const float rs = rsqrtf(wsum(a0 * a0 + a1 * a1) * (1.f / 128.f) + EPS);
            const float2 gg = *(const float2*)(gkv + 2 * lane);
            *(unsigned*)(CKVN + (size_t)r * 256 + 2 * lane) = pk2(a0 * rs * gg.x, a1 * rs * gg.y);
            *(unsigned*)(CKVN + (size_t)r * 256 + 128 + 2 * lane) = 0u;
        }
        {
            const u32x2 wu = *(const u32x2*)(zr + C_SGU + 4 * lane);
            const pg8::f32x2 gu0 = pg8::gelu_pk((pg8::f32x2){lo_f(wu.x), hi_f(wu.x)}), gu1 = pg8::gelu_pk((pg8::f32x2){lo_f(wu.y), hi_f(wu.y)});
            u32x2 ou; ou.x = pk2(gu0.x, gu0.y); ou.y = pk2(gu1.x, gu1.y);
            *(u32x2*)(UG + (size_t)r * 256 + 4 * lane) = ou;
            const u32x2 wv = *(const u32x2*)(zr + C_SGU + 256 + 4 * lane);
            const pg8::f32x2 gv0 = pg8::gelu_pk((pg8::f32x2){lo_f(wv.x), hi_f(wv.x)}), gv1 = pg8::gelu_pk((pg8::f32x2){lo_f(wv.y), hi_f(wv.y)});
            float a0 = gv0.x, a1 = gv0.y, a2 = gv1.x, a3 = gv1.y;
            const float mu = wsum(a0 + a1 + a2 + a3) * (1.f / 256.f);
            a0 -= mu; a1 -= mu; a2 -= mu; a3 -= mu;
            const float rs = rsqrtf(wsum(a0 * a0 + a1 * a1 + a2 * a2 + a3 * a3) * (1.f / 256.f) + EPS);
            const float4 gg = *(const float4*)(sg + 4 * lane), bb = *(const float4*)(sb + 4 * lane);
            u32x2 ov; ov.x = pk2(a0 * rs * gg.x + bb.x, a1 * rs * gg.y + bb.y); ov.y = pk2(a2 * rs * gg.z + bb.z, a3 * rs * gg.w + bb.w);
            *(u32x2*)(VG + (size_t)r * 256 + 4 * lane) = ov;
        }
        {
            const int hw = 1 << (lane >> 4);
            int sbase, n, tt;
            if (lat) { sbase = r & ~(SEQ - 1); n = SEQ; tt = t; }
            else { sbase = NLAT + ((r - NLAT) & ~(CTXL - 1)); n = CTXL; tt = (r - NLAT) & (CTXL - 1); }
            const int lo = max(tt - hw, 0), hi = min(tt + hw, n);
            float s0 = 0.f, s1 = 0.f, s2 = 0.f, s3 = 0.f;
#pragma unroll
            for (int d = -8; d < 8; ++d) {
                const int q = tt + d;
                const float wgt = (q >= lo && q < hi) ? 1.f : 0.f;
                const int qc = min(max(q, 0), n - 1);
                const u32x2 w = *(const u32x2*)(Z + (size_t)(sbase + qc) * DINP + 4 * lane);
                s0 += wgt * lo_f(w.x); s1 += wgt * hi_f(w.x); s2 += wgt * lo_f(w.y); s3 += wgt * hi_f(w.y);
            }
            const float inv = 1.f / (float)(hi - lo);
            const u32x2 wx = *(const u32x2*)(zr + 4 * lane);
            u32x2 o; o.x = pk2(s0 * inv - lo_f(wx.x), s1 * inv - hi_f(wx.x)); o.y = pk2(s2 * inv - lo_f(wx.y), s3 * inv - hi_f(wx.y));
            *(u32x2*)(DPOOL + (size_t)r * 256 + 4 * lane) = o;
        }
    }
}

DI void rot8_scale(u32x4& a, u32x4& b, const float2* tab, bool rope, float qs) {
#pragma unroll
    for (int e = 0; e < 4; ++e) {
        const float x1a = lo_f(a[e]), x1b = hi_f(a[e]), x2a = lo_f(b[e]), x2b = hi_f(b[e]);
        float y1a = x1a, y1b = x1b, y2a = x2a, y2b = x2b;
        if (rope) {
            const float2 ca = tab[2 * e], cb = tab[2 * e + 1];
            y1a = x1a * ca.x - x2a * ca.y; y2a = x2a * ca.x + x1a * ca.y;
            y1b = x1b * cb.x - x2b * cb.y; y2b = x2b * cb.x + x1b * cb.y;
        }
        a[e] = pk2(y1a * qs, y1b * qs); b[e] = pk2(y2a * qs, y2b * qs);
    }
}
DI void scale8(u32x4& a, float qs) {
#pragma unroll
    for (int e = 0; e < 4; ++e) a[e] = pk2(lo_f(a[e]) * qs, hi_f(a[e]) * qs);
}

template <int DQK, bool MASK, bool FAST = false>
DI bool attn_item(unsigned char* smem, lds_ptr lds3, const float2* tabR, const float2* tabC,
                  const bf16_t* qbase, int ldq, bool rope, int t0, float qscale,
                  const bf16_t* k1, int ldk1, const bf16_t* k2, const bf16_t* vb, int ldv,
                  int rowA, int lenA, int posA, int rowB, int lenB,
                  float m0, float l0, bool first_unclamped, bf16_t* ob) {
    constexpr int QP = DQK * 2 + 16, VP = 192, NKS = DQK / 16, CPK = DQK / 8;
    constexpr int K_OFF = 256 * QP, KB = 64 * QP, V_OFF = K_OFF + 2 * KB, VB = 64 * VP;
    constexpr float RESCALE_T = 8.f;
    static_assert(V_OFF + 2 * VB <= LDS_BYTES, "attention LDS");
    const int tid = tid_(), wid = tid >> 6, lane = tid & 63, l31 = lane & 31, h = lane >> 5;
    {
        const int row = tid >> 1, hh = tid & 1;
        const bf16_t* qr = qbase + (size_t)row * ldq;
        unsigned char* qd = smem + row * QP;
        const int tq = t0 + row, rp = tq >> 6, cp = tq & 63;
        if constexpr (DQK == 64) {
            u32x4 c[4];
#pragma unroll
            for (int j = 0; j < 4; ++j) c[j] = *(const u32x4*)(qr + 32 * hh + 8 * j);
            const float2* tab = hh ? (tabC + cp * 16) : (tabR + rp * 16);
            rot8_scale(c[0], c[2], tab, rope, qscale);
            rot8_scale(c[1], c[3], tab + 8, rope, qscale);
#pragma unroll
            for (int j = 0; j < 4; ++j) *(u32x4*)(qd + (32 * hh + 8 * j) * 2) = c[j];
        } else {
            u32x4 c[6];
#pragma unroll
            for (int j = 0; j < 6; ++j) c[j] = *(const u32x4*)(qr + 48 * hh + 8 * j);
            if (hh) {
                scale8(c[0], qscale); scale8(c[1], qscale);
                rot8_scale(c[2], c[3], tabR + rp * 8, rope, qscale);
                rot8_scale(c[4], c[5], tabC + cp * 8, rope, qscale);
            } else {
#pragma unroll
                for (int j = 0; j < 6; ++j) scale8(c[j], qscale);
            }
#pragma unroll
            for (int j = 0; j < 6; ++j) *(u32x4*)(qd + (48 * hh + 8 * j) * 2) = c[j];
        }
    }
    __syncthreads();
    const unsigned char* qlane = smem + (32 * wid + l31) * QP + 16 * h;

    const int nA = lenA >> 6, nT = nA + (lenB >> 6);
    u32x4 kr0, kr1, vr;
    const int kidx1 = min(tid + 512, 64 * CPK - 1);
    const int kkey0 = tid / CPK, kc0 = tid % CPK, kkey1 = kidx1 / CPK, kc1 = kidx1 % CPK;
    const int koff0 = (kc0 < 8) ? kkey0 * ldk1 + 8 * kc0 : kkey0 * 32 + 8 * (kc0 - 8);
    const int koff1 = (kc1 < 8) ? kkey1 * ldk1 + 8 * kc1 : kkey1 * 32 + 8 * (kc1 - 8);
    const int voff = (tid >> 3) * ldv + 8 * (tid & 7);
    auto gloadK = [&](int j) {
        const int jj = min(j, nT - 1);
        const int row0 = (jj < nA) ? rowA + 64 * jj : rowB + 64 * (jj - nA);
        const bf16_t* b1 = k1 + (size_t)row0 * ldk1; const bf16_t* b2 = k2 + (size_t)row0 * 32;
        kr0 = *(const u32x4*)(((kc0 < 8) ? b1 : b2) + koff0);
        if constexpr (DQK == 96) { if (tid < 256) kr1 = *(const u32x4*)(((kc1 < 8) ? b1 : b2) + koff1); }
    };
    auto gloadV = [&](int j) {
        const int jj = min(j, nT - 1);
        const int row0 = (jj < nA) ? rowA + 64 * jj : rowB + 64 * (jj - nA);
        vr = *(const u32x4*)(vb + (size_t)row0 * ldv + voff);
    };
    const int ksoff0 = kkey0 * QP + 16 * kc0, ksoff1 = kkey1 * QP + 16 * kc1, vsoff = (tid >> 3) * VP + 16 * (tid & 7);
    auto sstoreK = [&](int buf) {
        *(u32x4*)(smem + K_OFF + buf * KB + ksoff0) = kr0;
        if constexpr (DQK == 96) { if (tid < 256) *(u32x4*)(smem + K_OFF + buf * KB + ksoff1) = kr1; }
    };
    auto sstoreV = [&](int buf) { *(u32x4*)(smem + V_OFF + buf * VB + vsoff) = vr; };

    f32x16 O0, O1, negm;
    float mref = m0;
#pragma unroll
    for (int i = 0; i < 16; ++i) { O0[i] = 0.f; O1[i] = 0.f; negm[i] = -m0; }
    float lsum = l0 * (h == 0 ? 1.f : 0.f);
    const int qpos = t0 + 32 * wid + l31;
    const int q4 = (lane & 15) >> 2, p4 = lane & 3, blk = (lane >> 4) & 1;
    const int vlane = (4 * h + q4) * VP + 32 * blk + 8 * p4;
    const int klane = l31 * QP + 16 * h;

    auto kfrags = [&](int buf, bf16x8 (&kf0)[NKS], bf16x8 (&kf1)[NKS]) {
        const unsigned char* Kt = smem + K_OFF + buf * KB + klane;
#pragma unroll
        for (int ks = 0; ks < NKS; ++ks) { kf0[ks] = *(const bf16x8*)(Kt + 32 * ks); kf1[ks] = *(const bf16x8*)(Kt + 32 * QP + 32 * ks); }
    };
    f32x16 zacc;
#pragma unroll
    for (int i = 0; i < 16; ++i) zacc[i] = 0.f;
    auto qk = [&](const bf16x8 (&kf0)[NKS], const bf16x8 (&kf1)[NKS], int jt, f32x16& S0, f32x16& S1) {
#pragma unroll
        for (int ks = 0; ks < NKS; ++ks) {
            const bf16x8 qv = *(const bf16x8*)(qlane + 32 * ks);
            if (ks == 0) { S0 = MFMA32(kf0[0], qv, FAST ? negm : zacc); S1 = MFMA32(kf1[0], qv, FAST ? negm : zacc); }
            else { S0 = MFMA32(kf0[ks], qv, S0); S1 = MFMA32(kf1[ks], qv, S1); }
        }
        if constexpr (MASK) {
            const int d0 = (jt < nA) ? posA + 64 * jt - qpos : 0;
#pragma unroll
            for (int i = 0; i < 16; ++i) {
                const int dd = d0 + crow16(i, h);
                if (dd > 128 || dd < -128) S0[i] = -1e30f;
                if (dd + 32 > 128 || dd + 32 < -128) S1[i] = -1e30f;
            }
        }
    };

    gloadK(0); gloadV(0); sstoreK(0); sstoreV(0);
    gloadK(1); sstoreK(1);
    __syncthreads();
    bool bad = false;
    f32x16 SA0, SA1, SB0, SB1;
    {
        bf16x8 kf0[NKS], kf1[NKS];
        kfrags(0, kf0, kf1);
        qk(kf0, kf1, 0, SA0, SA1);
    }
    asm volatile("s_nop 15\n\ts_nop 15" ::: "memory");
    auto iter = [&](int j, f32x16& S0, f32x16& S1, f32x16& N0, f32x16& N1) {
        gloadK(j + 2);
        gloadV(j + 1);
        bf16x8 kf0[NKS], kf1[NKS];
        kfrags((j + 1) & 1, kf0, kf1);
        __builtin_amdgcn_sched_barrier(0);
        const bool first = (j == 0) && first_unclamped;
        float ps = 0.f;
        if constexpr (FAST) {
            bf16x8 qv[NKS];
#pragma unroll
            for (int ks = 0; ks < NKS; ++ks) qv[ks] = *(const bf16x8*)(qlane + 32 * ks);
            __builtin_amdgcn_sched_barrier(0);
            if (first) {
                float mx = max3f(S0[0], S1[0], S0[1]);
                mx = max3f(mx, S1[1], S0[2]); mx = max3f(mx, S1[2], S0[3]); mx = max3f(mx, S1[3], S0[4]); mx = max3f(mx, S1[4], S0[5]);
                mx = max3f(mx, S1[5], S0[6]); mx = max3f(mx, S1[6], S0[7]); mx = max3f(mx, S1[7], S0[8]); mx = max3f(mx, S1[8], S0[9]);
                mx = max3f(mx, S1[9], S0[10]); mx = max3f(mx, S1[10], S0[11]); mx = max3f(mx, S1[11], S0[12]); mx = max3f(mx, S1[12], S0[13]);
                mx = max3f(mx, S1[13], S0[14]); mx = max3f(mx, S1[14], S0[15]); mx = fmaxf(mx, S1[15]);
                const float delta = fmaxf(mx, __shfl_xor(mx, 32)) + 10.f;
                mref += delta;
#pragma unroll
                for (int i = 0; i < 16; ++i) { S0[i] -= delta; S1[i] -= delta; negm[i] = -mref; }
            }
#pragma unroll
            for (int i = 0; i < 16; ++i) { S0[i] = __builtin_amdgcn_exp2f(S0[i]); ps += S0[i]; }
            __builtin_amdgcn_sched_barrier(0);
#pragma unroll
            for (int ks = 0; ks < NKS; ++ks) {
                if (ks == 0) { N0 = MFMA32(kf0[0], qv[0], negm); N1 = MFMA32(kf1[0], qv[0], negm); }
                else { N0 = MFMA32(kf0[ks], qv[ks], N0); N1 = MFMA32(kf1[ks], qv[ks], N1); }
            }
            __builtin_amdgcn_sched_barrier(0);
            lds_ptr Vt = lds3 + V_OFF + (j & 1) * VB + vlane;
            bf16x8 vf0[4], vf1[4];
#pragma unroll
            for (int ms = 0; ms < 4; ++ms) { vf0[ms] = tr_pair(Vt + 16 * ms * VP, 8 * VP); vf1[ms] = tr_pair(Vt + 16 * ms * VP + 64, 8 * VP); }
            __builtin_amdgcn_sched_barrier(0);
#pragma unroll
            for (int i = 0; i < 16; ++i) { S1[i] = __builtin_amdgcn_exp2f(S1[i]); ps += S1[i]; }
            bad = bad || !(ps < 8192.f);
            lsum += ps;
            u32x4 pw[4];
#pragma unroll
            for (int s = 0; s < 2; ++s) {
                pw[s].x = pk2(S0[8 * s], S0[8 * s + 1]); pw[s].y = pk2(S0[8 * s + 2], S0[8 * s + 3]); pw[s].z = pk2(S0[8 * s + 4], S0[8 * s + 5]); pw[s].w = pk2(S0[8 * s + 6], S0[8 * s + 7]);
                pw[2 + s].x = pk2(S1[8 * s], S1[8 * s + 1]); pw[2 + s].y = pk2(S1[8 * s + 2], S1[8 * s + 3]); pw[2 + s].z = pk2(S1[8 * s + 4], S1[8 * s + 5]); pw[2 + s].w = pk2(S1[8 * s + 6], S1[8 * s + 7]);
            }
            __builtin_amdgcn_sched_barrier(0);
#pragma unroll
            for (int ms = 0; ms < 4; ++ms) {
                const bf16x8 pf = __builtin_bit_cast(bf16x8, pw[ms]);
                O0 = MFMA32(vf0[ms], pf, O0);
                O1 = MFMA32(vf1[ms], pf, O1);
            }
            sstoreK(j & 1);
            sstoreV((j + 1) & 1);
            __syncthreads();
            return;
        } else {
            float mx = max3f(S0[0], S1[0], S0[1]);
            mx = max3f(mx, S1[1], S0[2]); mx = max3f(mx, S1[2], S0[3]); mx = max3f(mx, S1[3], S0[4]); mx = max3f(mx, S1[4], S0[5]);
            mx = max3f(mx, S1[5], S0[6]); mx = max3f(mx, S1[6], S0[7]); mx = max3f(mx, S1[7], S0[8]); mx = max3f(mx, S1[8], S0[9]);
            mx = max3f(mx, S1[9], S0[10]); mx = max3f(mx, S1[10], S0[11]); mx = max3f(mx, S1[11], S0[12]); mx = max3f(mx, S1[12], S0[13]);
            mx = max3f(mx, S1[13], S0[14]); mx = max3f(mx, S1[14], S0[15]); mx = fmaxf(mx, S1[15]);
            if (first || __any(mx - mref > RESCALE_T)) {
                const float mxf = fmaxf(mx, __shfl_xor(mx, 32));
                const float mnew = first ? mxf : fmaxf(mxf, mref);
                const float alpha = __builtin_amdgcn_exp2f(mref - mnew);
                mref = mnew; lsum *= alpha;
#pragma unroll
                for (int i = 0; i < 16; ++i) { O0[i] *= alpha; O1[i] *= alpha; }
            }
            qk(kf0, kf1, j + 1, N0, N1);
#pragma unroll
            for (int i = 0; i < 16; ++i) { S0[i] = __builtin_amdgcn_exp2f(S0[i] - mref); S1[i] = __builtin_amdgcn_exp2f(S1[i] - mref); ps += S0[i] + S1[i]; }
        }
        lsum += ps;
        lds_ptr Vt = lds3 + V_OFF + (j & 1) * VB + vlane;
#pragma unroll
        for (int mt = 0; mt < 2; ++mt)
#pragma unroll
            for (int s = 0; s < 2; ++s) {
                u32x4 pw;
                if (mt == 0) { pw.x = pk2(S0[8 * s], S0[8 * s + 1]); pw.y = pk2(S0[8 * s + 2], S0[8 * s + 3]); pw.z = pk2(S0[8 * s + 4], S0[8 * s + 5]); pw.w = pk2(S0[8 * s + 6], S0[8 * s + 7]); }
                else { pw.x = pk2(S1[8 * s], S1[8 * s + 1]); pw.y = pk2(S1[8 * s + 2], S1[8 * s + 3]); pw.z = pk2(S1[8 * s + 4], S1[8 * s + 5]); pw.w = pk2(S1[8 * s + 6], S1[8 * s + 7]); }
                const bf16x8 pf = __builtin_bit_cast(bf16x8, pw);
                const bf16x8 v0 = tr_pair(Vt + (32 * mt + 16 * s) * VP, 8 * VP);
                const bf16x8 v1 = tr_pair(Vt + (32 * mt + 16 * s) * VP + 64, 8 * VP);
                O0 = MFMA32(v0, pf, O0);
                O1 = MFMA32(v1, pf, O1);
            }
        sstoreK(j & 1);
        sstoreV((j + 1) & 1);
        __syncthreads();
    };
    for (int j = 0; j < nT; j += 2) {
        iter(j, SA0, SA1, SB0, SB1);
        iter(j + 1, SB0, SB1, SA0, SA1);
    }
    if constexpr (FAST) { if (__syncthreads_or((int)bad)) return false; }
    const float ltot = lsum + __shfl_xor(lsum, 32);
    const float inv = 1.f / ltot;
    bf16_t* orow = ob + (size_t)(32 * wid + l31) * 1024;
#pragma unroll
    for (int g4 = 0; g4 < 4; ++g4) {
        u32x2 o0, o1;
        o0.x = pk2(O0[4 * g4] * inv, O0[4 * g4 + 1] * inv); o0.y = pk2(O0[4 * g4 + 2] * inv, O0[4 * g4 + 3] * inv);
        o1.x = pk2(O1[4 * g4] * inv, O1[4 * g4 + 1] * inv); o1.y = pk2(O1[4 * g4 + 2] * inv, O1[4 * g4 + 3] * inv);
        *(u32x2*)(orow + 8 * g4 + 4 * h) = o0;
        *(u32x2*)(orow + 32 + 8 * g4 + 4 * h) = o1;
    }
    return true;
}

DI void sgu_item(unsigned char* smem, lds_ptr lds3, const Params& p, int l, int c) {
    constexpr int VPB = 576;
    const int tid = tid_(), wid = tid >> 6, lane = tid & 63, l31 = lane & 31, h = lane >> 5;
    unsigned char* U = p.ws + WS_U;
    const bf16_t* VG = (const bf16_t*)(U + U_VG); const bf16_t* UG = (const bf16_t*)(U + U_UG);
    bf16_t* YC = (bf16_t*)(U + U_YCAT);
    const bf16_t* WSG = (const bf16_t*)(p.ws + W_SGU);
    const float* bs = p.in[17] + l * 512;
    const int row0 = c * 128;
#pragma unroll
    for (int i = 0; i < 8; ++i) {
        const int idx = tid + 512 * i, rr = idx >> 5, ch = idx & 31;
        const u32x4 v = *(const u32x4*)(VG + (size_t)(row0 + rr) * 256 + 8 * ch);
        *(u32x4*)(smem + rr * VPB + 16 * ch) = v;
    }
    __syncthreads();
    const int hd = wid >> 1, ph = wid & 1;
    f32x16 C00, C01, C10, C11;
#pragma unroll
    for (int i = 0; i < 16; ++i) { C00[i] = 0.f; C01[i] = 0.f; C10[i] = 0.f; C11[i] = 0.f; }
    const int q4 = (lane & 15) >> 2, p4 = lane & 3, blk = (lane >> 4) & 1;
    lds_ptr vbase = lds3 + (8 * h + q4) * VPB + (hd * 64 + 16 * blk) * 2 + 8 * p4;
    const bf16_t* wb = WSG + (size_t)(hd * 128 + 64 * ph + l31) * 128 + 8 * h;
#pragma unroll
    for (int ks = 0; ks < 8; ++ks) {
        const bf16x8 A0 = tr_pair(vbase + 16 * ks * VPB, 4 * VPB);
        const bf16x8 A1 = tr_pair(vbase + 16 * ks * VPB + 64, 4 * VPB);
        const bf16x8 B0 = *(const bf16x8*)(wb + 16 * ks);
        const bf16x8 B1 = *(const bf16x8*)(wb + 32 * 128 + 16 * ks);
        C00 = MFMA32(A0, B0, C00); C01 = MFMA32(A0, B1, C01);
        C10 = MFMA32(A1, B0, C10); C11 = MFMA32(A1, B1, C11);
    }
#pragma unroll
    for (int pt = 0; pt < 2; ++pt) {
        const int pp = 64 * ph + 32 * pt + l31, row = row0 + pp;
        const float bias = bs[hd * 128 + pp];
#pragma unroll
        for (int dt = 0; dt < 2; ++dt)
#pragma unroll
            for (int g4 = 0; g4 < 4; ++g4) {
                const int d0 = 32 * dt + 8 * g4 + 4 * h;
                const u32x2 uu = *(const u32x2*)(UG + (size_t)row * 256 + hd * 64 + d0);
                float c0, c1, c2, c3;
                if (dt == 0 && pt == 0) { c0 = C00[4 * g4]; c1 = C00[4 * g4 + 1]; c2 = C00[4 * g4 + 2]; c3 = C00[4 * g4 + 3]; }
                else if (dt == 0) { c0 = C01[4 * g4]; c1 = C01[4 * g4 + 1]; c2 = C01[4 * g4 + 2]; c3 = C01[4 * g4 + 3]; }
                else if (pt == 0) { c0 = C10[4 * g4]; c1 = C10[4 * g4 + 1]; c2 = C10[4 * g4 + 2]; c3 = C10[4 * g4 + 3]; }
                else { c0 = C11[4 * g4]; c1 = C11[4 * g4 + 1]; c2 = C11[4 * g4 + 2]; c3 = C11[4 * g4 + 3]; }
                u32x2 o;
                o.x = pk2((c0 + bias) * lo_f(uu.x), (c1 + bias) * hi_f(uu.x));
                o.y = pk2((c2 + bias) * lo_f(uu.y), (c3 + bias) * hi_f(uu.y));
                *(u32x2*)(YC + (size_t)row * 1024 + 768 + hd * 64 + d0) = o;
            }
    }
    __syncthreads();
}

DI void phase_mix(const Params& p, int l, unsigned char* smem, lds_ptr lds3) {
    const int G = nblk_(), bid = bid_();
    unsigned char* U = p.ws + WS_U;
    const bf16_t* Z = (const bf16_t*)(U + U_Z);
    const bf16_t* QRAW = (const bf16_t*)(U + U_QRAW); const bf16_t* KVRAW = (const bf16_t*)(U + U_KVRAW);
    const bf16_t* KSR = (const bf16_t*)(p.ws + WS_KSR); const bf16_t* KRR = (const bf16_t*)(p.ws + WS_KRR);
    bf16_t* YC = (bf16_t*)(U + U_YCAT);
    const float2* tS = (const float2*)(p.ws + WS_TAB); const float2* tM = tS + 320 * 16;
    const float mla_scale = 0.10206207261596575f * LOG2E;
    const float swa_scale = 0.125f * LOG2E;
    unsigned failmask = 0u;
    for (int pass = 0; pass < 2; ++pass) {
        int slot = 0;
        for (int ii = bid; ii < 512 + G; ii += G, ++slot) {
            const int i = (ii < 512) ? ii : ((ii - 512 >= G - 8) ? 512 + (ii - 512 - (G - 8)) : -1);
            if (i < 0) continue;
            if (pass == 1 && !((failmask >> slot) & 1u)) continue;
            int b, hd, q0row, t0, rowA, lenA; bool rope;
            if (i < 512) { const int bh = i & 7, qt = i >> 3; b = bh >> 2; hd = bh & 3; t0 = qt * 256; q0row = b * SEQ + t0; rowA = b * SEQ; lenA = SEQ; rope = true; }
            else { const int k = i - 512; b = k >> 2; hd = k & 3; t0 = 0; q0row = NLAT + b * CTXL; rowA = 0; lenA = 0; rope = false; }
            if (pass == 0) {
                const bool ok = attn_item<96, false, true>(smem, lds3, tM, tM + 256 * 8, QRAW + (size_t)q0row * 512 + hd * 96, 512, rope, t0, mla_scale,
                              KVRAW + hd * 128, 512, KRR, KVRAW + hd * 128 + 64, 512,
                              rowA, lenA, 0, NLAT + b * CTXL, CTXL, 0.f, 0.f, true, YC + (size_t)q0row * 1024 + 512 + hd * 64);
                if (!ok) failmask |= 1u << slot;
            } else {
                attn_item<96, false, false>(smem, lds3, tM, tM + 256 * 8, QRAW + (size_t)q0row * 512 + hd * 96, 512, rope, t0, mla_scale,
                              KVRAW + hd * 128, 512, KRR, KVRAW + hd * 128 + 64, 512,
                              rowA, lenA, 0, NLAT + b * CTXL, CTXL, 0.f, 0.f, true, YC + (size_t)q0row * 1024 + 512 + hd * 64);
            }
        }
        if (failmask == 0u) break;
    }
    for (int ii = bid; ii < 512 + G; ii += G) {
        const int i = (ii < 512) ? ii : ((ii - 512 >= G - 16 && ii - 512 < G - 8) ? 512 + (ii - 512 - (G - 16)) : -1);
        if (i < 0) continue;
        int b, hd, q0row, t0, rowA, lenA, posA; bool rope;
        if (i < 512) {
            const int bh = i & 7, qt = i >> 3; b = bh >> 2; hd = bh & 3; t0 = qt * 256; q0row = b * SEQ + t0; rope = true;
            posA = max(t0 - 128, 0); const int endA = min(t0 + 384, SEQ); rowA = b * SEQ + posA; lenA = endA - posA;
        } else { const int k = i - 512; b = k >> 2; hd = k & 3; t0 = 0; q0row = NLAT + b * CTXL; rowA = 0; lenA = 0; posA = 0; rope = false; }
        const int kvh = hd >> 1;
        const float sink = p.in[9][l * 4 + hd] * LOG2E;
        attn_item<64, true>(smem, lds3, tS, tS + 256 * 16, Z + (size_t)q0row * DINP + C_SWA_Q + hd * 64, DINP, rope, t0, swa_scale,
                      KSR + kvh * 64, 128, nullptr, Z + C_SWA_V + kvh * 64, DINP,
                      rowA, lenA, posA, NLAT + b * CTXL, CTXL, sink, 1.f, false, YC + (size_t)q0row * 1024 + 256 + hd * 64);
    }
    for (int c = bid; c < 260; c += G) sgu_item(smem, lds3, p, l, c);
}

#define XB_TMO      128
#define XB_XCNT(j)  (256  + 64 * (j))
#define XB_XSUB(j)  (1280 + 64 * (j))
#define XB_XGEN(j)  (2304 + 64 * (j))
#define XB_TOP      3328
#define XB_TOPGEN   3392
#define XCD_BAR_WORDS 3456
#define XB_SPIN_CAP (1u << 18)
#define LAS __attribute__((address_space(3)))

__device__ __forceinline__ unsigned xb_ld(unsigned* p)              { return __hip_atomic_load(p, __ATOMIC_RELAXED, __HIP_MEMORY_SCOPE_AGENT); }
__device__ __forceinline__ unsigned xb_add(unsigned* p, unsigned v) { return __hip_atomic_fetch_add(p, v, __ATOMIC_RELAXED, __HIP_MEMORY_SCOPE_AGENT); }
__device__ __forceinline__ unsigned xb_xcc_id() { return (unsigned)__builtin_amdgcn_s_getreg((3 << 11) | 20) & 0xFu; }
#define XB_SPIN(cond, bar) do { unsigned _sp = 0; while (cond) { __builtin_amdgcn_s_sleep(1); \
    if ((++_sp & 255u) == 0u) { if (xb_ld(&(bar)[XB_TMO])) break; if (_sp > XB_SPIN_CAP) { atomicAdd(&(bar)[XB_TMO], 1u); break; } } } } while (0)

struct XcdBarrier {
    unsigned* bar; unsigned x;
    volatile LAS unsigned* st;
};

__device__ __forceinline__ XcdBarrier xcd_barrier_post(unsigned* bar, volatile LAS unsigned* st) {
    XcdBarrier b; b.bar = bar; b.x = xb_xcc_id(); b.st = st;
    if (threadIdx.x == 0) (void)xb_add(&bar[XB_XCNT(b.x)], 1u);
    return b;
}
__device__ __forceinline__ void xcd_barrier_complete(unsigned* bar, unsigned x, unsigned& nloc, unsigned& nx) {
    const unsigned G = gridDim.x * gridDim.y * gridDim.z;
    unsigned sum, cnt, mine, sp = 0u;
    for (;;) {
        sum = 0u; cnt = 0u; mine = 0u;
#pragma unroll
        for (unsigned j = 0; j < 16; ++j) { const unsigned c = xb_ld(&bar[XB_XCNT(j)]); sum += c; cnt += (c > 0u) ? 1u : 0u; mine = (j == x) ? c : mine; }
        if (sum == G) break;
        __builtin_amdgcn_s_sleep(1);
        if ((++sp & 255u) == 0u) { if (xb_ld(&bar[XB_TMO])) break; if (sp > XB_SPIN_CAP) { atomicAdd(&bar[XB_TMO], 1u); break; } }
    }
    nloc = mine > 0u ? mine : 1u; nx = cnt > 0u ? cnt : 1u;
}

__device__ __forceinline__ void xcd_barrier(const XcdBarrier& b) {
    asm volatile("s_waitcnt vmcnt(0)" ::: "memory");
    __syncthreads();
    if (threadIdx.x == 0) {
        unsigned* bar = b.bar;
        __builtin_amdgcn_s_waitcnt(0);
        unsigned nloc = b.st[0], nx = b.st[1];
        if (nloc == 0u) { xcd_barrier_complete(bar, b.x, nloc, nx); b.st[0] = nloc; b.st[1] = nx; }
        const unsigned old = xb_add(&bar[XB_XSUB(b.x)], 1u);
        const unsigned gen = old / nloc;
        if (old + 1u == (gen + 1u) * nloc) {
            __builtin_amdgcn_fence(__ATOMIC_RELEASE, "agent");
            asm volatile("s_waitcnt vmcnt(0)" ::: "memory");
            const unsigned og = xb_add(&bar[XB_TOP], 1u);
            const unsigned tg = og / nx;
            if (og + 1u == (tg + 1u) * nx) xb_add(&bar[XB_TOPGEN], 1u);
            else XB_SPIN(xb_ld(&bar[XB_TOPGEN]) == tg, bar);
            __builtin_amdgcn_fence(__ATOMIC_ACQUIRE, "agent");
            xb_add(&bar[XB_XGEN(b.x)], 1u);
            asm volatile("s_waitcnt vmcnt(0)" ::: "memory");
        } else {
            XB_SPIN(xb_ld(&bar[XB_XGEN(b.x)]) == gen, bar);
            __builtin_amdgcn_fence(__ATOMIC_ACQUIRE, "agent");
            asm volatile("s_waitcnt vmcnt(0)" ::: "memory");
        }
    }
    __syncthreads();
}


DI void grid_bar(lds_ptr lds3) {
    XcdBarrier b; b.bar = (unsigned*)(params_().ws + WS_BAR); b.x = xb_xcc_id(); b.st = (volatile LAS unsigned*)(lds3 + LDS_BYTES);
    xcd_barrier(b);
}

__global__ __launch_bounds__(512, 2) void fwd_megakernel(Params p_unused) {
    extern __shared__ __attribute__((aligned(16))) unsigned char smem[];
    cg::grid_group grid = cg::this_grid();
    lds_ptr lds3 = (lds_ptr)smem;
    {
        const Params& p = params_();
        if (blockIdx.x == 0) { unsigned* bw = (unsigned*)(p.ws + WS_BAR); for (int i = threadIdx.x; i < XCD_BAR_WORDS; i += 512) bw[i] = 0u; }
        if (threadIdx.x == 0) { *(volatile LAS unsigned*)(lds3 + LDS_BYTES) = 0u; *(volatile LAS unsigned*)(lds3 + LDS_BYTES + 4) = 0u; }
        phase_adaln(p, (float*)smem);
        phase_tables(p);
        convert_layer(p, 0, smem);
    }
    grid.sync();
    (void)xcd_barrier_post((unsigned*)(params_().ws + WS_BAR), (volatile LAS unsigned*)(lds3 + LDS_BYTES));
    {
        const Params& p = params_();
        phase_ln(p, 0, nullptr, nullptr, (const float*)(p.ws + WS_MOD), 0);
    }
    grid_bar(lds3);
    for (int l = 0; l < DEPTH; ++l) {
        {
            const Params& p = params_(); unsigned char* U = p.ws + WS_U;
            pg8::EpiBf16<0> E; E.O = (bf16_t*)(U + U_Z); E.ldc = DINP; E.bias = nullptr; E.split_cols = 0; E.split_stride = 0;
            run_gemm(lds3, (const bf16_t*)(U + U_H), (const bf16_t*)(p.ws + W_IN), R, DINP, 1024, E);
        }
        grid_bar(lds3);
        phase_postz(params_(), l);
        grid_bar(lds3);
        {
            const Params& p = params_(); unsigned char* U = p.ws + WS_U;
            pg8::EpiBf16<0> E; E.bias = nullptr; E.split_cols = 0; E.split_stride = 0;
            E.O = (bf16_t*)(U + U_QRAW); E.ldc = 512;
            run_gemm(lds3, (const bf16_t*)(U + U_CQN), (const bf16_t*)(p.ws + W_UQ), R, 512, 256, E);
        }
        {
            const Params& p = params_(); unsigned char* U = p.ws + WS_U;
            pg8::EpiBf16<0> E; E.bias = nullptr; E.split_cols = 0; E.split_stride = 0;
            E.O = (bf16_t*)(U + U_KVRAW); E.ldc = 512;
            run_gemm(lds3, (const bf16_t*)(U + U_CKVN), (const bf16_t*)(p.ws + W_UKV), R, 512, 256, E, nblk_() - 8);
        }
        {
            const Params& p = params_(); unsigned char* U = p.ws + WS_U;
            pg8::EpiBf16<0> E; E.bias = nullptr; E.split_cols = 0; E.split_stride = 0;
            E.O = (bf16_t*)(U + U_YCAT); E.ldc = 1024;
            run_gemm(lds3, (const bf16_t*)(U + U_DPOOL), (const bf16_t*)(p.ws + W_POOL), R, 256, 256, E, nblk_() - 16);
        }
        grid_bar(lds3);
        phase_mix(params_(), l, smem, lds3);
        grid_bar(lds3);
        {
            const Params& p = params_(); unsigned char* U = p.ws + WS_U;
            EpiScaleBf16 E; E.O = (bf16_t*)(U + U_Z); E.modl = (const float*)(p.ws + WS_MOD) + (size_t)l * 3 * 6144; E.idx = 2;
            run_gemm(lds3, (const bf16_t*)(U + U_YCAT), (const bf16_t*)(p.ws + W_OUT), (l + 1 < DEPTH) ? R : NLAT, 1024, 1024, E);
        }
        grid_bar(lds3);
        {
            const Params& p = params_();
            phase_ln(p, 1, p.in[19] + l * 1024, p.in[20] + l * 1024, (const float*)(p.ws + WS_MOD) + (size_t)l * 3 * 6144, 3,
                     (const bf16_t*)(p.ws + WS_U + U_Z), (l + 1 < DEPTH) ? R : NLAT);
        }
        grid_bar(lds3);
        {
            const Params& p = params_(); unsigned char* U = p.ws + WS_U;
            EpiRelu2 E; E.O = (bf16_t*)(U + U_F1); E.ldc = 4096;
            run_gemm(lds3, (const bf16_t*)(U + U_H), (const bf16_t*)(p.ws + W_FF1), (l + 1 < DEPTH) ? R : NLAT, 4096, 1024, E);
        }
        grid_bar(lds3);
        {
            const Params& p = params_(); unsigned char* U = p.ws + WS_U;
            EpiScaleBf16 E; E.O = (bf16_t*)(U + U_H); E.modl = (const float*)(p.ws + WS_MOD) + (size_t)l * 3 * 6144; E.idx = 5;
            run_gemm(lds3, (const bf16_t*)(U + U_F1), (const bf16_t*)(p.ws + W_FF2), (l + 1 < DEPTH) ? R : NLAT, 1024, 4096, E);
        }
        grid_bar(lds3);
        {
            const Params& p = params_();
            const float* modl = (const float*)(p.ws + WS_MOD) + (size_t)l * 3 * 6144;
            if (l + 1 < DEPTH) {
                phase_ln(p, 1, p.in[23] + l * 1024, p.in[24] + l * 1024, modl + 3 * 6144, 0, (const bf16_t*)(p.ws + WS_U + U_H));
                convert_layer(p, l + 1, smem);
            } else {
                phase_ln(p, 2, p.in[23] + l * 1024, p.in[24] + l * 1024, modl, 0, (const bf16_t*)(p.ws + WS_U + U_H));
            }
        }
        grid_bar(lds3);
    }
}

extern "C" void kernel_launch(void* const* d_in, const int* in_sizes, int n_in, void* d_out, int out_size, void* d_ws, size_t ws_size, hipStream_t stream) {
    static int grid_blocks = 0;
    if (!grid_blocks) {
        int dev = 0, cus = 0, per_cu = 0;
        hipGetDevice(&dev);
        hipDeviceGetAttribute(&cus, hipDeviceAttributeMultiprocessorCount, dev);
        if (hipFuncSetAttribute((const void*)fwd_megakernel, hipFuncAttributeMaxDynamicSharedMemorySize, LDS_ALLOC) != hipSuccess)
            fprintf(stderr, "kernel_launch: hipFuncSetAttribute(%d B LDS) failed\n", LDS_BYTES);
        if (hipOccupancyMaxActiveBlocksPerMultiprocessor(&per_cu, (const void*)fwd_megakernel, 512, LDS_ALLOC) != hipSuccess || per_cu < 1) per_cu = 1;
        (void)hipGetLastError();
        grid_blocks = cus * per_cu;
        if (ws_size < WS_END) fprintf(stderr, "kernel_launch: workspace %zu < needed %zu\n", ws_size, (size_t)WS_END);
    }
    Params p{};
    for (int i = 0; i < 25; ++i) p.in[i] = (const float*)d_in[i];
    p.out = (float*)d_out; p.ws = (unsigned char*)d_ws;
    void* args[] = {&p};
    hipError_t e = hipLaunchCooperativeKernel((const void*)fwd_megakernel, dim3(grid_blocks), dim3(512), args, LDS_ALLOC, stream);
    if (e != hipSuccess) fprintf(stderr, "cooperative launch failed: %s (grid %d)\n", hipGetErrorString(e), grid_blocks);
}
```

```cpp
#include <hip/hip_runtime.h>
#include <hip/hip_cooperative_groups.h>
#include <cstdio>
namespace cg = cooperative_groups;
namespace pg8 {
#define PG8_LAS __attribute__((address_space(3)))
typedef unsigned short bf16_t;
typedef short bf16x8 __attribute__((ext_vector_type(8)));
typedef float f32x4 __attribute__((ext_vector_type(4)));
typedef unsigned u32x4 __attribute__((ext_vector_type(4)));
constexpr int BM = 256, BK = 64, HALF = 128, HTB = HALF * BK * 2  , STAGE_BYTES = 8 * HTB, NXCD = 8, WGM = 8;

__host__ __device__ __forceinline__ int lds_byte(int r, int c) { const int st = (r >> 4) * 2 + (c >> 5), rr = r & 15, cc = c & 31, ob = rr * 64 + cc * 2; return st * 1024 + (ob ^ (((ob >> 9) & 1) << 5)); }
__host__ __device__ __forceinline__ void stage_rc(int b, int& R, int& C) { const int st = b / 1024, sb = b % 1024, swz = sb ^ (((sb >> 9) & 1) << 5); R = (st >> 1) * 16 + swz / 64; C = (st & 1) * 32 + (swz % 64) / 2; }
__host__ __device__ __forceinline__ int perm32(int rho) { const int n = rho >> 4, i = rho & 15; return 8 * (i >> 2) + 4 * n + (i & 3); }

struct Unit { int pm, pn; };
struct Gemm { const bf16_t* A; const bf16_t* Bt; int M, N, K; };

struct StaticOrder {
    int nM, nN, nwg, G, c;
    __host__ __device__ void init(int M, int N, int G_, int c_) { nM = M / BM; nN = N / BM; nwg = nM * nN; G = G_; c = c_; }
    __host__ __device__ bool next(int i, Unit& u) const {
        const long L = (long)i * G + c; if (L >= nwg) return false;
        int wgid = (int)L; { const int q = nwg / NXCD, r = nwg % NXCD, xcd = wgid % NXCD, off = wgid / NXCD; wgid = (xcd < r ? xcd * (q + 1) : r * (q + 1) + (xcd - r) * q) + off; }
        const int nig = WGM * nN, gid = wgid / nig, fm = gid * WGM, gsz = (nM - fm) < WGM ? (nM - fm) : WGM;
        u.pm = fm + ((wgid % nig) % gsz); u.pn = (wgid % nig) / gsz; return true;
    }
    __device__ __forceinline__ void a_ready(const Unit&) const {}
    __device__ __forceinline__ void done(const Unit&) const {}
};
struct CountedOrder : StaticOrder {
    const unsigned* ready; unsigned need; unsigned* tmo;
    __device__ __forceinline__ void a_ready(const Unit& u) const {
        if (threadIdx.x < 64) {
            const unsigned long long t0 = __builtin_amdgcn_s_memrealtime(); unsigned polls = 0;
            while ((unsigned)__builtin_amdgcn_readfirstlane(__hip_atomic_load(ready + 64 * u.pm, __ATOMIC_RELAXED, __HIP_MEMORY_SCOPE_AGENT)) < need) {
                if ((++polls & 255u) == 0u && __builtin_amdgcn_readfirstlane(__hip_atomic_load(tmo, __ATOMIC_RELAXED, __HIP_MEMORY_SCOPE_AGENT)) != 0u) break;
                if (__builtin_amdgcn_s_memrealtime() - t0 > 2000000ull) {
                    if (threadIdx.x == 0) { unsigned expect = 0u; __hip_atomic_compare_exchange_strong(tmo + 1, &expect, 0x600u | (unsigned)(u.pm & 0xff), __ATOMIC_RELAXED, __ATOMIC_RELAXED, __HIP_MEMORY_SCOPE_AGENT); __hip_atomic_store(tmo, 1u, __ATOMIC_RELAXED, __HIP_MEMORY_SCOPE_AGENT); }
                    break; }
                __builtin_amdgcn_s_sleep(2); }
            __builtin_amdgcn_fence(__ATOMIC_ACQUIRE, "agent");
            asm volatile("s_waitcnt vmcnt(0)" ::: "memory");
        }
#if !defined(BROKEN_HOOK_NO_BARRIER)
        asm volatile("" ::: "memory"); __builtin_amdgcn_s_barrier(); asm volatile("" ::: "memory");
#endif
    }
};

__device__ __forceinline__ unsigned cvt_pk_bf16(float lo, float hi) { unsigned r; asm volatile("v_cvt_pk_bf16_f32 %0, %1, %2" : "=v"(r) : "v"(lo), "v"(hi)); return r; }
typedef float f32x2 __attribute__((ext_vector_type(2)));
__device__ __forceinline__ f32x2 gelu_pk(f32x2 v) {
    const f32x2 av = __builtin_elementwise_abs(v), d = av * 0.2316418882f + 1.0f;
    f32x2 t; t.x = __builtin_amdgcn_rcpf(d.x); t.y = __builtin_amdgcn_rcpf(d.y);
    f32x2 q = t * 0.5307027145f + (-0.7265760135f); q = q * t + 0.7107068705f; q = q * t + (-0.142248368f); q = q * t + 0.127414796f; q = q * t;
    const f32x2 s = (v * v) * (-0.72134752044f);
    f32x2 e; e.x = __builtin_amdgcn_exp2f(s.x); e.y = __builtin_amdgcn_exp2f(s.y);
    const f32x2 m = v * (q * e), r = v - m;
    f32x2 o; o.x = v.x < 0.f ? m.x : r.x; o.y = v.y < 0.f ? m.y : r.y; return o;
}

struct EpiF32 {
    static constexpr bool PERM = false, AFTER_DRAIN = false;
    float* C; int ldc; const float* bias;
    __device__ __forceinline__ void operator()(const f32x4 (&acc)[2][2][4][2], const Unit& u, int wr, int wc, int fr, int fq) const {
        const int row0 = u.pm * BM + wr * 64 + fr, col0 = u.pn * BM + wc * 32 + 4 * fq;
        f32x4 bv[2][2];
#pragma unroll
        for (int bj = 0; bj < 2; ++bj)
#pragma unroll
            for (int n = 0; n < 2; ++n) bv[bj][n] = bias ? *(const f32x4*)(bias + col0 + bj * HALF + n * 16) : (f32x4){0.f, 0.f, 0.f, 0.f};
#pragma unroll
        for (int ai = 0; ai < 2; ++ai)
#pragma unroll
            for (int m = 0; m < 4; ++m) { float* rowp = C + (size_t)(row0 + ai * HALF + m * 16) * ldc + col0;
#pragma unroll
                for (int bj = 0; bj < 2; ++bj)
#pragma unroll
                    for (int n = 0; n < 2; ++n) *(f32x4*)(rowp + bj * HALF + n * 16) = acc[ai][bj][m][n] + bv[bj][n]; }
    }
};
template <int ACT  > struct EpiBf16 {
    static constexpr bool PERM = true, AFTER_DRAIN = false;
    bf16_t* O; int ldc; const float* bias; int split_cols; size_t split_stride;
    __device__ __forceinline__ void operator()(const f32x4 (&acc)[2][2][4][2], const Unit& u, int wr, int wc, int fr, int fq) const {
        const int row0 = u.pm * BM + wr * 64 + fr; int colt = u.pn * BM; bf16_t* base = O;
        if (split_cols) { const int t = colt / split_cols; base += (size_t)t * split_stride; colt -= t * split_cols; }
        const int col0 = colt + wc * 32 + 8 * fq, bcol0 = u.pn * BM + wc * 32 + 8 * fq;
        f32x4 bv[2][2];
#pragma unroll
        for (int bj = 0; bj < 2; ++bj)
#pragma unroll
            for (int n = 0; n < 2; ++n) bv[bj][n] = bias ? *(const f32x4*)(bias + bcol0 + bj * HALF + 4 * n) : (f32x4){0.f, 0.f, 0.f, 0.f};
#pragma unroll
        for (int ai = 0; ai < 2; ++ai)
#pragma unroll
            for (int m = 0; m < 4; ++m) { bf16_t* rowp = base + (size_t)(row0 + ai * HALF + m * 16) * ldc + col0;
#pragma unroll
                for (int bj = 0; bj < 2; ++bj) { f32x4 v0 = acc[ai][bj][m][0] + bv[bj][0], v1 = acc[ai][bj][m][1] + bv[bj][1];
                    if (ACT == 1) { f32x2 a = gelu_pk((f32x2){v0[0], v0[1]}), b = gelu_pk((f32x2){v0[2], v0[3]}), c = gelu_pk((f32x2){v1[0], v1[1]}), d = gelu_pk((f32x2){v1[2], v1[3]});
                        v0 = (f32x4){a.x, a.y, b.x, b.y}; v1 = (f32x4){c.x, c.y, d.x, d.y}; }
                    if (ACT == 2) {
#pragma unroll
                        for (int j = 0; j < 4; ++j) { v0[j] = 0.5f * v0[j] * (1.0f + erff(v0[j] * 0.70710678f)); v1[j] = 0.5f * v1[j] * (1.0f + erff(v1[j] * 0.70710678f)); } }
                    u32x4 w; w.x = cvt_pk_bf16(v0[0], v0[1]); w.y = cvt_pk_bf16(v0[2], v0[3]); w.z = cvt_pk_bf16(v1[0], v1[1]); w.w = cvt_pk_bf16(v1[2], v1[3]);
                    *(u32x4*)(rowp + bj * HALF) = w; } }
    }
};
template <class Epi, class Sched, bool STAMP = false>
__device__ __forceinline__ void gemm_phase(PG8_LAS unsigned char* lds, const Gemm g, const Sched& S, const Epi& E, unsigned long long* stamps) {
    int tid_raw = threadIdx.x; asm volatile("" : "+v"(tid_raw)); const int tid = tid_raw, wid = __builtin_amdgcn_readfirstlane(tid >> 6), lane = tid & 63, wr = wid >> 2, wc = wid & 3, fr = lane & 15, fq = lane >> 4;
    const int K = g.K, nt = K / BK;
    int ts_lo = 0, ts_hi = 0, nts = 0; const unsigned long long rt_entry = STAMP ? (unsigned long long)wall_clock64() : 0ull;
#define PG8_STAMP() do { if (STAMP && wid == 0 && nts < 64) { const unsigned long long _c = (unsigned long long)clock64(); \
        ts_lo = (lane == nts) ? (int)(unsigned)_c : ts_lo; ts_hi = (lane == nts) ? (int)(unsigned)(_c >> 32) : ts_hi; ++nts; } } while (0)
    PG8_STAMP();
    unsigned voffA[2], voffB[2];
#pragma unroll
    for (int i = 0; i < 2; ++i) { int R, C; stage_rc(tid * 16 + i * 8192, R, C); const int Rb = Epi::PERM ? ((R & ~31) + perm32(R & 31)) : R;
        voffA[i] = (unsigned)(R * K + C) * 2u; voffB[i] = (unsigned)(Rb * K + C) * 2u; }
    const size_t kstep = (size_t)(BK * 2);
    const size_t hstep = (size_t)HALF * K * 2;
    const size_t tstep = 2 * hstep;
    const unsigned ldsw = (unsigned)wid * 1024u;
    const int aoff = lds_byte(wr * 64 + fr, fq * 8), boff = lds_byte(wc * 32 + fr, fq * 8);
#define PG8_SA(b, h) (((b) * 2 + (h)) * HTB)
#define PG8_SB(b, h) ((4 + (b) * 2 + (h)) * HTB)
#define PG8_STAGE(bufoff, gbase, voff) do { _Pragma("unroll") for (int _i = 0; _i < 2; ++_i) \
        __builtin_amdgcn_global_load_lds((const unsigned*)((const char*)(gbase) + (voff)[_i]), (PG8_LAS unsigned*)(lds + (bufoff) + ldsw + _i * 8192), 16, 0, 0); } while (0)
#define PG8_LDA(dst, b, h) do { _Pragma("unroll") for (int m = 0; m < 4; ++m) _Pragma("unroll") for (int k = 0; k < 2; ++k) dst[m][k] = *(const PG8_LAS bf16x8*)(lds + PG8_SA(b, h) + aoff + m * 2048 + k * 1024); } while (0)
#define PG8_LDB(dst, b, h) do { _Pragma("unroll") for (int n = 0; n < 2; ++n) _Pragma("unroll") for (int k = 0; k < 2; ++k) dst[n][k] = *(const PG8_LAS bf16x8*)(lds + PG8_SB(b, h) + boff + n * 2048 + k * 1024); } while (0)
#define PG8_MMA(ai, bj, At, Bt) do { __builtin_amdgcn_s_setprio(1); _Pragma("unroll") for (int m = 0; m < 4; ++m) _Pragma("unroll") for (int n = 0; n < 2; ++n) _Pragma("unroll") for (int k = 0; k < 2; ++k) \
        acc[ai][bj][m][n] = __builtin_amdgcn_mfma_f32_16x16x32_bf16(Bt[n][k], At[m][k], acc[ai][bj][m][n], 0, 0, 0); __builtin_amdgcn_s_setprio(0); } while (0)
#define PG8_WAIT_V(n) asm volatile("s_waitcnt vmcnt(" #n ")" ::: "memory")
#define PG8_WAIT_L(n) asm volatile("s_waitcnt lgkmcnt(" #n ")" ::: "memory")
#define PG8_BAR __builtin_amdgcn_s_barrier()
#define PG8_SCHED __builtin_amdgcn_sched_barrier(0)
    Unit cur, nxt; int ui = 0;
    if (!S.next(0, cur)) return;
    f32x4 acc[2][2][4][2];
#pragma unroll
    for (int a = 0; a < 2; ++a)
#pragma unroll
        for (int b = 0; b < 2; ++b)
#pragma unroll
            for (int m = 0; m < 4; ++m)
#pragma unroll
                for (int n = 0; n < 2; ++n) acc[a][b][m][n] = (f32x4){0.f, 0.f, 0.f, 0.f};
    bf16x8 At[4][2], B0[2][2], B1[2][2];
    const char* cA = (const char*)g.A + (size_t)cur.pm * tstep; const char* cB = (const char*)g.Bt + (size_t)cur.pn * tstep;
    S.a_ready(cur);
    PG8_STAGE(PG8_SB(0, 0), cB, voffB); PG8_STAGE(PG8_SA(0, 0), cA, voffA); PG8_STAGE(PG8_SB(0, 1), cB + hstep, voffB); PG8_STAGE(PG8_SA(0, 1), cA + hstep, voffA);
    if (wr == 1) PG8_BAR;
    PG8_WAIT_V(4); PG8_BAR;
    PG8_STAGE(PG8_SB(1, 0), cB + kstep, voffB); PG8_STAGE(PG8_SA(1, 0), cA + kstep, voffA); PG8_STAGE(PG8_SB(1, 1), cB + hstep + kstep, voffB);
    PG8_WAIT_V(6); PG8_BAR;
    PG8_STAMP();
    for (;;) {
        const bool has_next = S.next(ui + 1, nxt);
        const char* nA = has_next ? (const char*)g.A + (size_t)nxt.pm * tstep : cA; const char* nB = has_next ? (const char*)g.Bt + (size_t)nxt.pn * tstep : cB;
        for (int t = 0; t < nt; t += 2) {
            const bool last = (t == nt - 2);
            const char* a1 = cA + (size_t)(t + 1) * kstep;
            const char* a2 = last ? nA : cA + (size_t)(t + 2) * kstep; const char* b2 = last ? nB : cB + (size_t)(t + 2) * kstep;
            const char* a3 = a2 + kstep; const char* b3 = b2 + kstep;
            if (last && has_next) S.a_ready(nxt);
            PG8_LDB(B0, 0, 0); PG8_SCHED; PG8_LDA(At, 0, 0); PG8_STAGE(PG8_SA(1, 1), a1 + hstep, voffA);
            PG8_WAIT_L(8); PG8_BAR; PG8_WAIT_L(0); PG8_MMA(0, 0, At, B0); PG8_BAR; PG8_SCHED;
            PG8_LDB(B1, 0, 1); PG8_STAGE(PG8_SB(0, 0), b2, voffB);
            PG8_BAR; PG8_WAIT_L(0); PG8_MMA(0, 1, At, B1); PG8_BAR;
            PG8_LDA(At, 0, 1); PG8_STAGE(PG8_SA(0, 0), a2, voffA);
            PG8_BAR; PG8_WAIT_L(0); PG8_MMA(1, 0, At, B0); PG8_BAR; PG8_SCHED;
            PG8_STAGE(PG8_SB(0, 1), b2 + hstep, voffB);
            PG8_WAIT_V(6); PG8_BAR; PG8_MMA(1, 1, At, B1); PG8_BAR;
            PG8_LDB(B0, 1, 0); PG8_SCHED; PG8_LDA(At, 1, 0); PG8_STAGE(PG8_SA(0, 1), a2 + hstep, voffA);
            PG8_WAIT_L(8); PG8_BAR; PG8_WAIT_L(0); PG8_MMA(0, 0, At, B0); PG8_BAR; PG8_SCHED;
            PG8_LDB(B1, 1, 1); PG8_STAGE(PG8_SB(1, 0), b3, voffB);
            PG8_BAR; PG8_WAIT_L(0); PG8_MMA(0, 1, At, B1); PG8_BAR;
            PG8_LDA(At, 1, 1); PG8_STAGE(PG8_SA(1, 0), a3, voffA);
            PG8_BAR; PG8_WAIT_L(0); PG8_MMA(1, 0, At, B0); PG8_BAR; PG8_SCHED;
            PG8_STAGE(PG8_SB(1, 1), b3 + hstep, voffB);
            PG8_WAIT_V(6); PG8_BAR; PG8_MMA(1, 1, At, B1); PG8_BAR;
        }
        PG8_STAMP();
        if constexpr (!Epi::AFTER_DRAIN) { E(acc, cur, wr, wc, fr, fq); S.done(cur); }
        PG8_STAMP();
        if (!has_next) break;
#pragma unroll
        for (int a = 0; a < 2; ++a)
#pragma unroll
            for (int b = 0; b < 2; ++b)
#pragma unroll
                for (int m = 0; m < 4; ++m)
#pragma unroll
                    for (int n = 0; n < 2; ++n) acc[a][b][m][n] = (f32x4){0.f, 0.f, 0.f, 0.f};
        cur = nxt; cA = nA; cB = nB; ++ui;
    }
    PG8_WAIT_V(0);
    if (wr == 0) PG8_BAR;
    PG8_BAR;
    if constexpr (Epi::AFTER_DRAIN) { E.fused(acc, cur, wr, wc, fr, fq, lds, wid, lane); S.done(cur); }
    PG8_STAMP();
    if (STAMP && wid == 0) { stamps[lane] = lane < nts ? (((unsigned long long)(unsigned)ts_hi << 32) | (unsigned)ts_lo) : 0ull;
        if (lane == 62) stamps[62] = rt_entry; if (lane == 63) stamps[63] = (unsigned long long)wall_clock64(); }
#undef PG8_STAMP
#undef PG8_SA
#undef PG8_SB
#undef PG8_STAGE
#undef PG8_LDA
#undef PG8_LDB
#undef PG8_MMA
#undef PG8_WAIT_V
#undef PG8_WAIT_L
#undef PG8_BAR
#undef PG8_SCHED
}
}

#define DI __device__ __forceinline__
using pg8::bf16_t; using pg8::bf16x8; using pg8::f32x4; using pg8::u32x4;
typedef short s16x4 __attribute__((ext_vector_type(4)));
typedef float f32x16 __attribute__((ext_vector_type(16)));
typedef unsigned u32x2 __attribute__((ext_vector_type(2)));
typedef __bf16 bf2_t __attribute__((ext_vector_type(2)));
typedef float f32x2_t __attribute__((ext_vector_type(2)));
typedef PG8_LAS unsigned char* lds_ptr;

constexpr int D = 1024, NLAT = 32768, NCTX = 512, R = NLAT + NCTX, SEQ = 16384, CTXL = 256, DEPTH = 4;
constexpr int DIN = 1696, DINP = 1792;
constexpr int C_SWA_Q = 256, C_MLA_CQ = 512, C_SGU = 768, C_SWA_K = 1280, C_SWA_V = 1408, C_MLA_CKV = 1536, C_MLA_KR = 1664;
constexpr float EPS = 1e-6f;
constexpr float DN_ALPHA = 1.681792830507429f;
constexpr float LOG2E = 1.4426950408889634f;
constexpr int LDS_BYTES = 131072;
constexpr int LDS_ALLOC = LDS_BYTES + 16;

constexpr size_t W_IN = 0;
constexpr size_t W_OUT = W_IN + (size_t)DINP * 1024 * 2;
constexpr size_t W_FF1 = W_OUT + (size_t)1024 * 1024 * 2;
constexpr size_t W_FF2 = W_FF1 + (size_t)4096 * 1024 * 2;
constexpr size_t W_UQ = W_FF2 + (size_t)4096 * 1024 * 2;
constexpr size_t W_UKV = W_UQ + (size_t)512 * 256 * 2;
constexpr size_t W_POOL = W_UKV + (size_t)512 * 256 * 2;
constexpr size_t W_SGU = W_POOL + (size_t)256 * 256 * 2;
constexpr size_t WS_MOD = W_SGU + (size_t)4 * 128 * 128 * 2;
constexpr size_t WS_TAB = WS_MOD + (size_t)DEPTH * 3 * 6144 * 4;
constexpr size_t WS_X = WS_TAB + (size_t)(320 * 16 + 320 * 8) * 8;
constexpr size_t WS_U = WS_X + (size_t)R * 1024 * 4;
constexpr size_t U_Z = 0;
constexpr size_t U_QRAW = U_Z + (size_t)R * DINP * 2;
constexpr size_t U_KVRAW = U_QRAW + (size_t)R * 512 * 2;
constexpr size_t U_CQN = U_KVRAW + (size_t)R * 512 * 2;
constexpr size_t U_CKVN = U_CQN + (size_t)R * 256 * 2;
constexpr size_t U_DPOOL = U_CKVN + (size_t)R * 256 * 2;
constexpr size_t U_UG = U_DPOOL + (size_t)R * 256 * 2;
constexpr size_t U_VG = U_UG + (size_t)R * 256 * 2;
constexpr size_t U_F1 = 0;
constexpr size_t U_H = (size_t)R * 4096 * 2;
constexpr size_t U_YCAT = U_H;
constexpr size_t WS_KSR = WS_U + U_H + (size_t)R * 1024 * 2;
constexpr size_t WS_KRR = WS_KSR + (size_t)R * 128 * 2;
constexpr size_t WS_BAR = WS_KRR + (size_t)R * 32 * 2;
constexpr size_t WS_END = WS_BAR + 16384;
static_assert(U_VG + (size_t)R * 256 * 2 == U_H, "mixer-mode buffers must exactly fill the f1 slot");
static_assert(WS_END <= (size_t)536870912, "workspace too large");
static_assert(WS_X % 256 == 0 && WS_U % 256 == 0 && WS_MOD % 256 == 0 && WS_TAB % 256 == 0, "alignment");

struct Params { const float* in[25]; float* out; unsigned char* ws; };
DI int tid_() { int t = threadIdx.x; asm volatile("" : "+v"(t)); return t; }
DI int bid_() { int t = blockIdx.x; asm volatile("" : "+s"(t)); return t; }
DI int nblk_() { int t = gridDim.x; asm volatile("" : "+s"(t)); return t; }
DI const Params& params_() { auto k = __builtin_amdgcn_kernarg_segment_ptr(); asm volatile("" : "+s"(k)); return *(const Params*)k; }


DI float bf2f(bf16_t b) { return __uint_as_float(((unsigned)b) << 16); }
DI unsigned pk2(float a, float b) { f32x2_t v = {a, b}; bf2_t r = __builtin_convertvector(v, bf2_t); return __builtin_bit_cast(unsigned, r); }
DI bf16_t f2bf(float a) { return (bf16_t)(pk2(a, 0.f) & 0xffffu); }
DI float lo_f(unsigned u) { return __uint_as_float(u << 16); }
DI float hi_f(unsigned u) { return __uint_as_float(u & 0xffff0000u); }
DI float wsum(float v) {
#pragma unroll
    for (int m = 32; m >= 1; m >>= 1) v += __shfl_xor(v, m);
    return v;
}
DI float max3f(float a, float b, float c) { float r; asm("v_max3_f32 %0, %1, %2, %3" : "=v"(r) : "v"(a), "v"(b), "v"(c)); return r; }
DI int crow16(int i, int h) { return (i & 3) + 8 * (i >> 2) + 4 * h; }
#define MFMA32(a, b, c) __builtin_amdgcn_mfma_f32_32x32x16_bf16((a), (b), (c), 0, 0, 0)
DI bf16x8 tr_pair(lds_ptr lo_addr, int hi_delta) {
    const s16x4 lo = __builtin_amdgcn_ds_read_tr16_b64_v4i16((PG8_LAS s16x4*)lo_addr);
    const s16x4 hi = __builtin_amdgcn_ds_read_tr16_b64_v4i16((PG8_LAS s16x4*)(lo_addr + hi_delta));
    return __builtin_shufflevector(lo, hi, 0, 1, 2, 3, 4, 5, 6, 7);
}

struct EpiScaleBf16 {
    static constexpr bool PERM = true, AFTER_DRAIN = false;
    bf16_t* O; const float* modl; int idx;
    DI void operator()(const f32x4 (&acc)[2][2][4][2], const pg8::Unit& u, int wr, int wc, int fr, int fq) const {
        const int row0 = u.pm * 256 + wr * 64 + fr, col0 = u.pn * 256 + wc * 32 + 8 * fq;
        const int set = (u.pm < 64) ? 0 : (u.pm < 128 ? 1 : 2);
        const float* mp = modl + set * 6144 + idx * 1024 + col0;
        f32x4 mv[2][2];
#pragma unroll
        for (int bj = 0; bj < 2; ++bj)
#pragma unroll
            for (int n = 0; n < 2; ++n) mv[bj][n] = *(const f32x4*)(mp + bj * 128 + 4 * n);
#pragma unroll
        for (int ai = 0; ai < 2; ++ai)
#pragma unroll
            for (int m = 0; m < 4; ++m) {
                bf16_t* rowp = O + (size_t)(row0 + ai * 128 + m * 16) * 1024 + col0;
#pragma unroll
                for (int bj = 0; bj < 2; ++bj) {
                    const f32x4 v0 = acc[ai][bj][m][0] * mv[bj][0], v1 = acc[ai][bj][m][1] * mv[bj][1];
                    u32x4 w; w.x = pk2(v0[0], v0[1]); w.y = pk2(v0[2], v0[3]); w.z = pk2(v1[0], v1[1]); w.w = pk2(v1[2], v1[3]);
                    *(u32x4*)(rowp + bj * 128) = w;
                }
            }
    }
};
struct EpiRelu2 {
    static constexpr bool PERM = true, AFTER_DRAIN = false;
    bf16_t* O; int ldc;
    DI void operator()(const f32x4 (&acc)[2][2][4][2], const pg8::Unit& u, int wr, int wc, int fr, int fq) const {
        const int row0 = u.pm * 256 + wr * 64 + fr, col0 = u.pn * 256 + wc * 32 + 8 * fq;
#pragma unroll
        for (int ai = 0; ai < 2; ++ai)
#pragma unroll
            for (int m = 0; m < 4; ++m) {
                bf16_t* rowp = O + (size_t)(row0 + ai * 128 + m * 16) * ldc + col0;
#pragma unroll
                for (int bj = 0; bj < 2; ++bj) {
                    f32x4 v0 = acc[ai][bj][m][0], v1 = acc[ai][bj][m][1];
#pragma unroll
                    for (int j = 0; j < 4; ++j) { const float a = fmaxf(v0[j], 0.f), b = fmaxf(v1[j], 0.f); v0[j] = a * a; v1[j] = b * b; }
                    u32x4 w; w.x = pk2(v0[0], v0[1]); w.y = pk2(v0[2], v0[3]); w.z = pk2(v1[0], v1[1]); w.w = pk2(v1[2], v1[3]);
                    *(u32x4*)(rowp + bj * 128) = w;
                }
            }
    }
};

template <class Epi>
DI void run_gemm(lds_ptr lds3, const bf16_t* A, const bf16_t* Bt, int M, int N, int K, const Epi& E, int crot = 0) {
    pg8::Gemm g; g.A = A; g.Bt = Bt; g.M = M; g.N = N; g.K = K;
    const int G = nblk_(); int c = bid_() + crot; if (c >= G) c -= G;
    pg8::StaticOrder S; S.init(M, N, G, c);
    pg8::gemm_phase<Epi, pg8::StaticOrder, false>(lds3, g, S, E, nullptr);
}

DI void phase_adaln(const Params& p, float* lf) {
    for (int i = tid_(); i < 3072; i += 512) {
        const int s = i >> 10, k = i & 1023;
        const float v = (s < 2) ? p.in[1][s * 1024 + k] : p.in[3][k];
        lf[i] = v / (1.f + expf(-v));
    }
    __syncthreads();
    float* red = lf + 3072;
    const int wid = tid_() >> 6, lane = tid_() & 63;
    float* mod = (float*)(p.ws + WS_MOD);
    for (int item = bid_(); item < DEPTH * 96; item += nblk_()) {
        const int l = item / 96, jc = (item % 96) * 64;
        const float* w = p.in[4] + (size_t)l * 1024 * 6144 + jc + lane;
        float a0 = 0.f, a1 = 0.f, a2 = 0.f;
        const int i0 = wid * 128;
#pragma unroll 32
        for (int i = 0; i < 128; ++i) {
            const float wv = w[(size_t)(i0 + i) * 6144];
            a0 += lf[i0 + i] * wv; a1 += lf[1024 + i0 + i] * wv; a2 += lf[2048 + i0 + i] * wv;
        }
        red[(wid * 3 + 0) * 64 + lane] = a0; red[(wid * 3 + 1) * 64 + lane] = a1; red[(wid * 3 + 2) * 64 + lane] = a2;
        __syncthreads();
        if (tid_() < 192) {
            const int s = tid_() >> 6;
            float sum = 0.f;
#pragma unroll
            for (int w8 = 0; w8 < 8; ++w8) sum += red[(w8 * 3 + s) * 64 + lane];
            mod[((size_t)l * 3 + s) * 6144 + jc + lane] = sum + p.in[5][l * 6144 + jc + lane];
        }
        __syncthreads();
    }
}

DI void phase_tables(const Params& p) {
    float2* tS = (float2*)(p.ws + WS_TAB);
    float2* tM = tS + 320 * 16;
    const int gtid = bid_() * 512 + tid_(), gsz = nblk_() * 512;
    const float L2B = 13.287712379549449f;
    for (int i = gtid; i < 320 * 16 + 320 * 8; i += gsz) {
        int pos, f; float inv;
        if (i < 320 * 16) { pos = i >> 4; f = i & 15; inv = exp2f(-(float)(2 * f) * (1.f / 32.f) * L2B); }
        else { const int k = i - 320 * 16; pos = k >> 3; f = k & 7; inv = exp2f(-(float)(2 * f) * (1.f / 16.f) * L2B); }
        const float ang = (float)(pos < 256 ? pos : pos - 256) * inv;
        const double ad = (double)ang;
        const double kk = __builtin_rint(ad * 0.15915494309189535);
        const float rr = (float)(ad - kk * 6.283185307179586);
        tS[i] = make_float2(__cosf(rr), __sinf(rr));
    }
}

struct ConvJob { const float* src; bf16_t* dst; int K, N, KP, tk, tn; };
DI void conv_load(const ConvJob& c, int t, float4 (&v)[2]) {
#pragma unroll
    for (int rep = 0; rep < 2; ++rep) {
        const int k = c.tk * 64 + rep * 32 + (t >> 4), n = c.tn * 64 + (t & 15) * 4;
        v[rep] = make_float4(0.f, 0.f, 0.f, 0.f);
        if (k < c.K && n < c.N) v[rep] = *(const float4*)(c.src + (size_t)k * c.N + n);
    }
}
DI void conv_store(const ConvJob& c, int t, const float4 (&v)[2], bf16_t* tile) {
#pragma unroll
    for (int rep = 0; rep < 2; ++rep) {
        const int kl = rep * 32 + (t >> 4), nl = (t & 15) * 4;
        tile[(nl + 0) * 72 + kl] = f2bf(v[rep].x); tile[(nl + 1) * 72 + kl] = f2bf(v[rep].y);
        tile[(nl + 2) * 72 + kl] = f2bf(v[rep].z); tile[(nl + 3) * 72 + kl] = f2bf(v[rep].w);
    }
    __syncthreads();
    {
        const int nl = t >> 3, kl = (t & 7) * 8;
        const u32x4 w = *(const u32x4*)(tile + nl * 72 + kl);
        *(u32x4*)(c.dst + (size_t)(c.tn * 64 + nl) * c.KP + c.tk * 64 + kl) = w;
    }
    __syncthreads();
}

DI void convert_layer(const Params& p, int l, unsigned char* smem) {
    bf16_t* tile = (bf16_t*)smem;
    constexpr int T_IN = 16 * 28, T_OUT = 16 * 16, T_FF1 = 16 * 64, T_FF2 = 64 * 16, T_UQ = 4 * 8, T_UKV = 4 * 8;
    constexpr int T_ALL = T_IN + T_OUT + T_FF1 + T_FF2 + T_UQ + T_UKV;
    auto decode = [&](int t) {
        ConvJob c; int NT; size_t off; int tt = t;
        if (tt < T_IN) { c.src = p.in[6] + (size_t)l * 1024 * DIN; c.K = 1024; c.N = DIN; c.KP = 1024; NT = 28; off = W_IN; }
        else if ((tt -= T_IN) < T_OUT) { c.src = p.in[18] + (size_t)l * 1024 * 1024; c.K = 1024; c.N = 1024; c.KP = 1024; NT = 16; off = W_OUT; }
        else if ((tt -= T_OUT) < T_FF1) { c.src = p.in[21] + (size_t)l * 1024 * 4096; c.K = 1024; c.N = 4096; c.KP = 1024; NT = 64; off = W_FF1; }
        else if ((tt -= T_FF1) < T_FF2) { c.src = p.in[22] + (size_t)l * 4096 * 1024; c.K = 4096; c.N = 1024; c.KP = 4096; NT = 16; off = W_FF2; }
        else if ((tt -= T_FF2) < T_UQ) { c.src = p.in[11] + (size_t)l * 256 * 384; c.K = 256; c.N = 384; c.KP = 256; NT = 8; off = W_UQ; }
        else { tt -= T_UQ; c.src = p.in[13] + (size_t)l * 128 * 512; c.K = 128; c.N = 512; c.KP = 256; NT = 8; off = W_UKV; }
        c.dst = (bf16_t*)(p.ws + off); c.tk = tt / NT; c.tn = tt % NT;
        return c;
    };
    {
        const int t = tid_(), G = nblk_();
        int tix = bid_();
        float4 cur[2], nxt[2];
        if (tix < T_ALL) conv_load(decode(tix), t, cur);
        for (; tix < T_ALL; tix += G) {
            const bool more = tix + G < T_ALL;
            if (more) conv_load(decode(tix + G), t, nxt);
            conv_store(decode(tix), t, cur, tile);
            cur[0] = nxt[0]; cur[1] = nxt[1];
        }
    }
    const int gtid = bid_() * 512 + tid_(), gsz = nblk_() * 512;
    {
        bf16_t* dst = (bf16_t*)(p.ws + W_POOL);
        const float* pw = p.in[7] + (size_t)l * 4 * 64 * 64; const float* ps = p.in[8] + l * 256;
        for (int i = gtid; i < 65536; i += gsz) {
            const int row = i >> 8, col = i & 255, g = row >> 6, e = row & 63;
            float v = 0.f;
            if ((col >> 6) == g) v = pw[(g * 64 + (col & 63)) * 64 + e] * ps[row];
            dst[i] = f2bf(v);
        }
    }
    {
        bf16_t* dst = (bf16_t*)(p.ws + W_SGU);
        const float* sw = p.in[16] + (size_t)l * 65536;
        for (int i = gtid; i < 65536; i += gsz) dst[i] = f2bf(sw[i]);
    }
}

DI void wsum4(float& a, float& b, float& c, float& d) {
#pragma unroll
    for (int m = 32; m >= 1; m >>= 1) {
        const float ta = __shfl_xor(a, m), tb = __shfl_xor(b, m), tc = __shfl_xor(c, m), td = __shfl_xor(d, m);
        a += ta; b += tb; c += tc; d += td;
    }
}
DI void row_stats(const float4 (&v)[4], float& s, float& q) {
    s = 0.f; q = 0.f;
#pragma unroll
    for (int j = 0; j < 4; ++j) { s += v[j].x + v[j].y + v[j].z + v[j].w; q += v[j].x * v[j].x + v[j].y * v[j].y + v[j].z * v[j].z + v[j].w * v[j].w; }
}
DI void phase_ln(const Params& p, int mode, const float* g, const float* b, const float* modl, int i0, const bf16_t* Y = nullptr, int rlimit = R) {
    const int wid = tid_() >> 6, lane = tid_() & 63;
    bf16_t* XL = (bf16_t*)(p.ws + WS_X);
    float* XC = (float*)(p.ws + WS_X + (size_t)NLAT * 1024 * 2);
    bf16_t* H = (bf16_t*)(p.ws + WS_U + U_H);
    const int rmax = (mode == 2) ? NLAT : rlimit;
    const int rstride = nblk_() * 8;
    for (int ra = bid_() * 8 + wid; ra < rmax; ra += 2 * rstride) {
        const bool has_b = ra + rstride < rmax;
        const int rb = has_b ? ra + rstride : ra;
        float4 v[2][4];
#pragma unroll
        for (int k = 0; k < 2; ++k) {
            const int r = k ? rb : ra;
            if (mode != 0 && r < NLAT) {
#pragma unroll
                for (int j = 0; j < 4; ++j) {
                    const u32x2 w = *(const u32x2*)(XL + (size_t)r * 1024 + 4 * lane + 256 * j);
                    v[k][j] = make_float4(lo_f(w.x), hi_f(w.x), lo_f(w.y), hi_f(w.y));
                }
            } else {
                const float* src;
                if (mode == 0) src = (r < NLAT) ? p.in[0] + (size_t)r * 1024 : p.in[2] + (size_t)(r - NLAT) * 1024;
                else src = XC + (size_t)(r - NLAT) * 1024;
#pragma unroll
                for (int j = 0; j < 4; ++j) v[k][j] = *(const float4*)(src + 4 * lane + 256 * j);
            }
        }
        if (mode != 0) {
#pragma unroll
            for (int k = 0; k < 2; ++k) {
                const int r = k ? rb : ra;
                {
#pragma unroll
                    for (int j = 0; j < 4; ++j) {
                        const u32x2 yw = *(const u32x2*)(Y + (size_t)r * 1024 + 4 * lane + 256 * j);
                        v[k][j].x = v[k][j].x * DN_ALPHA + lo_f(yw.x); v[k][j].y = v[k][j].y * DN_ALPHA + hi_f(yw.x);
                        v[k][j].z = v[k][j].z * DN_ALPHA + lo_f(yw.y); v[k][j].w = v[k][j].w * DN_ALPHA + hi_f(yw.y);
                    }
                }
            }
            float s0, q0, s1, q1;
            row_stats(v[0], s0, q0); row_stats(v[1], s1, q1);
            wsum4(s0, q0, s1, q1);
#pragma unroll
            for (int k = 0; k < 2; ++k) {
                const float mu = (k ? s1 : s0) * (1.f / 1024.f);
                const float rs = rsqrtf(fmaxf((k ? q1 : q0) * (1.f / 1024.f) - mu * mu, 0.f) + EPS);
#pragma unroll
                for (int j = 0; j < 4; ++j) {
                    const float4 gg = *(const float4*)(g + 4 * lane + 256 * j), bb = *(const float4*)(b + 4 * lane + 256 * j);
                    v[k][j].x = (v[k][j].x - mu) * rs * gg.x + bb.x; v[k][j].y = (v[k][j].y - mu) * rs * gg.y + bb.y;
                    v[k][j].z = (v[k][j].z - mu) * rs * gg.z + bb.z; v[k][j].w = (v[k][j].w - mu) * rs * gg.w + bb.w;
                }
            }
        }
#pragma unroll
        for (int k = 0; k < 2; ++k) {
            const int r = k ? rb : ra;
            if (k == 0 || has_b) {
                if (mode != 2 && r < NLAT) {
#pragma unroll
                    for (int j = 0; j < 4; ++j) { u32x2 o; o.x = pk2(v[k][j].x, v[k][j].y); o.y = pk2(v[k][j].z, v[k][j].w); *(u32x2*)(XL + (size_t)r * 1024 + 4 * lane + 256 * j) = o; }
                } else {
                    float* dstx = (mode == 2) ? p.out + (size_t)r * 1024 : XC + (size_t)(r - NLAT) * 1024;
#pragma unroll
                    for (int j = 0; j < 4; ++j) *(float4*)(dstx + 4 * lane + 256 * j) = v[k][j];
                }
            }
        }
        if (mode != 2) {
            float s0, q0, s1, q1;
            row_stats(v[0], s0, q0); row_stats(v[1], s1, q1);
            wsum4(s0, q0, s1, q1);
#pragma unroll
            for (int k = 0; k < 2; ++k) {
                const int r = k ? rb : ra;
                if (k == 0 || has_b) {
                    const float mu = (k ? s1 : s0) * (1.f / 1024.f);
                    const float rs = rsqrtf(fmaxf((k ? q1 : q0) * (1.f / 1024.f) - mu * mu, 0.f) + EPS);
                    const int set = (r < SEQ) ? 0 : (r < NLAT ? 1 : 2);
                    const float* msh = modl + set * 6144 + i0 * 1024, *msc = msh + 1024;
#pragma unroll
                    for (int j = 0; j < 4; ++j) {
                        const float4 sh = *(const float4*)(msh + 4 * lane + 256 * j), sc = *(const float4*)(msc + 4 * lane + 256 * j);
                        u32x2 o;
                        o.x = pk2((v[k][j].x - mu) * rs * (1.f + sc.x) + sh.x, (v[k][j].y - mu) * rs * (1.f + sc.y) + sh.y);
                        o.y = pk2((v[k][j].z - mu) * rs * (1.f + sc.z) + sh.z, (v[k][j].w - mu) * rs * (1.f + sc.w) + sh.w);
                        *(u32x2*)(H + (size_t)r * 1024 + 4 * lane + 256 * j) = o;
                    }
                }
            }
        }
    }
}

DI float gelu_exact(float x) { return 0.5f * x * (1.f + erff(x * 0.70710678118654752f)); }

DI void phase_postz(const Params& p, int l) {
    const int wid = tid_() >> 6, lane = tid_() & 63;
    unsigned char* U = p.ws + WS_U;
    const bf16_t* Z = (const bf16_t*)(U + U_Z);
    bf16_t* KSR = (bf16_t*)(p.ws + WS_KSR); bf16_t* KRR = (bf16_t*)(p.ws + WS_KRR);
    bf16_t* CQN = (bf16_t*)(U + U_CQN); bf16_t* CKVN = (bf16_t*)(U + U_CKVN); bf16_t* DPOOL = (bf16_t*)(U + U_DPOOL);
    bf16_t* UG = (bf16_t*)(U + U_UG); bf16_t* VG = (bf16_t*)(U + U_VG);
    const float2* tS = (const float2*)(p.ws + WS_TAB); const float2* tM = tS + 320 * 16;
    const float* gq = p.in[10] + l * 256; const float* gkv = p.in[12] + l * 128;
    const float* sg = p.in[14] + l * 256; const float* sb = p.in[15] + l * 256;
    for (int r = bid_() * 8 + wid; r < R; r += nblk_() * 8) {
        const bf16_t* zr = Z + (size_t)r * DINP;
        const bool lat = r < NLAT;
        const int t = r & (SEQ - 1), rp = t >> 6, cp = t & 63;
        {
            const int hd = lane >> 5, pp = lane & 31, i = pp & 15, off = hd * 64 + ((pp & 16) ? 32 : 0);
            const float x1 = bf2f(zr[C_SWA_K + off + i]), x2 = bf2f(zr[C_SWA_K + off + 16 + i]);
            float o1 = x1, o2 = x2;
            if (lat) { const float2 cs = (pp & 16) ? tS[(256 + cp) * 16 + i] : tS[rp * 16 + i]; o1 = x1 * cs.x - x2 * cs.y; o2 = x2 * cs.x + x1 * cs.y; }
            KSR[(size_t)r * 128 + off + i] = f2bf(o1); KSR[(size_t)r * 128 + off + 16 + i] = f2bf(o2);
        }
        if (lane < 16) {
            const int i = lane & 7, off = (lane & 8) ? 16 : 0;
            const float x1 = bf2f(zr[C_MLA_KR + off + i]), x2 = bf2f(zr[C_MLA_KR + off + 8 + i]);
            float o1 = x1, o2 = x2;
            if (lat) { const float2 cs = (lane & 8) ? tM[(256 + cp) * 8 + i] : tM[rp * 8 + i]; o1 = x1 * cs.x - x2 * cs.y; o2 = x2 * cs.x + x1 * cs.y; }
            KRR[(size_t)r * 32 + off + i] = f2bf(o1); KRR[(size_t)r * 32 + off + 8 + i] = f2bf(o2);
        }
        {
            const u32x2 w = *(const u32x2*)(zr + C_MLA_CQ + 4 * lane);
            const float a0 = lo_f(w.x), a1 = hi_f(w.x), a2 = lo_f(w.y), a3 = hi_f(w.y);
            const float rs = rsqrtf(wsum(a0 * a0 + a1 * a1 + a2 * a2 + a3 * a3) * (1.f / 256.f) + EPS);
            const float4 gg = *(const float4*)(gq + 4 * lane);
            u32x2 o; o.x = pk2(a0 * rs * gg.x, a1 * rs * gg.y); o.y = pk2(a2 * rs * gg.z, a3 * rs * gg.w);
            *(u32x2*)(CQN + (size_t)r * 256 + 4 * lane) = o;
        }
        {
            const unsigned w = *(const unsigned*)(zr + C_MLA_CKV + 2 * lane);
            const float a0 = lo_f(w), a1 = hi_f(w);
            const float rs = rsqrtf(wsum(a0 * a0 + a1 * a1) * (1.f / 128.f) + EPS);
            const float2 gg = *(const float2*)(gkv + 2 * lane);
            *(unsigned*)(CKVN + (size_t)r * 256 + 2 * lane) = pk2(a0 * rs * gg.x, a1 * rs * gg.y);
            *(unsigned*)(CKVN + (size_t)r * 256 + 128 + 2 * lane) = 0u;
        }
        {
            const u32x2 wu = *(const u32x2*)(zr + C_SGU + 4 * lane);
            const pg8::f32x2 gu0 = pg8::gelu_pk((pg8::f32x2){lo_f(wu.x), hi_f(wu.x)}), gu1 = pg8::gelu_pk((pg8::f32x2){lo_f(wu.y), hi_f(wu.y)});
            u32x2 ou; ou.x = pk2(gu0.x, gu0.y); ou.y = pk2(gu1.x, gu1.y);
            *(u32x2*)(UG + (size_t)r * 256 + 4 * lane) = ou;
            const u32x2 wv = *(const u32x2*)(zr + C_SGU + 256 + 4 * lane);
            const pg8::f32x2 gv0 = pg8::gelu_pk((pg8::f32x2){lo_f(wv.x), hi_f(wv.x)}), gv1 = pg8::gelu_pk((pg8::f32x2){lo_f(wv.y), hi_f(wv.y)});
            float a0 = gv0.x, a1 = gv0.y, a2 = gv1.x, a3 = gv1.y;
            const float mu = wsum(a0 + a1 + a2 + a3) * (1.f / 256.f);
            a0 -= mu; a1 -= mu; a2 -= mu; a3 -= mu;
            const float rs = rsqrtf(wsum(a0 * a0 + a1 * a1 + a2 * a2 + a3 * a3) * (1.f / 256.f) + EPS);
            const float4 gg = *(const float4*)(sg + 4 * lane), bb = *(const float4*)(sb + 4 * lane);
            u32x2 ov; ov.x = pk2(a0 * rs * gg.x + bb.x, a1 * rs * gg.y + bb.y); ov.y = pk2(a2 * rs * gg.z + bb.z, a3 * rs * gg.w + bb.w);
            *(u32x2*)(VG + (size_t)r * 256 + 4 * lane) = ov;
        }
        {
            const int hw = 1 << (lane >> 4);
            int sbase, n, tt;
            if (lat) { sbase = r & ~(SEQ - 1); n = SEQ; tt = t; }
            else { sbase = NLAT + ((r - NLAT) & ~(CTXL - 1)); n = CTXL; tt = (r - NLAT) & (CTXL - 1); }
            const int lo = max(tt - hw, 0), hi = min(tt + hw, n);
            float s0 = 0.f, s1 = 0.f, s2 = 0.f, s3 = 0.f;
#pragma unroll
            for (int d = -8; d < 8; ++d) {
                const int q = tt + d;
                const float wgt = (q >= lo && q < hi) ? 1.f : 0.f;
                const int qc = min(max(q, 0), n - 1);
                const u32x2 w = *(const u32x2*)(Z + (size_t)(sbase + qc) * DINP + 4 * lane);
                s0 += wgt * lo_f(w.x); s1 += wgt * hi_f(w.x); s2 += wgt * lo_f(w.y); s3 += wgt * hi_f(w.y);
            }
            const float inv = 1.f / (float)(hi - lo);
            const u32x2 wx = *(const u32x2*)(zr + 4 * lane);
            u32x2 o; o.x = pk2(s0 * inv - lo_f(wx.x), s1 * inv - hi_f(wx.x)); o.y = pk2(s2 * inv - lo_f(wx.y), s3 * inv - hi_f(wx.y));
            *(u32x2*)(DPOOL + (size_t)r * 256 + 4 * lane) = o;
        }
    }
}

DI void rot8_scale(u32x4& a, u32x4& b, const float2* tab, bool rope, float qs) {
#pragma unroll
    for (int e = 0; e < 4; ++e) {
        const float x1a = lo_f(a[e]), x1b = hi_f(a[e]), x2a = lo_f(b[e]), x2b = hi_f(b[e]);
        float y1a = x1a, y1b = x1b, y2a = x2a, y2b = x2b;
        if (rope) {
            const float2 ca = tab[2 * e], cb = tab[2 * e + 1];
            y1a = x1a * ca.x - x2a * ca.y; y2a = x2a * ca.x + x1a * ca.y;
            y1b = x1b * cb.x - x2b * cb.y; y2b = x2b * cb.x + x1b * cb.y;
        }
        a[e] = pk2(y1a * qs, y1b * qs); b[e] = pk2(y2a * qs, y2b * qs);
    }
}
DI void scale8(u32x4& a, float qs) {
#pragma unroll
    for (int e = 0; e < 4; ++e) a[e] = pk2(lo_f(a[e]) * qs, hi_f(a[e]) * qs);
}

template <int DQK, bool MASK, bool FAST = false>
DI bool attn_item(unsigned char* smem, lds_ptr lds3, const float2* tabR, const float2* tabC,
                  const bf16_t* qbase, int ldq, bool rope, int t0, float qscale,
                  const bf16_t* k1, int ldk1, const bf16_t* k2, const bf16_t* vb, int ldv,
                  int rowA, int lenA, int posA, int rowB, int lenB,
                  float m0, float l0, bool first_unclamped, bf16_t* ob) {
    constexpr int QP = DQK * 2 + 16, VP = 192, NKS = DQK / 16, CPK = DQK / 8;
    constexpr int K_OFF = 256 * QP, KB = 64 * QP, V_OFF = K_OFF + 2 * KB, VB = 64 * VP;
    constexpr float RESCALE_T = 8.f;
    static_assert(V_OFF + 2 * VB <= LDS_BYTES, "attention LDS");
    const int tid = tid_(), wid = tid >> 6, lane = tid & 63, l31 = lane & 31, h = lane >> 5;
    {
        const int row = tid >> 1, hh = tid & 1;
        const bf16_t* qr = qbase + (size_t)row * ldq;
        unsigned char* qd = smem + row * QP;
        const int tq = t0 + row, rp = tq >> 6, cp = tq & 63;
        if constexpr (DQK == 64) {
            u32x4 c[4];
#pragma unroll
            for (int j = 0; j < 4; ++j) c[j] = *(const u32x4*)(qr + 32 * hh + 8 * j);
            const float2* tab = hh ? (tabC + cp * 16) : (tabR + rp * 16);
            rot8_scale(c[0], c[2], tab, rope, qscale);
            rot8_scale(c[1], c[3], tab + 8, rope, qscale);
#pragma unroll
            for (int j = 0; j < 4; ++j) *(u32x4*)(qd + (32 * hh + 8 * j) * 2) = c[j];
        } else {
            u32x4 c[6];
#pragma unroll
            for (int j = 0; j < 6; ++j) c[j] = *(const u32x4*)(qr + 48 * hh + 8 * j);
            if (hh) {
                scale8(c[0], qscale); scale8(c[1], qscale);
                rot8_scale(c[2], c[3], tabR + rp * 8, rope, qscale);
                rot8_scale(c[4], c[5], tabC + cp * 8, rope, qscale);
            } else {
#pragma unroll
                for (int j = 0; j < 6; ++j) scale8(c[j], qscale);
            }
#pragma unroll
            for (int j = 0; j < 6; ++j) *(u32x4*)(qd + (48 * hh + 8 * j) * 2) = c[j];
        }
    }
    __syncthreads();
    const unsigned char* qlane = smem + (32 * wid + l31) * QP + 16 * h;
    bf16x8 qfix[NKS];
    if constexpr (FAST) {
#pragma unroll
        for (int ks = 0; ks < NKS; ++ks) qfix[ks] = *(const bf16x8*)(qlane + 32 * ks);
    }

    const int nA = lenA >> 6, nT = nA + (lenB >> 6);
    u32x4 kr0, kr1, vr;
    const int kidx1 = min(tid + 512, 64 * CPK - 1);
    const int kkey0 = tid / CPK, kc0 = tid % CPK, kkey1 = kidx1 / CPK, kc1 = kidx1 % CPK;
    const int koff0 = (kc0 < 8) ? kkey0 * ldk1 + 8 * kc0 : kkey0 * 32 + 8 * (kc0 - 8);
    const int koff1 = (kc1 < 8) ? kkey1 * ldk1 + 8 * kc1 : kkey1 * 32 + 8 * (kc1 - 8);
    const int voff = (tid >> 3) * ldv + 8 * (tid & 7);
    auto gloadK = [&](int j) {
        const int jj = min(j, nT - 1);
        const int row0 = (jj < nA) ? rowA + 64 * jj : rowB + 64 * (jj - nA);
        const bf16_t* b1 = k1 + (size_t)row0 * ldk1; const bf16_t* b2 = k2 + (size_t)row0 * 32;
        kr0 = *(const u32x4*)(((kc0 < 8) ? b1 : b2) + koff0);
        if constexpr (DQK == 96) { if (tid < 256) kr1 = *(const u32x4*)(((kc1 < 8) ? b1 : b2) + koff1); }
    };
    auto gloadV = [&](int j) {
        const int jj = min(j, nT - 1);
        const int row0 = (jj < nA) ? rowA + 64 * jj : rowB + 64 * (jj - nA);
        vr = *(const u32x4*)(vb + (size_t)row0 * ldv + voff);
    };
    const int ksoff0 = kkey0 * QP + 16 * kc0, ksoff1 = kkey1 * QP + 16 * kc1, vsoff = (tid >> 3) * VP + 16 * (tid & 7);
    auto sstoreK = [&](int buf) {
        *(u32x4*)(smem + K_OFF + buf * KB + ksoff0) = kr0;
        if constexpr (DQK == 96) { if (tid < 256) *(u32x4*)(smem + K_OFF + buf * KB + ksoff1) = kr1; }
    };
    auto sstoreV = [&](int buf) { *(u32x4*)(smem + V_OFF + buf * VB + vsoff) = vr; };

    f32x16 O0, O1, negm;
    float mref = m0;
#pragma unroll
    for (int i = 0; i < 16; ++i) { O0[i] = 0.f; O1[i] = 0.f; negm[i] = -m0; }
    float lsum = l0 * (h == 0 ? 1.f : 0.f);
    const int qpos = t0 + 32 * wid + l31;
    const int q4 = (lane & 15) >> 2, p4 = lane & 3, blk = (lane >> 4) & 1;
    const int vlane = (4 * h + q4) * VP + 32 * blk + 8 * p4;
    const int klane = l31 * QP + 16 * h;

    auto kfrags = [&](int buf, bf16x8 (&kf0)[NKS], bf16x8 (&kf1)[NKS]) {
        const unsigned char* Kt = smem + K_OFF + buf * KB + klane;
#pragma unroll
        for (int ks = 0; ks < NKS; ++ks) { kf0[ks] = *(const bf16x8*)(Kt + 32 * ks); kf1[ks] = *(const bf16x8*)(Kt + 32 * QP + 32 * ks); }
    };
    f32x16 zacc;
#pragma unroll
    for (int i = 0; i < 16; ++i) zacc[i] = 0.f;
    auto qk = [&](const bf16x8 (&kf0)[NKS], const bf16x8 (&kf1)[NKS], int jt, f32x16& S0, f32x16& S1) {
#pragma unroll
        for (int ks = 0; ks < NKS; ++ks) {
            const bf16x8 qv = *(const bf16x8*)(qlane + 32 * ks);
            if (ks == 0) { S0 = MFMA32(kf0[0], qv, FAST ? negm : zacc); S1 = MFMA32(kf1[0], qv, FAST ? negm : zacc); }
            else { S0 = MFMA32(kf0[ks], qv, S0); S1 = MFMA32(kf1[ks], qv, S1); }
        }
        if constexpr (MASK) {
            const int d0 = (jt < nA) ? posA + 64 * jt - qpos : 0;
#pragma unroll
            for (int i = 0; i < 16; ++i) {
                const int dd = d0 + crow16(i, h);
                if (dd > 128 || dd < -128) S0[i] = -1e30f;
                if (dd + 32 > 128 || dd + 32 < -128) S1[i] = -1e30f;
            }
        }
    };

    gloadK(0); gloadV(0); sstoreK(0); sstoreV(0);
    gloadK(1); sstoreK(1);
    __syncthreads();
    bool bad = false;
    f32x16 SA0, SA1, SB0, SB1;
    {
        bf16x8 kf0[NKS], kf1[NKS];
        kfrags(0, kf0, kf1);
        qk(kf0, kf1, 0, SA0, SA1);
    }
    asm volatile("s_nop 15\n\ts_nop 15" ::: "memory");
    auto iter = [&](int j, f32x16& S0, f32x16& S1, f32x16& N0, f32x16& N1) {
        gloadK(j + 2);
        gloadV(j + 1);
        bf16x8 kf0[NKS], kf1[NKS];
        kfrags((j + 1) & 1, kf0, kf1);
        __builtin_amdgcn_sched_barrier(0);
        const bool first = (j == 0) && first_unclamped;
        float ps = 0.f;
        if constexpr (FAST) {
            const bf16x8 (&qv)[NKS] = qfix;
            if (first) {
                float mx = max3f(S0[0], S1[0], S0[1]);
                mx = max3f(mx, S1[1], S0[2]); mx = max3f(mx, S1[2], S0[3]); mx = max3f(mx, S1[3], S0[4]); mx = max3f(mx, S1[4], S0[5]);
                mx = max3f(mx, S1[5], S0[6]); mx = max3f(mx, S1[6], S0[7]); mx = max3f(mx, S1[7], S0[8]); mx = max3f(mx, S1[8], S0[9]);
                mx = max3f(mx, S1[9], S0[10]); mx = max3f(mx, S1[10], S0[11]); mx = max3f(mx, S1[11], S0[12]); mx = max3f(mx, S1[12], S0[13]);
                mx = max3f(mx, S1[13], S0[14]); mx = max3f(mx, S1[14], S0[15]); mx = fmaxf(mx, S1[15]);
                const float delta = fmaxf(mx, __shfl_xor(mx, 32)) + 10.f;
                mref += delta;
#pragma unroll
                for (int i = 0; i < 16; ++i) { S0[i] -= delta; S1[i] -= delta; negm[i] = -mref; }
            }
#pragma unroll
            for (int i = 0; i < 16; ++i) { S0[i] = __builtin_amdgcn_exp2f(S0[i]); ps += S0[i]; }
            __builtin_amdgcn_sched_barrier(0);
#pragma unroll
            for (int ks = 0; ks < NKS; ++ks) {
                if (ks == 0) { N0 = MFMA32(kf0[0], qv[0], negm); N1 = MFMA32(kf1[0], qv[0], negm); }
                else { N0 = MFMA32(kf0[ks], qv[ks], N0); N1 = MFMA32(kf1[ks], qv[ks], N1); }
            }
            __builtin_amdgcn_sched_barrier(0);
            lds_ptr Vt = lds3 + V_OFF + (j & 1) * VB + vlane;
            bf16x8 vf0[4], vf1[4];
#pragma unroll
            for (int ms = 0; ms < 4; ++ms) { vf0[ms] = tr_pair(Vt + 16 * ms * VP, 8 * VP); vf1[ms] = tr_pair(Vt + 16 * ms * VP + 64, 8 * VP); }
            __builtin_amdgcn_sched_barrier(0);
#pragma unroll
            for (int i = 0; i < 16; ++i) { S1[i] = __builtin_amdgcn_exp2f(S1[i]); ps += S1[i]; }
            bad = bad || !(ps < 8192.f);
            lsum += ps;
            u32x4 pw[4];
#pragma unroll
            for (int s = 0; s < 2; ++s) {
                pw[s].x = pk2(S0[8 * s], S0[8 * s + 1]); pw[s].y = pk2(S0[8 * s + 2], S0[8 * s + 3]); pw[s].z = pk2(S0[8 * s + 4], S0[8 * s + 5]); pw[s].w = pk2(S0[8 * s + 6], S0[8 * s + 7]);
                pw[2 + s].x = pk2(S1[8 * s], S1[8 * s + 1]); pw[2 + s].y = pk2(S1[8 * s + 2], S1[8 * s + 3]); pw[2 + s].z = pk2(S1[8 * s + 4], S1[8 * s + 5]); pw[2 + s].w = pk2(S1[8 * s + 6], S1[8 * s + 7]);
            }
            __builtin_amdgcn_sched_barrier(0);
#pragma unroll
            for (int ms = 0; ms < 4; ++ms) {
                const bf16x8 pf = __builtin_bit_cast(bf16x8, pw[ms]);
                O0 = MFMA32(vf0[ms], pf, O0);
                O1 = MFMA32(vf1[ms], pf, O1);
            }
            sstoreK(j & 1);
            sstoreV((j + 1) & 1);
            __syncthreads();
            return;
        } else {
            float mx = max3f(S0[0], S1[0], S0[1]);
            mx = max3f(mx, S1[1], S0[2]); mx = max3f(mx, S1[2], S0[3]); mx = max3f(mx, S1[3], S0[4]); mx = max3f(mx, S1[4], S0[5]);
            mx = max3f(mx, S1[5], S0[6]); mx = max3f(mx, S1[6], S0[7]); mx = max3f(mx, S1[7], S0[8]); mx = max3f(mx, S1[8], S0[9]);
            mx = max3f(mx, S1[9], S0[10]); mx = max3f(mx, S1[10], S0[11]); mx = max3f(mx, S1[11], S0[12]); mx = max3f(mx, S1[12], S0[13]);
            mx = max3f(mx, S1[13], S0[14]); mx = max3f(mx, S1[14], S0[15]); mx = fmaxf(mx, S1[15]);
            if (first || __any(mx - mref > RESCALE_T)) {
                const float mxf = fmaxf(mx, __shfl_xor(mx, 32));
                const float mnew = first ? mxf : fmaxf(mxf, mref);
                const float alpha = __builtin_amdgcn_exp2f(mref - mnew);
                mref = mnew; lsum *= alpha;
#pragma unroll
                for (int i = 0; i < 16; ++i) { O0[i] *= alpha; O1[i] *= alpha; }
            }
            qk(kf0, kf1, j + 1, N0, N1);
#pragma unroll
            for (int i = 0; i < 16; ++i) { S0[i] = __builtin_amdgcn_exp2f(S0[i] - mref); S1[i] = __builtin_amdgcn_exp2f(S1[i] - mref); ps += S0[i] + S1[i]; }
        }
        lsum += ps;
        lds_ptr Vt = lds3 + V_OFF + (j & 1) * VB + vlane;
#pragma unroll
        for (int mt = 0; mt < 2; ++mt)
#pragma unroll
            for (int s = 0; s < 2; ++s) {
                u32x4 pw;
                if (mt == 0) { pw.x = pk2(S0[8 * s], S0[8 * s + 1]); pw.y = pk2(S0[8 * s + 2], S0[8 * s + 3]); pw.z = pk2(S0[8 * s + 4], S0[8 * s + 5]); pw.w = pk2(S0[8 * s + 6], S0[8 * s + 7]); }
                else { pw.x = pk2(S1[8 * s], S1[8 * s + 1]); pw.y = pk2(S1[8 * s + 2], S1[8 * s + 3]); pw.z = pk2(S1[8 * s + 4], S1[8 * s + 5]); pw.w = pk2(S1[8 * s + 6], S1[8 * s + 7]); }
                const bf16x8 pf = __builtin_bit_cast(bf16x8, pw);
                const bf16x8 v0 = tr_pair(Vt + (32 * mt + 16 * s) * VP, 8 * VP);
                const bf16x8 v1 = tr_pair(Vt + (32 * mt + 16 * s) * VP + 64, 8 * VP);
                O0 = MFMA32(v0, pf, O0);
                O1 = MFMA32(v1, pf, O1);
            }
        sstoreK(j & 1);
        sstoreV((j + 1) & 1);
        __syncthreads();
    };
    for (int j = 0; j < nT; j += 2) {
        iter(j, SA0, SA1, SB0, SB1);
        iter(j + 1, SB0, SB1, SA0, SA1);
    }
    if constexpr (FAST) { if (__syncthreads_or((int)bad)) return false; }
    const float ltot = lsum + __shfl_xor(lsum, 32);
    const float inv = 1.f / ltot;
    bf16_t* orow = ob + (size_t)(32 * wid + l31) * 1024;
#pragma unroll
    for (int g4 = 0; g4 < 4; ++g4) {
        u32x2 o0, o1;
        o0.x = pk2(O0[4 * g4] * inv, O0[4 * g4 + 1] * inv); o0.y = pk2(O0[4 * g4 + 2] * inv, O0[4 * g4 + 3] * inv);
        o1.x = pk2(O1[4 * g4] * inv, O1[4 * g4 + 1] * inv); o1.y = pk2(O1[4 * g4 + 2] * inv, O1[4 * g4 + 3] * inv);
        *(u32x2*)(orow + 8 * g4 + 4 * h) = o0;
        *(u32x2*)(orow + 32 + 8 * g4 + 4 * h) = o1;
    }
    return true;
}

DI void sgu_item(unsigned char* smem, lds_ptr lds3, const Params& p, int l, int c) {
    constexpr int VPB = 576;
    const int tid = tid_(), wid = tid >> 6, lane = tid & 63, l31 = lane & 31, h = lane >> 5;
    unsigned char* U = p.ws + WS_U;
    const bf16_t* VG = (const bf16_t*)(U + U_VG); const bf16_t* UG = (const bf16_t*)(U + U_UG);
    bf16_t* YC = (bf16_t*)(U + U_YCAT);
    const bf16_t* WSG = (const bf16_t*)(p.ws + W_SGU);
    const float* bs = p.in[17] + l * 512;
    const int row0 = c * 128;
#pragma unroll
    for (int i = 0; i < 8; ++i) {
        const int idx = tid + 512 * i, rr = idx >> 5, ch = idx & 31;
        const u32x4 v = *(const u32x4*)(VG + (size_t)(row0 + rr) * 256 + 8 * ch);
        *(u32x4*)(smem + rr * VPB + 16 * ch) = v;
    }
    __syncthreads();
    const int hd = wid >> 1, ph = wid & 1;
    f32x16 C00, C01, C10, C11;
#pragma unroll
    for (int i = 0; i < 16; ++i) { C00[i] = 0.f; C01[i] = 0.f; C10[i] = 0.f; C11[i] = 0.f; }
    const int q4 = (lane & 15) >> 2, p4 = lane & 3, blk = (lane >> 4) & 1;
    lds_ptr vbase = lds3 + (8 * h + q4) * VPB + (hd * 64 + 16 * blk) * 2 + 8 * p4;
    const bf16_t* wb = WSG + (size_t)(hd * 128 + 64 * ph + l31) * 128 + 8 * h;
#pragma unroll
    for (int ks = 0; ks < 8; ++ks) {
        const bf16x8 A0 = tr_pair(vbase + 16 * ks * VPB, 4 * VPB);
        const bf16x8 A1 = tr_pair(vbase + 16 * ks * VPB + 64, 4 * VPB);
        const bf16x8 B0 = *(const bf16x8*)(wb + 16 * ks);
        const bf16x8 B1 = *(const bf16x8*)(wb + 32 * 128 + 16 * ks);
        C00 = MFMA32(A0, B0, C00); C01 = MFMA32(A0, B1, C01);
        C10 = MFMA32(A1, B0, C10); C11 = MFMA32(A1, B1, C11);
    }
#pragma unroll
    for (int pt = 0; pt < 2; ++pt) {
        const int pp = 64 * ph + 32 * pt + l31, row = row0 + pp;
        const float bias = bs[hd * 128 + pp];
#pragma unroll
        for (int dt = 0; dt < 2; ++dt)
#pragma unroll
            for (int g4 = 0; g4 < 4; ++g4) {
                const int d0 = 32 * dt + 8 * g4 + 4 * h;
                const u32x2 uu = *(const u32x2*)(UG + (size_t)row * 256 + hd * 64 + d0);
                float c0, c1, c2, c3;
                if (dt == 0 && pt == 0) { c0 = C00[4 * g4]; c1 = C00[4 * g4 + 1]; c2 = C00[4 * g4 + 2]; c3 = C00[4 * g4 + 3]; }
                else if (dt == 0) { c0 = C01[4 * g4]; c1 = C01[4 * g4 + 1]; c2 = C01[4 * g4 + 2]; c3 = C01[4 * g4 + 3]; }
                else if (pt == 0) { c0 = C10[4 * g4]; c1 = C10[4 * g4 + 1]; c2 = C10[4 * g4 + 2]; c3 = C10[4 * g4 + 3]; }
                else { c0 = C11[4 * g4]; c1 = C11[4 * g4 + 1]; c2 = C11[4 * g4 + 2]; c3 = C11[4 * g4 + 3]; }
                u32x2 o;
                o.x = pk2((c0 + bias) * lo_f(uu.x), (c1 + bias) * hi_f(uu.x));
                o.y = pk2((c2 + bias) * lo_f(uu.y), (c3 + bias) * hi_f(uu.y));
                *(u32x2*)(YC + (size_t)row * 1024 + 768 + hd * 64 + d0) = o;
            }
    }
    __syncthreads();
}

DI void phase_mix(const Params& p, int l, unsigned char* smem, lds_ptr lds3) {
    const int G = nblk_(), bid = bid_();
    unsigned char* U = p.ws + WS_U;
    const bf16_t* Z = (const bf16_t*)(U + U_Z);
    const bf16_t* QRAW = (const bf16_t*)(U + U_QRAW); const bf16_t* KVRAW = (const bf16_t*)(U + U_KVRAW);
    const bf16_t* KSR = (const bf16_t*)(p.ws + WS_KSR); const bf16_t* KRR = (const bf16_t*)(p.ws + WS_KRR);
    bf16_t* YC = (bf16_t*)(U + U_YCAT);
    const float2* tS = (const float2*)(p.ws + WS_TAB); const float2* tM = tS + 320 * 16;
    const float mla_scale = 0.10206207261596575f * LOG2E;
    const float swa_scale = 0.125f * LOG2E;
    unsigned failmask = 0u;
    for (int pass = 0; pass < 2; ++pass) {
        int slot = 0;
        for (int ii = bid; ii < 512 + G; ii += G, ++slot) {
            const int i = (ii < 512) ? ii : ((ii - 512 >= G - 8) ? 512 + (ii - 512 - (G - 8)) : -1);
            if (i < 0) continue;
            if (pass == 1 && !((failmask >> slot) & 1u)) continue;
            int b, hd, q0row, t0, rowA, lenA; bool rope;
            if (i < 512) { const int bh = i & 7, qt = i >> 3; b = bh >> 2; hd = bh & 3; t0 = qt * 256; q0row = b * SEQ + t0; rowA = b * SEQ; lenA = SEQ; rope = true; }
            else { const int k = i - 512; b = k >> 2; hd = k & 3; t0 = 0; q0row = NLAT + b * CTXL; rowA = 0; lenA = 0; rope = false; }
            if (pass == 0) {
                const bool ok = attn_item<96, false, true>(smem, lds3, tM, tM + 256 * 8, QRAW + (size_t)q0row * 512 + hd * 96, 512, rope, t0, mla_scale,
                              KVRAW + hd * 128, 512, KRR, KVRAW + hd * 128 + 64, 512,
                              rowA, lenA, 0, NLAT + b * CTXL, CTXL, 0.f, 0.f, true, YC + (size_t)q0row * 1024 + 512 + hd * 64);
                if (!ok) failmask |= 1u << slot;
            } else {
                attn_item<96, false, false>(smem, lds3, tM, tM + 256 * 8, QRAW + (size_t)q0row * 512 + hd * 96, 512, rope, t0, mla_scale,
                              KVRAW + hd * 128, 512, KRR, KVRAW + hd * 128 + 64, 512,
                              rowA, lenA, 0, NLAT + b * CTXL, CTXL, 0.f, 0.f, true, YC + (size_t)q0row * 1024 + 512 + hd * 64);
            }
        }
        if (failmask == 0u) break;
    }
    for (int ii = bid; ii < 512 + G; ii += G) {
        const int i = (ii < 512) ? ii : ((ii - 512 >= G - 16 && ii - 512 < G - 8) ? 512 + (ii - 512 - (G - 16)) : -1);
        if (i < 0) continue;
        int b, hd, q0row, t0, rowA, lenA, posA; bool rope;
        if (i < 512) {
            const int bh = i & 7, qt = i >> 3; b = bh >> 2; hd = bh & 3; t0 = qt * 256; q0row = b * SEQ + t0; rope = true;
            posA = max(t0 - 128, 0); const int endA = min(t0 + 384, SEQ); rowA = b * SEQ + posA; lenA = endA - posA;
        } else { const int k = i - 512; b = k >> 2; hd = k & 3; t0 = 0; q0row = NLAT + b * CTXL; rowA = 0; lenA = 0; posA = 0; rope = false; }
        const int kvh = hd >> 1;
        const float sink = p.in[9][l * 4 + hd] * LOG2E;
        attn_item<64, true>(smem, lds3, tS, tS + 256 * 16, Z + (size_t)q0row * DINP + C_SWA_Q + hd * 64, DINP, rope, t0, swa_scale,
                      KSR + kvh * 64, 128, nullptr, Z + C_SWA_V + kvh * 64, DINP,
                      rowA, lenA, posA, NLAT + b * CTXL, CTXL, sink, 1.f, false, YC + (size_t)q0row * 1024 + 256 + hd * 64);
    }
    for (int c = bid; c < 260; c += G) sgu_item(smem, lds3, p, l, c);
}

#define XB_TMO      128
#define XB_XCNT(j)  (256  + 64 * (j))
#define XB_XSUB(j)  (1280 + 64 * (j))
#define XB_XGEN(j)  (2304 + 64 * (j))
#define XB_TOP      3328
#define XB_TOPGEN   3392
#define XCD_BAR_WORDS 3456
#define XB_SPIN_CAP (1u << 18)
#define LAS __attribute__((address_space(3)))

__device__ __forceinline__ unsigned xb_ld(unsigned* p)              { return __hip_atomic_load(p, __ATOMIC_RELAXED, __HIP_MEMORY_SCOPE_AGENT); }
__device__ __forceinline__ unsigned xb_add(unsigned* p, unsigned v) { return __hip_atomic_fetch_add(p, v, __ATOMIC_RELAXED, __HIP_MEMORY_SCOPE_AGENT); }
__device__ __forceinline__ unsigned xb_xcc_id() { return (unsigned)__builtin_amdgcn_s_getreg((3 << 11) | 20) & 0xFu; }
#define XB_SPIN(cond, bar) do { unsigned _sp = 0; while (cond) { __builtin_amdgcn_s_sleep(1); \
    if ((++_sp & 255u) == 0u) { if (xb_ld(&(bar)[XB_TMO])) break; if (_sp > XB_SPIN_CAP) { atomicAdd(&(bar)[XB_TMO], 1u); break; } } } } while (0)

struct XcdBarrier {
    unsigned* bar; unsigned x;
    volatile LAS unsigned* st;
};

__device__ __forceinline__ XcdBarrier xcd_barrier_post(unsigned* bar, volatile LAS unsigned* st) {
    XcdBarrier b; b.bar = bar; b.x = xb_xcc_id(); b.st = st;
    if (threadIdx.x == 0) (void)xb_add(&bar[XB_XCNT(b.x)], 1u);
    return b;
}
__device__ __forceinline__ void xcd_barrier_complete(unsigned* bar, unsigned x, unsigned& nloc, unsigned& nx) {
    const unsigned G = gridDim.x * gridDim.y * gridDim.z;
    unsigned sum, cnt, mine, sp = 0u;
    for (;;) {
        sum = 0u; cnt = 0u; mine = 0u;
#pragma unroll
        for (unsigned j = 0; j < 16; ++j) { const unsigned c = xb_ld(&bar[XB_XCNT(j)]); sum += c; cnt += (c > 0u) ? 1u : 0u; mine = (j == x) ? c : mine; }
        if (sum == G) break;
        __builtin_amdgcn_s_sleep(1);
        if ((++sp & 255u) == 0u) { if (xb_ld(&bar[XB_TMO])) break; if (sp > XB_SPIN_CAP) { atomicAdd(&bar[XB_TMO], 1u); break; } }
    }
    nloc = mine > 0u ? mine : 1u; nx = cnt > 0u ? cnt : 1u;
}

__device__ __forceinline__ void xcd_barrier(const XcdBarrier& b) {
    asm volatile("s_waitcnt vmcnt(0)" ::: "memory");
    __syncthreads();
    if (threadIdx.x == 0) {
        unsigned* bar = b.bar;
        __builtin_amdgcn_s_waitcnt(0);
        unsigned nloc = b.st[0], nx = b.st[1];
        if (nloc == 0u) { xcd_barrier_complete(bar, b.x, nloc, nx); b.st[0] = nloc; b.st[1] = nx; }
        const unsigned old = xb_add(&bar[XB_XSUB(b.x)], 1u);
        const unsigned gen = old / nloc;
        if (old + 1u == (gen + 1u) * nloc) {
            __builtin_amdgcn_fence(__ATOMIC_RELEASE, "agent");
            asm volatile("s_waitcnt vmcnt(0)" ::: "memory");
            const unsigned og = xb_add(&bar[XB_TOP], 1u);
            const unsigned tg = og / nx;
            if (og + 1u == (tg + 1u) * nx) xb_add(&bar[XB_TOPGEN], 1u);
            else XB_SPIN(xb_ld(&bar[XB_TOPGEN]) == tg, bar);
            __builtin_amdgcn_fence(__ATOMIC_ACQUIRE, "agent");
            xb_add(&bar[XB_XGEN(b.x)], 1u);
            asm volatile("s_waitcnt vmcnt(0)" ::: "memory");
        } else {
            XB_SPIN(xb_ld(&bar[XB_XGEN(b.x)]) == gen, bar);
            __builtin_amdgcn_fence(__ATOMIC_ACQUIRE, "agent");
            asm volatile("s_waitcnt vmcnt(0)" ::: "memory");
        }
    }
    __syncthreads();
}


DI void grid_bar(lds_ptr lds3) {
    XcdBarrier b; b.bar = (unsigned*)(params_().ws + WS_BAR); b.x = xb_xcc_id(); b.st = (volatile LAS unsigned*)(lds3 + LDS_BYTES);
    xcd_barrier(b);
}

__global__ __launch_bounds__(512, 2) void fwd_megakernel(Params p_unused) {
    extern __shared__ __attribute__((aligned(16))) unsigned char smem[];
    cg::grid_group grid = cg::this_grid();
    lds_ptr lds3 = (lds_ptr)smem;
    {
        const Params& p = params_();
        if (blockIdx.x == 0) { unsigned* bw = (unsigned*)(p.ws + WS_BAR); for (int i = threadIdx.x; i < XCD_BAR_WORDS; i += 512) bw[i] = 0u; }
        if (threadIdx.x == 0) { *(volatile LAS unsigned*)(lds3 + LDS_BYTES) = 0u; *(volatile LAS unsigned*)(lds3 + LDS_BYTES + 4) = 0u; }
        phase_adaln(p, (float*)smem);
        phase_tables(p);
        convert_layer(p, 0, smem);
    }
    grid.sync();
    (void)xcd_barrier_post((unsigned*)(params_().ws + WS_BAR), (volatile LAS unsigned*)(lds3 + LDS_BYTES));
    {
        const Params& p = params_();
        phase_ln(p, 0, nullptr, nullptr, (const float*)(p.ws + WS_MOD), 0);
    }
    grid_bar(lds3);
    for (int l = 0; l < DEPTH; ++l) {
        {
            const Params& p = params_(); unsigned char* U = p.ws + WS_U;
            pg8::EpiBf16<0> E; E.O = (bf16_t*)(U + U_Z); E.ldc = DINP; E.bias = nullptr; E.split_cols = 0; E.split_stride = 0;
            run_gemm(lds3, (const bf16_t*)(U + U_H), (const bf16_t*)(p.ws + W_IN), R, DINP, 1024, E);
        }
        grid_bar(lds3);
        phase_postz(params_(), l);
        grid_bar(lds3);
        {
            const Params& p = params_(); unsigned char* U = p.ws + WS_U;
            pg8::EpiBf16<0> E; E.bias = nullptr; E.split_cols = 0; E.split_stride = 0;
            E.O = (bf16_t*)(U + U_QRAW); E.ldc = 512;
            run_gemm(lds3, (const bf16_t*)(U + U_CQN), (const bf16_t*)(p.ws + W_UQ), R, 512, 256, E);
        }
        {
            const Params& p = params_(); unsigned char* U = p.ws + WS_U;
            pg8::EpiBf16<0> E; E.bias = nullptr; E.split_cols = 0; E.split_stride = 0;
            E.O = (bf16_t*)(U + U_KVRAW); E.ldc = 512;
            run_gemm(lds3, (const bf16_t*)(U + U_CKVN), (const bf16_t*)(p.ws + W_UKV), R, 512, 256, E, nblk_() - 8);
        }
        {
            const Params& p = params_(); unsigned char* U = p.ws + WS_U;
            pg8::EpiBf16<0> E; E.bias = nullptr; E.split_cols = 0; E.split_stride = 0;
            E.O = (bf16_t*)(U + U_YCAT); E.ldc = 1024;
            run_gemm(lds3, (const bf16_t*)(U + U_DPOOL), (const bf16_t*)(p.ws + W_POOL), R, 256, 256, E, nblk_() - 16);
        }
        grid_bar(lds3);
        phase_mix(params_(), l, smem, lds3);
        grid_bar(lds3);
        {
            const Params& p = params_(); unsigned char* U = p.ws + WS_U;
            EpiScaleBf16 E; E.O = (bf16_t*)(U + U_Z); E.modl = (const float*)(p.ws + WS_MOD) + (size_t)l * 3 * 6144; E.idx = 2;
            run_gemm(lds3, (const bf16_t*)(U + U_YCAT), (const bf16_t*)(p.ws + W_OUT), (l + 1 < DEPTH) ? R : NLAT, 1024, 1024, E);
        }
        grid_bar(lds3);
        {
            const Params& p = params_();
            phase_ln(p, 1, p.in[19] + l * 1024, p.in[20] + l * 1024, (const float*)(p.ws + WS_MOD) + (size_t)l * 3 * 6144, 3,
                     (const bf16_t*)(p.ws + WS_U + U_Z), (l + 1 < DEPTH) ? R : NLAT);
        }
        grid_bar(lds3);
        {
            const Params& p = params_(); unsigned char* U = p.ws + WS_U;
            EpiRelu2 E; E.O = (bf16_t*)(U + U_F1); E.ldc = 4096;
            run_gemm(lds3, (const bf16_t*)(U + U_H), (const bf16_t*)(p.ws + W_FF1), (l + 1 < DEPTH) ? R : NLAT, 4096, 1024, E);
        }
        grid_bar(lds3);
        {
            const Params& p = params_(); unsigned char* U = p.ws + WS_U;
            EpiScaleBf16 E; E.O = (bf16_t*)(U + U_H); E.modl = (const float*)(p.ws + WS_MOD) + (size_t)l * 3 * 6144; E.idx = 5;
            run_gemm(lds3, (const bf16_t*)(U + U_F1), (const bf16_t*)(p.ws + W_FF2), (l + 1 < DEPTH) ? R : NLAT, 1024, 4096, E);
        }
        grid_bar(lds3);
        {
            const Params& p = params_();
            const float* modl = (const float*)(p.ws + WS_MOD) + (size_t)l * 3 * 6144;
            if (l + 1 < DEPTH) {
                phase_ln(p, 1, p.in[23] + l * 1024, p.in[24] + l * 1024, modl + 3 * 6144, 0, (const bf16_t*)(p.ws + WS_U + U_H));
                convert_layer(p, l + 1, smem);
            } else {
                phase_ln(p, 2, p.in[23] + l * 1024, p.in[24] + l * 1024, modl, 0, (const bf16_t*)(p.ws + WS_U + U_H));
            }
        }
        grid_bar(lds3);
    }
}

extern "C" void kernel_launch(void* const* d_in, const int* in_sizes, int n_in, void* d_out, int out_size, void* d_ws, size_t ws_size, hipStream_t stream) {
    static int grid_blocks = 0;
    if (!grid_blocks) {
        int dev = 0, cus = 0, per_cu = 0;
        hipGetDevice(&dev);
        hipDeviceGetAttribute(&cus, hipDeviceAttributeMultiprocessorCount, dev);
        if (hipFuncSetAttribute((const void*)fwd_megakernel, hipFuncAttributeMaxDynamicSharedMemorySize, LDS_ALLOC) != hipSuccess)
            fprintf(stderr, "kernel_launch: hipFuncSetAttribute(%d B LDS) failed\n", LDS_BYTES);
        if (hipOccupancyMaxActiveBlocksPerMultiprocessor(&per_cu, (const void*)fwd_megakernel, 512, LDS_ALLOC) != hipSuccess || per_cu < 1) per_cu = 1;
        (void)hipGetLastError();
        grid_blocks = cus * per_cu;
        if (ws_size < WS_END) fprintf(stderr, "kernel_launch: workspace %zu < needed %zu\n", ws_size, (size_t)WS_END);
    }
    Params p{};
    for (int i = 0; i < 25; ++i) p.in[i] = (const float*)d_in[i];
    p.out = (float*)d_out; p.ws = (unsigned char*)d_ws;
    void* args[] = {&p};
    hipError_t e = hipLaunchCooperativeKernel((const void*)fwd_megakernel, dim3(grid_blocks), dim3(512), args, LDS_ALLOC, stream);
    if (e != hipSuccess) fprintf(stderr, "cooperative launch failed: %s (grid %d)\n", hipGetErrorString(e), grid_blocks);
}
```

```cpp
#include <hip/hip_runtime.h>
#include <hip/hip_cooperative_groups.h>
#include <cstdio>
namespace cg = cooperative_groups;
namespace pg8 {
#define PG8_LAS __attribute__((address_space(3)))
typedef unsigned short bf16_t;
typedef short bf16x8 __attribute__((ext_vector_type(8)));
typedef float f32x4 __attribute__((ext_vector_type(4)));
typedef unsigned u32x4 __attribute__((ext_vector_type(4)));
constexpr int BM = 256, BK = 64, HALF = 128, HTB = HALF * BK * 2  , STAGE_BYTES = 8 * HTB, NXCD = 8, WGM = 8;

__host__ __device__ __forceinline__ int lds_byte(int r, int c) { const int st = (r >> 4) * 2 + (c >> 5), rr = r & 15, cc = c & 31, ob = rr * 64 + cc * 2; return st * 1024 + (ob ^ (((ob >> 9) & 1) << 5)); }
__host__ __device__ __forceinline__ void stage_rc(int b, int& R, int& C) { const int st = b / 1024, sb = b % 1024, swz = sb ^ (((sb >> 9) & 1) << 5); R = (st >> 1) * 16 + swz / 64; C = (st & 1) * 32 + (swz % 64) / 2; }
__host__ __device__ __forceinline__ int perm32(int rho) { const int n = rho >> 4, i = rho & 15; return 8 * (i >> 2) + 4 * n + (i & 3); }

struct Unit { int pm, pn; };
struct Gemm { const bf16_t* A; const bf16_t* Bt; int M, N, K; };

struct StaticOrder {
    int nM, nN, nwg, G, c;
    __host__ __device__ void init(int M, int N, int G_, int c_) { nM = M / BM; nN = N / BM; nwg = nM * nN; G = G_; c = c_; }
    __host__ __device__ bool next(int i, Unit& u) const {
        const long L = (long)i * G + c; if (L >= nwg) return false;
        int wgid = (int)L; { const int q = nwg / NXCD, r = nwg % NXCD, xcd = wgid % NXCD, off = wgid / NXCD; wgid = (xcd < r ? xcd * (q + 1) : r * (q + 1) + (xcd - r) * q) + off; }
        const int nig = WGM * nN, gid = wgid / nig, fm = gid * WGM, gsz = (nM - fm) < WGM ? (nM - fm) : WGM;
        u.pm = fm + ((wgid % nig) % gsz); u.pn = (wgid % nig) / gsz; return true;
    }
    __device__ __forceinline__ void a_ready(const Unit&) const {}
    __device__ __forceinline__ void done(const Unit&) const {}
};
struct CountedOrder : StaticOrder {
    const unsigned* ready; unsigned need; unsigned* tmo;
    __device__ __forceinline__ void a_ready(const Unit& u) const {
        if (threadIdx.x < 64) {
            const unsigned long long t0 = __builtin_amdgcn_s_memrealtime(); unsigned polls = 0;
            while ((unsigned)__builtin_amdgcn_readfirstlane(__hip_atomic_load(ready + 64 * u.pm, __ATOMIC_RELAXED, __HIP_MEMORY_SCOPE_AGENT)) < need) {
                if ((++polls & 255u) == 0u && __builtin_amdgcn_readfirstlane(__hip_atomic_load(tmo, __ATOMIC_RELAXED, __HIP_MEMORY_SCOPE_AGENT)) != 0u) break;
                if (__builtin_amdgcn_s_memrealtime() - t0 > 2000000ull) {
                    if (threadIdx.x == 0) { unsigned expect = 0u; __hip_atomic_compare_exchange_strong(tmo + 1, &expect, 0x600u | (unsigned)(u.pm & 0xff), __ATOMIC_RELAXED, __ATOMIC_RELAXED, __HIP_MEMORY_SCOPE_AGENT); __hip_atomic_store(tmo, 1u, __ATOMIC_RELAXED, __HIP_MEMORY_SCOPE_AGENT); }
                    break; }
                __builtin_amdgcn_s_sleep(2); }
            __builtin_amdgcn_fence(__ATOMIC_ACQUIRE, "agent");
            asm volatile("s_waitcnt vmcnt(0)" ::: "memory");
        }
#if !defined(BROKEN_HOOK_NO_BARRIER)
        asm volatile("" ::: "memory"); __builtin_amdgcn_s_barrier(); asm volatile("" ::: "memory");
#endif
    }
};

__device__ __forceinline__ unsigned cvt_pk_bf16(float lo, float hi) { unsigned r; asm volatile("v_cvt_pk_bf16_f32 %0, %1, %2" : "=v"(r) : "v"(lo), "v"(hi)); return r; }
typedef float f32x2 __attribute__((ext_vector_type(2)));
__device__ __forceinline__ f32x2 gelu_pk(f32x2 v) {
    const f32x2 av = __builtin_elementwise_abs(v), d = av * 0.2316418882f + 1.0f;
    f32x2 t; t.x = __builtin_amdgcn_rcpf(d.x); t.y = __builtin_amdgcn_rcpf(d.y);
    f32x2 q = t * 0.5307027145f + (-0.7265760135f); q = q * t + 0.7107068705f; q = q * t + (-0.142248368f); q = q * t + 0.127414796f; q = q * t;
    const f32x2 s = (v * v) * (-0.72134752044f);
    f32x2 e; e.x = __builtin_amdgcn_exp2f(s.x); e.y = __builtin_amdgcn_exp2f(s.y);
    const f32x2 m = v * (q * e), r = v - m;
    f32x2 o; o.x = v.x < 0.f ? m.x : r.x; o.y = v.y < 0.f ? m.y : r.y; return o;
}

struct EpiF32 {
    static constexpr bool PERM = false, AFTER_DRAIN = false;
    float* C; int ldc; const float* bias;
    __device__ __forceinline__ void operator()(const f32x4 (&acc)[2][2][4][2], const Unit& u, int wr, int wc, int fr, int fq) const {
        const int row0 = u.pm * BM + wr * 64 + fr, col0 = u.pn * BM + wc * 32 + 4 * fq;
        f32x4 bv[2][2];
#pragma unroll
        for (int bj = 0; bj < 2; ++bj)
#pragma unroll
            for (int n = 0; n < 2; ++n) bv[bj][n] = bias ? *(const f32x4*)(bias + col0 + bj * HALF + n * 16) : (f32x4){0.f, 0.f, 0.f, 0.f};
#pragma unroll
        for (int ai = 0; ai < 2; ++ai)
#pragma unroll
            for (int m = 0; m < 4; ++m) { float* rowp = C + (size_t)(row0 + ai * HALF + m * 16) * ldc + col0;
#pragma unroll
                for (int bj = 0; bj < 2; ++bj)
#pragma unroll
                    for (int n = 0; n < 2; ++n) *(f32x4*)(rowp + bj * HALF + n * 16) = acc[ai][bj][m][n] + bv[bj][n]; }
    }
};
template <int ACT  > struct EpiBf16 {
    static constexpr bool PERM = true, AFTER_DRAIN = false;
    bf16_t* O; int ldc; const float* bias; int split_cols; size_t split_stride;
    __device__ __forceinline__ void operator()(const f32x4 (&acc)[2][2][4][2], const Unit& u, int wr, int wc, int fr, int fq) const {
        const int row0 = u.pm * BM + wr * 64 + fr; int colt = u.pn * BM; bf16_t* base = O;
        if (split_cols) { const int t = colt / split_cols; base += (size_t)t * split_stride; colt -= t * split_cols; }
        const int col0 = colt + wc * 32 + 8 * fq, bcol0 = u.pn * BM + wc * 32 + 8 * fq;
        f32x4 bv[2][2];
#pragma unroll
        for (int bj = 0; bj < 2; ++bj)
#pragma unroll
            for (int n = 0; n < 2; ++n) bv[bj][n] = bias ? *(const f32x4*)(bias + bcol0 + bj * HALF + 4 * n) : (f32x4){0.f, 0.f, 0.f, 0.f};
#pragma unroll
        for (int ai = 0; ai < 2; ++ai)
#pragma unroll
            for (int m = 0; m < 4; ++m) { bf16_t* rowp = base + (size_t)(row0 + ai * HALF + m * 16) * ldc + col0;
#pragma unroll
                for (int bj = 0; bj < 2; ++bj) { f32x4 v0 = acc[ai][bj][m][0] + bv[bj][0], v1 = acc[ai][bj][m][1] + bv[bj][1];
                    if (ACT == 1) { f32x2 a = gelu_pk((f32x2){v0[0], v0[1]}), b = gelu_pk((f32x2){v0[2], v0[3]}), c = gelu_pk((f32x2){v1[0], v1[1]}), d = gelu_pk((f32x2){v1[2], v1[3]});
                        v0 = (f32x4){a.x, a.y, b.x, b.y}; v1 = (f32x4){c.x, c.y, d.x, d.y}; }
                    if (ACT == 2) {
#pragma unroll
                        for (int j = 0; j < 4; ++j) { v0[j] = 0.5f * v0[j] * (1.0f + erff(v0[j] * 0.70710678f)); v1[j] = 0.5f * v1[j] * (1.0f + erff(v1[j] * 0.70710678f)); } }
                    u32x4 w; w.x = cvt_pk_bf16(v0[0], v0[1]); w.y = cvt_pk_bf16(v0[2], v0[3]); w.z = cvt_pk_bf16(v1[0], v1[1]); w.w = cvt_pk_bf16(v1[2], v1[3]);
                    *(u32x4*)(rowp + bj * HALF) = w; } }
    }
};
template <class Epi, class Sched, bool STAMP = false>
__device__ __forceinline__ void gemm_phase(PG8_LAS unsigned char* lds, const Gemm g, const Sched& S, const Epi& E, unsigned long long* stamps) {
    int tid_raw = threadIdx.x; asm volatile("" : "+v"(tid_raw)); const int tid = tid_raw, wid = __builtin_amdgcn_readfirstlane(tid >> 6), lane = tid & 63, wr = wid >> 2, wc = wid & 3, fr = lane & 15, fq = lane >> 4;
    const int K = g.K, nt = K / BK;
    int ts_lo = 0, ts_hi = 0, nts = 0; const unsigned long long rt_entry = STAMP ? (unsigned long long)wall_clock64() : 0ull;
#define PG8_STAMP() do { if (STAMP && wid == 0 && nts < 64) { const unsigned long long _c = (unsigned long long)clock64(); \
        ts_lo = (lane == nts) ? (int)(unsigned)_c : ts_lo; ts_hi = (lane == nts) ? (int)(unsigned)(_c >> 32) : ts_hi; ++nts; } } while (0)
    PG8_STAMP();
    unsigned voffA[2], voffB[2];
#pragma unroll
    for (int i = 0; i < 2; ++i) { int R, C; stage_rc(tid * 16 + i * 8192, R, C); const int Rb = Epi::PERM ? ((R & ~31) + perm32(R & 31)) : R;
        voffA[i] = (unsigned)(R * K + C) * 2u; voffB[i] = (unsigned)(Rb * K + C) * 2u; }
    const size_t kstep = (size_t)(BK * 2);
    const size_t hstep = (size_t)HALF * K * 2;
    const size_t tstep = 2 * hstep;
    const unsigned ldsw = (unsigned)wid * 1024u;
    const int aoff = lds_byte(wr * 64 + fr, fq * 8), boff = lds_byte(wc * 32 + fr, fq * 8);
#define PG8_SA(b, h) (((b) * 2 + (h)) * HTB)
#define PG8_SB(b, h) ((4 + (b) * 2 + (h)) * HTB)
#define PG8_STAGE(bufoff, gbase, voff) do { _Pragma("unroll") for (int _i = 0; _i < 2; ++_i) \
        __builtin_amdgcn_global_load_lds((const unsigned*)((const char*)(gbase) + (voff)[_i]), (PG8_LAS unsigned*)(lds + (bufoff) + ldsw + _i * 8192), 16, 0, 0); } while (0)
#define PG8_LDA(dst, b, h) do { _Pragma("unroll") for (int m = 0; m < 4; ++m) _Pragma("unroll") for (int k = 0; k < 2; ++k) dst[m][k] = *(const PG8_LAS bf16x8*)(lds + PG8_SA(b, h) + aoff + m * 2048 + k * 1024); } while (0)
#define PG8_LDB(dst, b, h) do { _Pragma("unroll") for (int n = 0; n < 2; ++n) _Pragma("unroll") for (int k = 0; k < 2; ++k) dst[n][k] = *(const PG8_LAS bf16x8*)(lds + PG8_SB(b, h) + boff + n * 2048 + k * 1024); } while (0)
#define PG8_MMA(ai, bj, At, Bt) do { __builtin_amdgcn_s_setprio(1); _Pragma("unroll") for (int m = 0; m < 4; ++m) _Pragma("unroll") for (int n = 0; n < 2; ++n) _Pragma("unroll") for (int k = 0; k < 2; ++k) \
        acc[ai][bj][m][n] = __builtin_amdgcn_mfma_f32_16x16x32_bf16(Bt[n][k], At[m][k], acc[ai][bj][m][n], 0, 0, 0); __builtin_amdgcn_s_setprio(0); } while (0)
#define PG8_WAIT_V(n) asm volatile("s_waitcnt vmcnt(" #n ")" ::: "memory")
#define PG8_WAIT_L(n) asm volatile("s_waitcnt lgkmcnt(" #n ")" ::: "memory")
#define PG8_BAR __builtin_amdgcn_s_barrier()
#define PG8_SCHED __builtin_amdgcn_sched_barrier(0)
    Unit cur, nxt; int ui = 0;
    if (!S.next(0, cur)) return;
    f32x4 acc[2][2][4][2];
#pragma unroll
    for (int a = 0; a < 2; ++a)
#pragma unroll
        for (int b = 0; b < 2; ++b)
#pragma unroll
            for (int m = 0; m < 4; ++m)
#pragma unroll
                for (int n = 0; n < 2; ++n) acc[a][b][m][n] = (f32x4){0.f, 0.f, 0.f, 0.f};
    bf16x8 At[4][2], B0[2][2], B1[2][2];
    const char* cA = (const char*)g.A + (size_t)cur.pm * tstep; const char* cB = (const char*)g.Bt + (size_t)cur.pn * tstep;
    S.a_ready(cur);
    PG8_STAGE(PG8_SB(0, 0), cB, voffB); PG8_STAGE(PG8_SA(0, 0), cA, voffA); PG8_STAGE(PG8_SB(0, 1), cB + hstep, voffB); PG8_STAGE(PG8_SA(0, 1), cA + hstep, voffA);
    if (wr == 1) PG8_BAR;
    PG8_WAIT_V(4); PG8_BAR;
    PG8_STAGE(PG8_SB(1, 0), cB + kstep, voffB); PG8_STAGE(PG8_SA(1, 0), cA + kstep, voffA); PG8_STAGE(PG8_SB(1, 1), cB + hstep + kstep, voffB);
    PG8_WAIT_V(6); PG8_BAR;
    PG8_STAMP();
    for (;;) {
        const bool has_next = S.next(ui + 1, nxt);
        const char* nA = has_next ? (const char*)g.A + (size_t)nxt.pm * tstep : cA; const char* nB = has_next ? (const char*)g.Bt + (size_t)nxt.pn * tstep : cB;
        for (int t = 0; t < nt; t += 2) {
            const bool last = (t == nt - 2);
            const char* a1 = cA + (size_t)(t + 1) * kstep;
            const char* a2 = last ? nA : cA + (size_t)(t + 2) * kstep; const char* b2 = last ? nB : cB + (size_t)(t + 2) * kstep;
            const char* a3 = a2 + kstep; const char* b3 = b2 + kstep;
            if (last && has_next) S.a_ready(nxt);
            PG8_LDB(B0, 0, 0); PG8_SCHED; PG8_LDA(At, 0, 0); PG8_STAGE(PG8_SA(1, 1), a1 + hstep, voffA);
            PG8_WAIT_L(8); PG8_BAR; PG8_WAIT_L(0); PG8_MMA(0, 0, At, B0); PG8_BAR; PG8_SCHED;
            PG8_LDB(B1, 0, 1); PG8_STAGE(PG8_SB(0, 0), b2, voffB);
            PG8_BAR; PG8_WAIT_L(0); PG8_MMA(0, 1, At, B1); PG8_BAR;
            PG8_LDA(At, 0, 1); PG8_STAGE(PG8_SA(0, 0), a2, voffA);
            PG8_BAR; PG8_WAIT_L(0); PG8_MMA(1, 0, At, B0); PG8_BAR; PG8_SCHED;
            PG8_STAGE(PG8_SB(0, 1), b2 + hstep, voffB);
            PG8_WAIT_V(6); PG8_BAR; PG8_MMA(1, 1, At, B1); PG8_BAR;
            PG8_LDB(B0, 1, 0); PG8_SCHED; PG8_LDA(At, 1, 0); PG8_STAGE(PG8_SA(0, 1), a2 + hstep, voffA);
            PG8_WAIT_L(8); PG8_BAR; PG8_WAIT_L(0); PG8_MMA(0, 0, At, B0); PG8_BAR; PG8_SCHED;
            PG8_LDB(B1, 1, 1); PG8_STAGE(PG8_SB(1, 0), b3, voffB);
            PG8_BAR; PG8_WAIT_L(0); PG8_MMA(0, 1, At, B1); PG8_BAR;
            PG8_LDA(At, 1, 1); PG8_STAGE(PG8_SA(1, 0), a3, voffA);
            PG8_BAR; PG8_WAIT_L(0); PG8_MMA(1, 0, At, B0); PG8_BAR; PG8_SCHED;
            PG8_STAGE(PG8_SB(1, 1), b3 + hstep, voffB);
            PG8_WAIT_V(6); PG8_BAR; PG8_MMA(1, 1, At, B1); PG8_BAR;
        }
        PG8_STAMP();
        if constexpr (!Epi::AFTER_DRAIN) { E(acc, cur, wr, wc, fr, fq); S.done(cur); }
        PG8_STAMP();
        if (!has_next) break;
#pragma unroll
        for (int a = 0; a < 2; ++a)
#pragma unroll
            for (int b = 0; b < 2; ++b)
#pragma unroll
                for (int m = 0; m < 4; ++m)
#pragma unroll
                    for (int n = 0; n < 2; ++n) acc[a][b][m][n] = (f32x4){0.f, 0.f, 0.f, 0.f};
        cur = nxt; cA = nA; cB = nB; ++ui;
    }
    PG8_WAIT_V(0);
    if (wr == 0) PG8_BAR;
    PG8_BAR;
    if constexpr (Epi::AFTER_DRAIN) { E.fused(acc, cur, wr, wc, fr, fq, lds, wid, lane); S.done(cur); }
    PG8_STAMP();
    if (STAMP && wid == 0) { stamps[lane] = lane < nts ? (((unsigned long long)(unsigned)ts_hi << 32) | (unsigned)ts_lo) : 0ull;
        if (lane == 62) stamps[62] = rt_entry; if (lane == 63) stamps[63] = (unsigned long long)wall_clock64(); }
#undef PG8_STAMP
#undef PG8_SA
#undef PG8_SB
#undef PG8_STAGE
#undef PG8_LDA
#undef PG8_LDB
#undef PG8_MMA
#undef PG8_WAIT_V
#undef PG8_WAIT_L
#undef PG8_BAR
#undef PG8_SCHED
}
}

#define DI __device__ __forceinline__
using pg8::bf16_t; using pg8::bf16x8; using pg8::f32x4; using pg8::u32x4;
typedef short s16x4 __attribute__((ext_vector_type(4)));
typedef float f32x16 __attribute__((ext_vector_type(16)));
typedef unsigned u32x2 __attribute__((ext_vector_type(2)));
typedef __bf16 bf2_t __attribute__((ext_vector_type(2)));
typedef float f32x2_t __attribute__((ext_vector_type(2)));
typedef PG8_LAS unsigned char* lds_ptr;

constexpr int D = 1024, NLAT = 32768, NCTX = 512, R = NLAT + NCTX, SEQ = 16384, CTXL = 256, DEPTH = 4;
constexpr int DIN = 1696, DINP = 1792;
constexpr int C_SWA_Q = 256, C_MLA_CQ = 512, C_SGU = 768, C_SWA_K = 1280, C_SWA_V = 1408, C_MLA_CKV = 1536, C_MLA_KR = 1664;
constexpr float EPS = 1e-6f;
constexpr float DN_ALPHA = 1.681792830507429f;
constexpr float LOG2E = 1.4426950408889634f;
constexpr int LDS_BYTES = 131072;
constexpr int LDS_ALLOC = LDS_BYTES + 16;

constexpr size_t W_IN = 0;
constexpr size_t W_OUT = W_IN + (size_t)DINP * 1024 * 2;
constexpr size_t W_FF1 = W_OUT + (size_t)1024 * 1024 * 2;
constexpr size_t W_FF2 = W_FF1 + (size_t)4096 * 1024 * 2;
constexpr size_t W_UQ = W_FF2 + (size_t)4096 * 1024 * 2;
constexpr size_t W_UKV = W_UQ + (size_t)512 * 256 * 2;
constexpr size_t W_POOL = W_UKV + (size_t)512 * 256 * 2;
constexpr size_t W_SGU = W_POOL + (size_t)256 * 256 * 2;
constexpr size_t WS_MOD = W_SGU + (size_t)4 * 128 * 128 * 2;
constexpr size_t WS_TAB = WS_MOD + (size_t)DEPTH * 3 * 6144 * 4;
constexpr size_t WS_X = WS_TAB + (size_t)(320 * 16 + 320 * 8) * 8;
constexpr size_t WS_U = WS_X + (size_t)R * 1024 * 4;
constexpr size_t U_Z = 0;
constexpr size_t U_QRAW = U_Z + (size_t)R * DINP * 2;
constexpr size_t U_KVRAW = U_QRAW + (size_t)R * 512 * 2;
constexpr size_t U_CQN = U_KVRAW + (size_t)R * 512 * 2;
constexpr size_t U_CKVN = U_CQN + (size_t)R * 256 * 2;
constexpr size_t U_DPOOL = U_CKVN + (size_t)R * 256 * 2;
constexpr size_t U_UG = U_DPOOL + (size_t)R * 256 * 2;
constexpr size_t U_VG = U_UG + (size_t)R * 256 * 2;
constexpr size_t U_F1 = 0;
constexpr size_t U_H = (size_t)R * 4096 * 2;
constexpr size_t U_YCAT = U_H;
constexpr size_t WS_KSR = WS_U + U_H + (size_t)R * 1024 * 2;
constexpr size_t WS_KRR = WS_KSR + (size_t)R * 128 * 2;
constexpr size_t WS_BAR = WS_KRR + (size_t)R * 32 * 2;
constexpr size_t WS_END = WS_BAR + 16384;
static_assert(U_VG + (size_t)R * 256 * 2 == U_H, "mixer-mode buffers must exactly fill the f1 slot");
static_assert(WS_END <= (size_t)536870912, "workspace too large");
static_assert(WS_X % 256 == 0 && WS_U % 256 == 0 && WS_MOD % 256 == 0 && WS_TAB % 256 == 0, "alignment");

struct Params { const float* in[25]; float* out; unsigned char* ws; };
DI int tid_() { int t = threadIdx.x; asm volatile("" : "+v"(t)); return t; }
DI int bid_() { int t = blockIdx.x; asm volatile("" : "+s"(t)); return t; }
DI int nblk_() { int t = gridDim.x; asm volatile("" : "+s"(t)); return t; }
DI const Params& params_() { auto k = __builtin_amdgcn_kernarg_segment_ptr(); asm volatile("" : "+s"(k)); return *(const Params*)k; }


DI float bf2f(bf16_t b) { return __uint_as_float(((unsigned)b) << 16); }
DI unsigned pk2(float a, float b) { f32x2_t v = {a, b}; bf2_t r = __builtin_convertvector(v, bf2_t); return __builtin_bit_cast(unsigned, r); }
DI bf16_t f2bf(float a) { return (bf16_t)(pk2(a, 0.f) & 0xffffu); }
DI float lo_f(unsigned u) { return __uint_as_float(u << 16); }
DI float hi_f(unsigned u) { return __uint_as_float(u & 0xffff0000u); }
DI float wsum(float v) {
#pragma unroll
    for (int m = 32; m >= 1; m >>= 1) v += __shfl_xor(v, m);
    return v;
}
DI float max3f(float a, float b, float c) { float r; asm("v_max3_f32 %0, %1, %2, %3" : "=v"(r) : "v"(a), "v"(b), "v"(c)); return r; }
DI int crow16(int i, int h) { return (i & 3) + 8 * (i >> 2) + 4 * h; }
#define MFMA32(a, b, c) __builtin_amdgcn_mfma_f32_32x32x16_bf16((a), (b), (c), 0, 0, 0)
DI bf16x8 tr_pair(lds_ptr lo_addr, int hi_delta) {
    const s16x4 lo = __builtin_amdgcn_ds_read_tr16_b64_v4i16((PG8_LAS s16x4*)lo_addr);
    const s16x4 hi = __builtin_amdgcn_ds_read_tr16_b64_v4i16((PG8_LAS s16x4*)(lo_addr + hi_delta));
    return __builtin_shufflevector(lo, hi, 0, 1, 2, 3, 4, 5, 6, 7);
}

struct EpiScaleBf16 {
    static constexpr bool PERM = true, AFTER_DRAIN = false;
    bf16_t* O; const float* modl; int idx;
    DI void operator()(const f32x4 (&acc)[2][2][4][2], const pg8::Unit& u, int wr, int wc, int fr, int fq) const {
        const int row0 = u.pm * 256 + wr * 64 + fr, col0 = u.pn * 256 + wc * 32 + 8 * fq;
        const int set = (u.pm < 64) ? 0 : (u.pm < 128 ? 1 : 2);
        const float* mp = modl + set * 6144 + idx * 1024 + col0;
        f32x4 mv[2][2];
#pragma unroll
        for (int bj = 0; bj < 2; ++bj)
#pragma unroll
            for (int n = 0; n < 2; ++n) mv[bj][n] = *(const f32x4*)(mp + bj * 128 + 4 * n);
#pragma unroll
        for (int ai = 0; ai < 2; ++ai)
#pragma unroll
            for (int m = 0; m < 4; ++m) {
                bf16_t* rowp = O + (size_t)(row0 + ai * 128 + m * 16) * 1024 + col0;
#pragma unroll
                for (int bj = 0; bj < 2; ++bj) {
                    const f32x4 v0 = acc[ai][bj][m][0] * mv[bj][0], v1 = acc[ai][bj][m][1] * mv[bj][1];
                    u32x4 w; w.x = pk2(v0[0], v0[1]); w.y = pk2(v0[2], v0[3]); w.z = pk2(v1[0], v1[1]); w.w = pk2(v1[2], v1[3]);
                    *(u32x4*)(rowp + bj * 128) = w;
                }
            }
    }
};
struct EpiRelu2 {
    static constexpr bool PERM = true, AFTER_DRAIN = false;
    bf16_t* O; int ldc;
    DI void operator()(const f32x4 (&acc)[2][2][4][2], const pg8::Unit& u, int wr, int wc, int fr, int fq) const {
        const int row0 = u.pm * 256 + wr * 64 + fr, col0 = u.pn * 256 + wc * 32 + 8 * fq;
#pragma unroll
        for (int ai = 0; ai < 2; ++ai)
#pragma unroll
            for (int m = 0; m < 4; ++m) {
                bf16_t* rowp = O + (size_t)(row0 + ai * 128 + m * 16) * ldc + col0;
#pragma unroll
                for (int bj = 0; bj < 2; ++bj) {
                    f32x4 v0 = acc[ai][bj][m][0], v1 = acc[ai][bj][m][1];
#pragma unroll
                    for (int j = 0; j < 4; ++j) { const float a = fmaxf(v0[j], 0.f), b = fmaxf(v1[j], 0.f); v0[j] = a * a; v1[j] = b * b; }
                    u32x4 w; w.x = pk2(v0[0], v0[1]); w.y = pk2(v0[2], v0[3]); w.z = pk2(v1[0], v1[1]); w.w = pk2(v1[2], v1[3]);
                    *(u32x4*)(rowp + bj * 128) = w;
                }
            }
    }
};

template <class Epi>
DI void run_gemm(lds_ptr lds3, const bf16_t* A, const bf16_t* Bt, int M, int N, int K, const Epi& E, int crot = 0) {
    pg8::Gemm g; g.A = A; g.Bt = Bt; g.M = M; g.N = N; g.K = K;
    const int G = nblk_(); int c = bid_() + crot; if (c >= G) c -= G;
    pg8::StaticOrder S; S.init(M, N, G, c);
    pg8::gemm_phase<Epi, pg8::StaticOrder, false>(lds3, g, S, E, nullptr);
}

DI void phase_adaln(const Params& p, float* lf) {
    for (int i = tid_(); i < 3072; i += 512) {
        const int s = i >> 10, k = i & 1023;
        const float v = (s < 2) ? p.in[1][s * 1024 + k] : p.in[3][k];
        lf[i] = v / (1.f + expf(-v));
    }
    __syncthreads();
    float* red = lf + 3072;
    const int wid = tid_() >> 6, lane = tid_() & 63;
    float* mod = (float*)(p.ws + WS_MOD);
    for (int item = bid_(); item < DEPTH * 96; item += nblk_()) {
        const int l = item / 96, jc = (item % 96) * 64;
        const float* w = p.in[4] + (size_t)l * 1024 * 6144 + jc + lane;
        float a0 = 0.f, a1 = 0.f, a2 = 0.f;
        const int i0 = wid * 128;
#pragma unroll 32
        for (int i = 0; i < 128; ++i) {
            const float wv = w[(size_t)(i0 + i) * 6144];
            a0 += lf[i0 + i] * wv; a1 += lf[1024 + i0 + i] * wv; a2 += lf[2048 + i0 + i] * wv;
        }
        red[(wid * 3 + 0) * 64 + lane] = a0; red[(wid * 3 + 1) * 64 + lane] = a1; red[(wid * 3 + 2) * 64 + lane] = a2;
        __syncthreads();
        if (tid_() < 192) {
            const int s = tid_() >> 6;
            float sum = 0.f;
#pragma unroll
            for (int w8 = 0; w8 < 8; ++w8) sum += red[(w8 * 3 + s) * 64 + lane];
            mod[((size_t)l * 3 + s) * 6144 + jc + lane] = sum + p.in[5][l * 6144 + jc + lane];
        }
        __syncthreads();
    }
}

DI void phase_tables(const Params& p) {
    float2* tS = (float2*)(p.ws + WS_TAB);
    float2* tM = tS + 320 * 16;
    const int gtid = bid_() * 512 + tid_(), gsz = nblk_() * 512;
    const float L2B = 13.287712379549449f;
    for (int i = gtid; i < 320 * 16 + 320 * 8; i += gsz) {
        int pos, f; float inv;
        if (i < 320 * 16) { pos = i >> 4; f = i & 15; inv = exp2f(-(float)(2 * f) * (1.f / 32.f) * L2B); }
        else { const int k = i - 320 * 16; pos = k >> 3; f = k & 7; inv = exp2f(-(float)(2 * f) * (1.f / 16.f) * L2B); }
        const float ang = (float)(pos < 256 ? pos : pos - 256) * inv;
        const double ad = (double)ang;
        const double kk = __builtin_rint(ad * 0.15915494309189535);
        const float rr = (float)(ad - kk * 6.283185307179586);
        tS[i] = make_float2(__cosf(rr), __sinf(rr));
    }
}

struct ConvJob { const float* src; bf16_t* dst; int K, N, KP, tk, tn; };
DI void conv_load(const ConvJob& c, int t, float4 (&v)[2]) {
#pragma unroll
    for (int rep = 0; rep < 2; ++rep) {
        const int k = c.tk * 64 + rep * 32 + (t >> 4), n = c.tn * 64 + (t & 15) * 4;
        v[rep] = make_float4(0.f, 0.f, 0.f, 0.f);
        if (k < c.K && n < c.N) v[rep] = *(const float4*)(c.src + (size_t)k * c.N + n);
    }
}
DI void conv_store(const ConvJob& c, int t, const float4 (&v)[2], bf16_t* tile) {
#pragma unroll
    for (int rep = 0; rep < 2; ++rep) {
        const int kl = rep * 32 + (t >> 4), nl = (t & 15) * 4;
        tile[(nl + 0) * 72 + kl] = f2bf(v[rep].x); tile[(nl + 1) * 72 + kl] = f2bf(v[rep].y);
        tile[(nl + 2) * 72 + kl] = f2bf(v[rep].z); tile[(nl + 3) * 72 + kl] = f2bf(v[rep].w);
    }
    __syncthreads();
    {
        const int nl = t >> 3, kl = (t & 7) * 8;
        const u32x4 w = *(const u32x4*)(tile + nl * 72 + kl);
        *(u32x4*)(c.dst + (size_t)(c.tn * 64 + nl) * c.KP + c.tk * 64 + kl) = w;
    }
    __syncthreads();
}

DI void convert_layer(const Params& p, int l, unsigned char* smem) {
    bf16_t* tile = (bf16_t*)smem;
    constexpr int T_IN = 16 * 28, T_OUT = 16 * 16, T_FF1 = 16 * 64, T_FF2 = 64 * 16, T_UQ = 4 * 8, T_UKV = 4 * 8;
    constexpr int T_ALL = T_IN + T_OUT + T_FF1 + T_FF2 + T_UQ + T_UKV;
    auto decode = [&](int t) {
        ConvJob c; int NT; size_t off; int tt = t;
        if (tt < T_IN) { c.src = p.in[6] + (size_t)l * 1024 * DIN; c.K = 1024; c.N = DIN; c.KP = 1024; NT = 28; off = W_IN; }
        else if ((tt -= T_IN) < T_OUT) { c.src = p.in[18] + (size_t)l * 1024 * 1024; c.K = 1024; c.N = 1024; c.KP = 1024; NT = 16; off = W_OUT; }
        else if ((tt -= T_OUT) < T_FF1) { c.src = p.in[21] + (size_t)l * 1024 * 4096; c.K = 1024; c.N = 4096; c.KP = 1024; NT = 64; off = W_FF1; }
        else if ((tt -= T_FF1) < T_FF2) { c.src = p.in[22] + (size_t)l * 4096 * 1024; c.K = 4096; c.N = 1024; c.KP = 4096; NT = 16; off = W_FF2; }
        else if ((tt -= T_FF2) < T_UQ) { c.src = p.in[11] + (size_t)l * 256 * 384; c.K = 256; c.N = 384; c.KP = 256; NT = 8; off = W_UQ; }
        else { tt -= T_UQ; c.src = p.in[13] + (size_t)l * 128 * 512; c.K = 128; c.N = 512; c.KP = 256; NT = 8; off = W_UKV; }
        c.dst = (bf16_t*)(p.ws + off); c.tk = tt / NT; c.tn = tt % NT;
        return c;
    };
    {
        const int t = tid_(), G = nblk_();
        int tix = bid_();
        float4 cur[2], nxt[2];
        if (tix < T_ALL) conv_load(decode(tix), t, cur);
        for (; tix < T_ALL; tix += G) {
            const bool more = tix + G < T_ALL;
            if (more) conv_load(decode(tix + G), t, nxt);
            conv_store(decode(tix), t, cur, tile);
            cur[0] = nxt[0]; cur[1] = nxt[1];
        }
    }
    const int gtid = bid_() * 512 + tid_(), gsz = nblk_() * 512;
    {
        bf16_t* dst = (bf16_t*)(p.ws + W_POOL);
        const float* pw = p.in[7] + (size_t)l * 4 * 64 * 64; const float* ps = p.in[8] + l * 256;
        for (int i = gtid; i < 65536; i += gsz) {
            const int row = i >> 8, col = i & 255, g = row >> 6, e = row & 63;
            float v = 0.f;
            if ((col >> 6) == g) v = pw[(g * 64 + (col & 63)) * 64 + e] * ps[row];
            dst[i] = f2bf(v);
        }
    }
    {
        bf16_t* dst = (bf16_t*)(p.ws + W_SGU);
        const float* sw = p.in[16] + (size_t)l * 65536;
        for (int i = gtid; i < 65536; i += gsz) dst[i] = f2bf(sw[i]);
    }
}

DI void wsum4(float& a, float& b, float& c, float& d) {
#pragma unroll
    for (int m = 32; m >= 1; m >>= 1) {
        const float ta = __shfl_xor(a, m), tb = __shfl_xor(b, m), tc = __shfl_xor(c, m), td = __shfl_xor(d, m);
        a += ta; b += tb; c += tc; d += td;
    }
}
DI void row_stats(const float4 (&v)[4], float& s, float& q) {
    s = 0.f; q = 0.f;
#pragma unroll
    for (int j = 0; j < 4; ++j) { s += v[j].x + v[j].y + v[j].z + v[j].w; q += v[j].x * v[j].x + v[j].y * v[j].y + v[j].z * v[j].z + v[j].w * v[j].w; }
}
DI void phase_ln(const Params& p, int mode, const float* g, const float* b, const float* modl, int i0, const bf16_t* Y = nullptr, int rlimit = R) {
    const int wid = tid_() >> 6, lane = tid_() & 63;
    bf16_t* XL = (bf16_t*)(p.ws + WS_X);
    float* XC = (float*)(p.ws + WS_X + (size_t)NLAT * 1024 * 2);
    bf16_t* H = (bf16_t*)(p.ws + WS_U + U_H);
    const int rmax = (mode == 2) ? NLAT : rlimit;
    const int rstride = nblk_() * 8;
    for (int ra = bid_() * 8 + wid; ra < rmax; ra += 2 * rstride) {
        const bool has_b = ra + rstride < rmax;
        const int rb = has_b ? ra + rstride : ra;
        float4 v[2][4];
#pragma unroll
        for (int k = 0; k < 2; ++k) {
            const int r = k ? rb : ra;
            if (mode != 0 && r < NLAT) {
#pragma unroll
                for (int j = 0; j < 4; ++j) {
                    const u32x2 w = *(const u32x2*)(XL + (size_t)r * 1024 + 4 * lane + 256 * j);
                    v[k][j] = make_float4(lo_f(w.x), hi_f(w.x), lo_f(w.y), hi_f(w.y));
                }
            } else {
                const float* src;
                if (mode == 0) src = (r < NLAT) ? p.in[0] + (size_t)r * 1024 : p.in[2] + (size_t)(r - NLAT) * 1024;
                else src = XC + (size_t)(r - NLAT) * 1024;
#pragma unroll
                for (int j = 0; j < 4; ++j) v[k][j] = *(const float4*)(src + 4 * lane + 256 * j);
            }
        }
        if (mode != 0) {
#pragma unroll
            for (int k = 0; k < 2; ++k) {
                const int r = k ? rb : ra;
                {
#pragma unroll
                    for (int j = 0; j < 4; ++j) {
                        const u32x2 yw = *(const u32x2*)(Y + (size_t)r * 1024 + 4 * lane + 256 * j);
                        v[k][j].x = v[k][j].x * DN_ALPHA + lo_f(yw.x); v[k][j].y = v[k][j].y * DN_ALPHA + hi_f(yw.x);
                        v[k][j].z = v[k][j].z * DN_ALPHA + lo_f(yw.y); v[k][j].w = v[k][j].w * DN_ALPHA + hi_f(yw.y);
                    }
                }
            }
            float s0, q0, s1, q1;
            row_stats(v[0], s0, q0); row_stats(v[1], s1, q1);
            wsum4(s0, q0, s1, q1);
#pragma unroll
            for (int k = 0; k < 2; ++k) {
                const float mu = (k ? s1 : s0) * (1.f / 1024.f);
                const float rs = rsqrtf(fmaxf((k ? q1 : q0) * (1.f / 1024.f) - mu * mu, 0.f) + EPS);
#pragma unroll
                for (int j = 0; j < 4; ++j) {
                    const float4 gg = *(const float4*)(g + 4 * lane + 256 * j), bb = *(const float4*)(b + 4 * lane + 256 * j);
                    v[k][j].x = (v[k][j].x - mu) * rs * gg.x + bb.x; v[k][j].y = (v[k][j].y - mu) * rs * gg.y + bb.y;
                    v[k][j].z = (v[k][j].z - mu) * rs * gg.z + bb.z; v[k][j].w = (v[k][j].w - mu) * rs * gg.w + bb.w;
                }
            }
        }
#pragma unroll
        for (int k = 0; k < 2; ++k) {
            const int r = k ? rb : ra;
            if (k == 0 || has_b) {
                if (mode != 2 && r < NLAT) {
#pragma unroll
                    for (int j = 0; j < 4; ++j) { u32x2 o; o.x = pk2(v[k][j].x, v[k][j].y); o.y = pk2(v[k][j].z, v[k][j].w); *(u32x2*)(XL + (size_t)r * 1024 + 4 * lane + 256 * j) = o; }
                } else {
                    float* dstx = (mode == 2) ? p.out + (size_t)r * 1024 : XC + (size_t)(r - NLAT) * 1024;
#pragma unroll
                    for (int j = 0; j < 4; ++j) *(float4*)(dstx + 4 * lane + 256 * j) = v[k][j];
                }
            }
        }
        if (mode != 2) {
            float s0, q0, s1, q1;
            row_stats(v[0], s0, q0); row_stats(v[1], s1, q1);
            wsum4(s0, q0, s1, q1);
#pragma unroll
            for (int k = 0; k < 2; ++k) {
                const int r = k ? rb : ra;
                if (k == 0 || has_b) {
                    const float mu = (k ? s1 : s0) * (1.f / 1024.f);
                    const float rs = rsqrtf(fmaxf((k ? q1 : q0) * (1.f / 1024.f) - mu * mu, 0.f) + EPS);
                    const int set = (r < SEQ) ? 0 : (r < NLAT ? 1 : 2);
                    const float* msh = modl + set * 6144 + i0 * 1024, *msc = msh + 1024;
#pragma unroll
                    for (int j = 0; j < 4; ++j) {
                        const float4 sh = *(const float4*)(msh + 4 * lane + 256 * j), sc = *(const float4*)(msc + 4 * lane + 256 * j);
                        u32x2 o;
                        o.x = pk2((v[k][j].x - mu) * rs * (1.f + sc.x) + sh.x, (v[k][j].y - mu) * rs * (1.f + sc.y) + sh.y);
                        o.y = pk2((v[k][j].z - mu) * rs * (1.f + sc.z) + sh.z, (v[k][j].w - mu) * rs * (1.f + sc.w) + sh.w);
                        *(u32x2*)(H + (size_t)r * 1024 + 4 * lane + 256 * j) = o;
                    }
                }
            }
        }
    }
}

DI float gelu_exact(float x) { return 0.5f * x * (1.f + erff(x * 0.70710678118654752f)); }

DI void phase_postz(const Params& p, int l) {
    const int wid = tid_() >> 6, lane = tid_() & 63;
    unsigned char* U = p.ws + WS_U;
    const bf16_t* Z = (const bf16_t*)(U + U_Z);
    bf16_t* KSR = (bf16_t*)(p.ws + WS_KSR); bf16_t* KRR = (bf16_t*)(p.ws + WS_KRR);
    bf16_t* CQN = (bf16_t*)(U + U_CQN); bf16_t* CKVN = (bf16_t*)(U + U_CKVN); bf16_t* DPOOL = (bf16_t*)(U + U_DPOOL);
    bf16_t* UG = (bf16_t*)(U + U_UG); bf16_t* VG = (bf16_t*)(U + U_VG);
    const float2* tS = (const float2*)(p.ws + WS_TAB); const float2* tM = tS + 320 * 16;
    const float* gq = p.in[10] + l * 256; const float* gkv = p.in[12] + l * 128;
    const float* sg = p.in[14] + l * 256; const float* sb = p.in[15] + l * 256;
    for (int r = bid_() * 8 + wid; r < R; r += nblk_() * 8) {
        const bf16_t* zr = Z + (size_t)r * DINP;
        const bool lat = r < NLAT;
        const int t = r & (SEQ - 1), rp = t >> 6, cp = t & 63;
        {
            const int hd = lane >> 5, pp = lane & 31, i = pp & 15, off = hd * 64 + ((pp & 16) ? 32 : 0);
            const float x1 = bf2f(zr[C_SWA_K + off + i]), x2 = bf2f(zr[C_SWA_K + off + 16 + i]);
            float o1 = x1, o2 = x2;
            if (lat) { const float2 cs = (pp & 16) ? tS[(256 + cp) * 16 + i] : tS[rp * 16 + i]; o1 = x1 * cs.x - x2 * cs.y; o2 = x2 * cs.x + x1 * cs.y; }
            KSR[(size_t)r * 128 + off + i] = f2bf(o1); KSR[(size_t)r * 128 + off + 16 + i] = f2bf(o2);
        }
        if (lane < 16) {
            const int i = lane & 7, off = (lane & 8) ? 16 : 0;
            const float x1 = bf2f(zr[C_MLA_KR + off + i]), x2 = bf2f(zr[C_MLA_KR + off + 8 + i]);
            float o1 = x1, o2 = x2;
            if (lat) { const float2 cs = (lane & 8) ? tM[(256 + cp) * 8 + i] : tM[rp * 8 + i]; o1 = x1 * cs.x - x2 * cs.y; o2 = x2 * cs.x + x1 * cs.y; }
            KRR[(size_t)r * 32 + off + i] = f2bf(o1); KRR[(size_t)r * 32 + off + 8 + i] = f2bf(o2);
        }
        {
            const u32x2 w = *(const u32x2*)(zr + C_MLA_CQ + 4 * lane);
            const float a0 = lo_f(w.x), a1 = hi_f(w.x), a2 = lo_f(w.y), a3 = hi_f(w.y);
            const float rs = rsqrtf(wsum(a0 * a0 + a1 * a1 + a2 * a2 + a3 * a3) * (1.f / 256.f) + EPS);
            const float4 gg = *(const float4*)(gq + 4 * lane);
            u32x2 o; o.x = pk2(a0 * rs * gg.x, a1 * rs * gg.y); o.y = pk2(a2 * rs * gg.z, a3 * rs * gg.w);
            *(u32x2*)(CQN + (size_t)r * 256 + 4 * lane) = o;
        }
        {
            const unsigned w = *(const unsigned*)(zr + C_MLA_CKV + 2 * lane);
            const float a0 = lo_f(w), a1 = hi_f(w);
            const float rs = rsqrtf(wsum(a0 * a0 + a1 * a1) * (1.f / 128.f) + EPS);
            const float2 gg = *(const float2*)(gkv + 2 * lane);
            *(unsigned*)(CKVN + (size_t)r * 256 + 2 * lane) = pk2(a0 * rs * gg.x, a1 * rs * gg.y);
            *(unsigned*)(CKVN + (size_t)r * 256 + 128 + 2 * lane) = 0u;
        }
        {
            const u32x2 wu = *(const u32x2*)(zr + C_SGU + 4 * lane);
            const pg8::f32x2 gu0 = pg8::gelu_pk((pg8::f32x2){lo_f(wu.x), hi_f(wu.x)}), gu1 = pg8::gelu_pk((pg8::f32x2){lo_f(wu.y), hi_f(wu.y)});
            u32x2 ou; ou.x = pk2(gu0.x, gu0.y); ou.y = pk2(gu1.x, gu1.y);
            *(u32x2*)(UG + (size_t)r * 256 + 4 * lane) = ou;
            const u32x2 wv = *(const u32x2*)(zr + C_SGU + 256 + 4 * lane);
            const pg8::f32x2 gv0 = pg8::gelu_pk((pg8::f32x2){lo_f(wv.x), hi_f(wv.x)}), gv1 = pg8::gelu_pk((pg8::f32x2){lo_f(wv.y), hi_f(wv.y)});
            float a0 = gv0.x, a1 = gv0.y, a2 = gv1.x, a3 = gv1.y;
            const float mu = wsum(a0 + a1 + a2 + a3) * (1.f / 256.f);
            a0 -= mu; a1 -= mu; a2 -= mu; a3 -= mu;
            const float rs = rsqrtf(wsum(a0 * a0 + a1 * a1 + a2 * a2 + a3 * a3) * (1.f / 256.f) + EPS);
            const float4 gg = *(const float4*)(sg + 4 * lane), bb = *(const float4*)(sb + 4 * lane);
            u32x2 ov; ov.x = pk2(a0 * rs * gg.x + bb.x, a1 * rs * gg.y + bb.y); ov.y = pk2(a2 * rs * gg.z + bb.z, a3 * rs * gg.w + bb.w);
            *(u32x2*)(VG + (size_t)r * 256 + 4 * lane) = ov;
        }
        {
            const int hw = 1 << (lane >> 4);
            int sbase, n, tt;
            if (lat) { sbase = r & ~(SEQ - 1); n = SEQ; tt = t; }
            else { sbase = NLAT + ((r - NLAT) & ~(CTXL - 1)); n = CTXL; tt = (r - NLAT) & (CTXL - 1); }
            const int lo = max(tt - hw, 0), hi = min(tt + hw, n);
            float s0 = 0.f, s1 = 0.f, s2 = 0.f, s3 = 0.f;
#pragma unroll
            for (int d = -8; d < 8; ++d) {
                const int q = tt + d;
                const float wgt = (q >= lo && q < hi) ? 1.f : 0.f;
                const int qc = min(max(q, 0), n - 1);
                const u32x2 w = *(const u32x2*)(Z + (size_t)(sbase + qc) * DINP + 4 * lane);
                s0 += wgt * lo_f(w.x); s1 += wgt * hi_f(w.x); s2 += wgt * lo_f(w.y); s3 += wgt * hi_f(w.y);
            }
            const float inv = 1.f / (float)(hi - lo);
            const u32x2 wx = *(const u32x2*)(zr + 4 * lane);
            u32x2 o; o.x = pk2(s0 * inv - lo_f(wx.x), s1 * inv - hi_f(wx.x)); o.y = pk2(s2 * inv - lo_f(wx.y), s3 * inv - hi_f(wx.y));
            *(u32x2*)(DPOOL + (size_t)r * 256 + 4 * lane) = o;
        }
    }
}

DI void rot8_scale(u32x4& a, u32x4& b, const float2* tab, bool rope, float qs) {
#pragma unroll
    for (int e = 0; e < 4; ++e) {
        const float x1a = lo_f(a[e]), x1b = hi_f(a[e]), x2a = lo_f(b[e]), x2b = hi_f(b[e]);
        float y1a = x1a, y1b = x1b, y2a = x2a, y2b = x2b;
        if (rope) {
            const float2 ca = tab[2 * e], cb = tab[2 * e + 1];
            y1a = x1a * ca.x - x2a * ca.y; y2a = x2a * ca.x + x1a * ca.y;
            y1b = x1b * cb.x - x2b * cb.y; y2b = x2b * cb.x + x1b * cb.y;
        }
        a[e] = pk2(y1a * qs, y1b * qs); b[e] = pk2(y2a * qs, y2b * qs);
    }
}
DI void scale8(u32x4& a, float qs) {
#pragma unroll
    for (int e = 0; e < 4; ++e) a[e] = pk2(lo_f(a[e]) * qs, hi_f(a[e]) * qs);
}

template <int DQK, bool MASK, bool FAST = false>
DI bool attn_item(unsigned char* smem, lds_ptr lds3, const float2* tabR, const float2* tabC,
                  const bf16_t* qbase, int ldq, bool rope, int t0, float qscale,
                  const bf16_t* k1, int ldk1, const bf16_t* k2, const bf16_t* vb, int ldv,
                  int rowA, int lenA, int posA, int rowB, int lenB,
                  float m0, float l0, bool first_unclamped, bf16_t* ob) {
    constexpr int QP = DQK * 2 + 16, VP = 192, NKS = DQK / 16, CPK = DQK / 8;
    constexpr int K_OFF = 256 * QP, KB = 64 * QP, V_OFF = K_OFF + 2 * KB, VB = 64 * VP;
    constexpr float RESCALE_T = 8.f;
    static_assert(V_OFF + 2 * VB <= LDS_BYTES, "attention LDS");
    const int tid = tid_(), wid = tid >> 6, lane = tid & 63, l31 = lane & 31, h = lane >> 5;
    {
        const int row = tid >> 1, hh = tid & 1;
        const bf16_t* qr = qbase + (size_t)row * ldq;
        unsigned char* qd = smem + row * QP;
        const int tq = t0 + row, rp = tq >> 6, cp = tq & 63;
        if constexpr (DQK == 64) {
            u32x4 c[4];
#pragma unroll
            for (int j = 0; j < 4; ++j) c[j] = *(const u32x4*)(qr + 32 * hh + 8 * j);
            const float2* tab = hh ? (tabC + cp * 16) : (tabR + rp * 16);
            rot8_scale(c[0], c[2], tab, rope, qscale);
            rot8_scale(c[1], c[3], tab + 8, rope, qscale);
#pragma unroll
            for (int j = 0; j < 4; ++j) *(u32x4*)(qd + (32 * hh + 8 * j) * 2) = c[j];
        } else {
            u32x4 c[6];
#pragma unroll
            for (int j = 0; j < 6; ++j) c[j] = *(const u32x4*)(qr + 48 * hh + 8 * j);
            if (hh) {
                scale8(c[0], qscale); scale8(c[1], qscale);
                rot8_scale(c[2], c[3], tabR + rp * 8, rope, qscale);
                rot8_scale(c[4], c[5], tabC + cp * 8, rope, qscale);
            } else {
#pragma unroll
                for (int j = 0; j < 6; ++j) scale8(c[j], qscale);
            }
#pragma unroll
            for (int j = 0; j < 6; ++j) *(u32x4*)(qd + (48 * hh + 8 * j) * 2) = c[j];
        }
    }
    __syncthreads();
    const unsigned char* qlane = smem + (32 * wid + l31) * QP + 16 * h;
    bf16x8 qfix[NKS];
    if constexpr (FAST) {
#pragma unroll
        for (int ks = 0; ks < NKS; ++ks) qfix[ks] = *(const bf16x8*)(qlane + 32 * ks);
    }

    const int nA = lenA >> 6, nT = nA + (lenB >> 6);
    u32x4 kr0, kr1, vr;
    const int kidx1 = min(tid + 512, 64 * CPK - 1);
    const int kkey0 = tid / CPK, kc0 = tid % CPK, kkey1 = kidx1 / CPK, kc1 = kidx1 % CPK;
    const int koff0 = (kc0 < 8) ? kkey0 * ldk1 + 8 * kc0 : kkey0 * 32 + 8 * (kc0 - 8);
    const int koff1 = (kc1 < 8) ? kkey1 * ldk1 + 8 * kc1 : kkey1 * 32 + 8 * (kc1 - 8);
    const int voff = (tid >> 3) * ldv + 8 * (tid & 7);
    auto gloadK = [&](int j) {
        const int jj = min(j, nT - 1);
        const int row0 = (jj < nA) ? rowA + 64 * jj : rowB + 64 * (jj - nA);
        const bf16_t* b1 = k1 + (size_t)row0 * ldk1; const bf16_t* b2 = k2 + (size_t)row0 * 32;
        kr0 = *(const u32x4*)(((kc0 < 8) ? b1 : b2) + koff0);
        if constexpr (DQK == 96) { if (tid < 256) kr1 = *(const u32x4*)(((kc1 < 8) ? b1 : b2) + koff1); }
    };
    auto gloadV = [&](int j) {
        const int jj = min(j, nT - 1);
        const int row0 = (jj < nA) ? rowA + 64 * jj : rowB + 64 * (jj - nA);
        vr = *(const u32x4*)(vb + (size_t)row0 * ldv + voff);
    };
    const int ksoff0 = kkey0 * QP + 16 * kc0, ksoff1 = kkey1 * QP + 16 * kc1, vsoff = (tid >> 3) * VP + 16 * (tid & 7);
    auto sstoreK = [&](int buf) {
        *(u32x4*)(smem + K_OFF + buf * KB + ksoff0) = kr0;
        if constexpr (DQK == 96) { if (tid < 256) *(u32x4*)(smem + K_OFF + buf * KB + ksoff1) = kr1; }
    };
    auto sstoreV = [&](int buf) { *(u32x4*)(smem + V_OFF + buf * VB + vsoff) = vr; };

    f32x16 O0, O1, negm;
    float mref = m0;
#pragma unroll
    for (int i = 0; i < 16; ++i) { O0[i] = 0.f; O1[i] = 0.f; negm[i] = -m0; }
    float lsum = l0 * (h == 0 ? 1.f : 0.f);
    const int qpos = t0 + 32 * wid + l31;
    const int q4 = (lane & 15) >> 2, p4 = lane & 3, blk = (lane >> 4) & 1;
    const int vlane = (4 * h + q4) * VP + 32 * blk + 8 * p4;
    const int klane = l31 * QP + 16 * h;

    auto kfrags = [&](int buf, bf16x8 (&kf0)[NKS], bf16x8 (&kf1)[NKS]) {
        const unsigned char* Kt = smem + K_OFF + buf * KB + klane;
#pragma unroll
        for (int ks = 0; ks < NKS; ++ks) { kf0[ks] = *(const bf16x8*)(Kt + 32 * ks); kf1[ks] = *(const bf16x8*)(Kt + 32 * QP + 32 * ks); }
    };
    f32x16 zacc;
#pragma unroll
    for (int i = 0; i < 16; ++i) zacc[i] = 0.f;
    auto qk = [&](const bf16x8 (&kf0)[NKS], const bf16x8 (&kf1)[NKS], int jt, f32x16& S0, f32x16& S1) {
#pragma unroll
        for (int ks = 0; ks < NKS; ++ks) {
            const bf16x8 qv = *(const bf16x8*)(qlane + 32 * ks);
            if (ks == 0) { S0 = MFMA32(kf0[0], qv, FAST ? negm : zacc); S1 = MFMA32(kf1[0], qv, FAST ? negm : zacc); }
            else { S0 = MFMA32(kf0[ks], qv, S0); S1 = MFMA32(kf1[ks], qv, S1); }
        }
        if constexpr (MASK) {
            const int d0 = (jt < nA) ? posA + 64 * jt - qpos : 0;
#pragma unroll
            for (int i = 0; i < 16; ++i) {
                const int dd = d0 + crow16(i, h);
                if (dd > 128 || dd < -128) S0[i] = -1e30f;
                if (dd + 32 > 128 || dd + 32 < -128) S1[i] = -1e30f;
            }
        }
    };

    gloadK(0); gloadV(0); sstoreK(0); sstoreV(0);
    gloadK(1); sstoreK(1);
    __syncthreads();
    bool bad = false;
    f32x16 SA0, SA1, SB0, SB1;
    {
        bf16x8 kf0[NKS], kf1[NKS];
        kfrags(0, kf0, kf1);
        qk(kf0, kf1, 0, SA0, SA1);
    }
    asm volatile("s_nop 15\n\ts_nop 15" ::: "memory");
    auto iter = [&](int j, f32x16& S0, f32x16& S1, f32x16& N0, f32x16& N1) {
        gloadK(j + 2);
        gloadV(j + 1);
        bf16x8 kf0[NKS], kf1[NKS];
        kfrags((j + 1) & 1, kf0, kf1);
        __builtin_amdgcn_sched_barrier(0);
        const bool first = (j == 0) && first_unclamped;
        float ps = 0.f;
        if constexpr (FAST) {
            const bf16x8 (&qv)[NKS] = qfix;
            if (first) {
                float mx = max3f(S0[0], S1[0], S0[1]);
                mx = max3f(mx, S1[1], S0[2]); mx = max3f(mx, S1[2], S0[3]); mx = max3f(mx, S1[3], S0[4]); mx = max3f(mx, S1[4], S0[5]);
                mx = max3f(mx, S1[5], S0[6]); mx = max3f(mx, S1[6], S0[7]); mx = max3f(mx, S1[7], S0[8]); mx = max3f(mx, S1[8], S0[9]);
                mx = max3f(mx, S1[9], S0[10]); mx = max3f(mx, S1[10], S0[11]); mx = max3f(mx, S1[11], S0[12]); mx = max3f(mx, S1[12], S0[13]);
                mx = max3f(mx, S1[13], S0[14]); mx = max3f(mx, S1[14], S0[15]); mx = fmaxf(mx, S1[15]);
                const float delta = fmaxf(mx, __shfl_xor(mx, 32)) + 10.f;
                mref += delta;
#pragma unroll
                for (int i = 0; i < 16; ++i) { S0[i] -= delta; S1[i] -= delta; negm[i] = -mref; }
            }
#pragma unroll
            for (int i = 0; i < 16; ++i) { S0[i] = __builtin_amdgcn_exp2f(S0[i]); ps += S0[i]; }
            asm volatile("" : "+v"(ps));
            __builtin_amdgcn_sched_barrier(0);
#pragma unroll
            for (int ks = 0; ks < NKS; ++ks) {
                if (ks == 0) { N0 = MFMA32(kf0[0], qv[0], negm); N1 = MFMA32(kf1[0], qv[0], negm); }
                else { N0 = MFMA32(kf0[ks], qv[ks], N0); N1 = MFMA32(kf1[ks], qv[ks], N1); }
            }
            __builtin_amdgcn_sched_barrier(0);
            lds_ptr Vt = lds3 + V_OFF + (j & 1) * VB + vlane;
            bf16x8 vf0[4], vf1[4];
#pragma unroll
            for (int ms = 0; ms < 4; ++ms) { vf0[ms] = tr_pair(Vt + 16 * ms * VP, 8 * VP); vf1[ms] = tr_pair(Vt + 16 * ms * VP + 64, 8 * VP); }
            __builtin_amdgcn_sched_barrier(0);
#pragma unroll
            for (int i = 0; i < 16; ++i) { S1[i] = __builtin_amdgcn_exp2f(S1[i]); ps += S1[i]; }
            asm volatile("" : "+v"(ps));
            bad = bad || !(ps < 8192.f);
            lsum += ps;
            asm volatile("" : "+v"(lsum));
            u32x4 pw[4];
#pragma unroll
            for (int s = 0; s < 2; ++s) {
                pw[s].x = pk2(S0[8 * s], S0[8 * s + 1]); pw[s].y = pk2(S0[8 * s + 2], S0[8 * s + 3]); pw[s].z = pk2(S0[8 * s + 4], S0[8 * s + 5]); pw[s].w = pk2(S0[8 * s + 6], S0[8 * s + 7]);
                pw[2 + s].x = pk2(S1[8 * s], S1[8 * s + 1]); pw[2 + s].y = pk2(S1[8 * s + 2], S1[8 * s + 3]); pw[2 + s].z = pk2(S1[8 * s + 4], S1[8 * s + 5]); pw[2 + s].w = pk2(S1[8 * s + 6], S1[8 * s + 7]);
            }
            __builtin_amdgcn_sched_barrier(0);
#pragma unroll
            for (int ms = 0; ms < 4; ++ms) {
                const bf16x8 pf = __builtin_bit_cast(bf16x8, pw[ms]);
                O0 = MFMA32(vf0[ms], pf, O0);
                O1 = MFMA32(vf1[ms], pf, O1);
            }
            sstoreK(j & 1);
            sstoreV((j + 1) & 1);
            __syncthreads();
            return;
        } else {
            float mx = max3f(S0[0], S1[0], S0[1]);
            mx = max3f(mx, S1[1], S0[2]); mx = max3f(mx, S1[2], S0[3]); mx = max3f(mx, S1[3], S0[4]); mx = max3f(mx, S1[4], S0[5]);
            mx = max3f(mx, S1[5], S0[6]); mx = max3f(mx, S1[6], S0[7]); mx = max3f(mx, S1[7], S0[8]); mx = max3f(mx, S1[8], S0[9]);
            mx = max3f(mx, S1[9], S0[10]); mx = max3f(mx, S1[10], S0[11]); mx = max3f(mx, S1[11], S0[12]); mx = max3f(mx, S1[12], S0[13]);
            mx = max3f(mx, S1[13], S0[14]); mx = max3f(mx, S1[14], S0[15]); mx = fmaxf(mx, S1[15]);
            if (first || __any(mx - mref > RESCALE_T)) {
                const float mxf = fmaxf(mx, __shfl_xor(mx, 32));
                const float mnew = first ? mxf : fmaxf(mxf, mref);
                const float alpha = __builtin_amdgcn_exp2f(mref - mnew);
                mref = mnew; lsum *= alpha;
#pragma unroll
                for (int i = 0; i < 16; ++i) { O0[i] *= alpha; O1[i] *= alpha; }
            }
            qk(kf0, kf1, j + 1, N0, N1);
#pragma unroll
            for (int i = 0; i < 16; ++i) { S0[i] = __builtin_amdgcn_exp2f(S0[i] - mref); S1[i] = __builtin_amdgcn_exp2f(S1[i] - mref); ps += S0[i] + S1[i]; }
        }
        lsum += ps;
        lds_ptr Vt = lds3 + V_OFF + (j & 1) * VB + vlane;
#pragma unroll
        for (int mt = 0; mt < 2; ++mt)
#pragma unroll
            for (int s = 0; s < 2; ++s) {
                u32x4 pw;
                if (mt == 0) { pw.x = pk2(S0[8 * s], S0[8 * s + 1]); pw.y = pk2(S0[8 * s + 2], S0[8 * s + 3]); pw.z = pk2(S0[8 * s + 4], S0[8 * s + 5]); pw.w = pk2(S0[8 * s + 6], S0[8 * s + 7]); }
                else { pw.x = pk2(S1[8 * s], S1[8 * s + 1]); pw.y = pk2(S1[8 * s + 2], S1[8 * s + 3]); pw.z = pk2(S1[8 * s + 4], S1[8 * s + 5]); pw.w = pk2(S1[8 * s + 6], S1[8 * s + 7]); }
                const bf16x8 pf = __builtin_bit_cast(bf16x8, pw);
                const bf16x8 v0 = tr_pair(Vt + (32 * mt + 16 * s) * VP, 8 * VP);
                const bf16x8 v1 = tr_pair(Vt + (32 * mt + 16 * s) * VP + 64, 8 * VP);
                O0 = MFMA32(v0, pf, O0);
                O1 = MFMA32(v1, pf, O1);
            }
        sstoreK(j & 1);
        sstoreV((j + 1) & 1);
        __syncthreads();
    };
    for (int j = 0; j < nT; j += 2) {
        iter(j, SA0, SA1, SB0, SB1);
        iter(j + 1, SB0, SB1, SA0, SA1);
    }
    if constexpr (FAST) { if (__syncthreads_or((int)bad)) return false; }
    const float ltot = lsum + __shfl_xor(lsum, 32);
    const float inv = 1.f / ltot;
    bf16_t* orow = ob + (size_t)(32 * wid + l31) * 1024;
#pragma unroll
    for (int g4 = 0; g4 < 4; ++g4) {
        u32x2 o0, o1;
        o0.x = pk2(O0[4 * g4] * inv, O0[4 * g4 + 1] * inv); o0.y = pk2(O0[4 * g4 + 2] * inv, O0[4 * g4 + 3] * inv);
        o1.x = pk2(O1[4 * g4] * inv, O1[4 * g4 + 1] * inv); o1.y = pk2(O1[4 * g4 + 2] * inv, O1[4 * g4 + 3] * inv);
        *(u32x2*)(orow + 8 * g4 + 4 * h) = o0;
        *(u32x2*)(orow + 32 + 8 * g4 + 4 * h) = o1;
    }
    return true;
}

DI void sgu_item(unsigned char* smem, lds_ptr lds3, const Params& p, int l, int c) {
    constexpr int VPB = 576;
    const int tid = tid_(), wid = tid >> 6, lane = tid & 63, l31 = lane & 31, h = lane >> 5;
    unsigned char* U = p.ws + WS_U;
    const bf16_t* VG = (const bf16_t*)(U + U_VG); const bf16_t* UG = (const bf16_t*)(U + U_UG);
    bf16_t* YC = (bf16_t*)(U + U_YCAT);
    const bf16_t* WSG = (const bf16_t*)(p.ws + W_SGU);
    const float* bs = p.in[17] + l * 512;
    const int row0 = c * 128;
#pragma unroll
    for (int i = 0; i < 8; ++i) {
        const int idx = tid + 512 * i, rr = idx >> 5, ch = idx & 31;
        const u32x4 v = *(const u32x4*)(VG + (size_t)(row0 + rr) * 256 + 8 * ch);
        *(u32x4*)(smem + rr * VPB + 16 * ch) = v;
    }
    __syncthreads();
    const int hd = wid >> 1, ph = wid & 1;
    f32x16 C00, C01, C10, C11;
#pragma unroll
    for (int i = 0; i < 16; ++i) { C00[i] = 0.f; C01[i] = 0.f; C10[i] = 0.f; C11[i] = 0.f; }
    const int q4 = (lane & 15) >> 2, p4 = lane & 3, blk = (lane >> 4) & 1;
    lds_ptr vbase = lds3 + (8 * h + q4) * VPB + (hd * 64 + 16 * blk) * 2 + 8 * p4;
    const bf16_t* wb = WSG + (size_t)(hd * 128 + 64 * ph + l31) * 128 + 8 * h;
#pragma unroll
    for (int ks = 0; ks < 8; ++ks) {
        const bf16x8 A0 = tr_pair(vbase + 16 * ks * VPB, 4 * VPB);
        const bf16x8 A1 = tr_pair(vbase + 16 * ks * VPB + 64, 4 * VPB);
        const bf16x8 B0 = *(const bf16x8*)(wb + 16 * ks);
        const bf16x8 B1 = *(const bf16x8*)(wb + 32 * 128 + 16 * ks);
        C00 = MFMA32(A0, B0, C00); C01 = MFMA32(A0, B1, C01);
        C10 = MFMA32(A1, B0, C10); C11 = MFMA32(A1, B1, C11);
    }
#pragma unroll
    for (int pt = 0; pt < 2; ++pt) {
        const int pp = 64 * ph + 32 * pt + l31, row = row0 + pp;
        const float bias = bs[hd * 128 + pp];
#pragma unroll
        for (int dt = 0; dt < 2; ++dt)
#pragma unroll
            for (int g4 = 0; g4 < 4; ++g4) {
                const int d0 = 32 * dt + 8 * g4 + 4 * h;
                const u32x2 uu = *(const u32x2*)(UG + (size_t)row * 256 + hd * 64 + d0);
                float c0, c1, c2, c3;
                if (dt == 0 && pt == 0) { c0 = C00[4 * g4]; c1 = C00[4 * g4 + 1]; c2 = C00[4 * g4 + 2]; c3 = C00[4 * g4 + 3]; }
                else if (dt == 0) { c0 = C01[4 * g4]; c1 = C01[4 * g4 + 1]; c2 = C01[4 * g4 + 2]; c3 = C01[4 * g4 + 3]; }
                else if (pt == 0) { c0 = C10[4 * g4]; c1 = C10[4 * g4 + 1]; c2 = C10[4 * g4 + 2]; c3 = C10[4 * g4 + 3]; }
                else { c0 = C11[4 * g4]; c1 = C11[4 * g4 + 1]; c2 = C11[4 * g4 + 2]; c3 = C11[4 * g4 + 3]; }
                u32x2 o;
                o.x = pk2((c0 + bias) * lo_f(uu.x), (c1 + bias) * hi_f(uu.x));
                o.y = pk2((c2 + bias) * lo_f(uu.y), (c3 + bias) * hi_f(uu.y));
                *(u32x2*)(YC + (size_t)row * 1024 + 768 + hd * 64 + d0) = o;
            }
    }
    __syncthreads();
}

DI void phase_mix(const Params& p, int l, unsigned char* smem, lds_ptr lds3) {
    const int G = nblk_(), bid = bid_();
    unsigned char* U = p.ws + WS_U;
    const bf16_t* Z = (const bf16_t*)(U + U_Z);
    const bf16_t* QRAW = (const bf16_t*)(U + U_QRAW); const bf16_t* KVRAW = (const bf16_t*)(U + U_KVRAW);
    const bf16_t* KSR = (const bf16_t*)(p.ws + WS_KSR); const bf16_t* KRR = (const bf16_t*)(p.ws + WS_KRR);
    bf16_t* YC = (bf16_t*)(U + U_YCAT);
    const float2* tS = (const float2*)(p.ws + WS_TAB); const float2* tM = tS + 320 * 16;
    const float mla_scale = 0.10206207261596575f * LOG2E;
    const float swa_scale = 0.125f * LOG2E;
    unsigned failmask = 0u;
    for (int pass = 0; pass < 2; ++pass) {
        int slot = 0;
        for (int ii = bid; ii < 512 + G; ii += G, ++slot) {
            const int i = (ii < 512) ? ii : ((ii - 512 >= G - 8) ? 512 + (ii - 512 - (G - 8)) : -1);
            if (i < 0) continue;
            if (pass == 1 && !((failmask >> slot) & 1u)) continue;
            int b, hd, q0row, t0, rowA, lenA; bool rope;
            if (i < 512) { const int bh = i & 7, qt = i >> 3; b = bh >> 2; hd = bh & 3; t0 = qt * 256; q0row = b * SEQ + t0; rowA = b * SEQ; lenA = SEQ; rope = true; }
            else { const int k = i - 512; b = k >> 2; hd = k & 3; t0 = 0; q0row = NLAT + b * CTXL; rowA = 0; lenA = 0; rope = false; }
            if (pass == 0) {
                const bool ok = attn_item<96, false, true>(smem, lds3, tM, tM + 256 * 8, QRAW + (size_t)q0row * 512 + hd * 96, 512, rope, t0, mla_scale,
                              KVRAW + hd * 128, 512, KRR, KVRAW + hd * 128 + 64, 512,
                              rowA, lenA, 0, NLAT + b * CTXL, CTXL, 0.f, 0.f, true, YC + (size_t)q0row * 1024 + 512 + hd * 64);
                if (!ok) failmask |= 1u << slot;
            } else {
                attn_item<96, false, false>(smem, lds3, tM, tM + 256 * 8, QRAW + (size_t)q0row * 512 + hd * 96, 512, rope, t0, mla_scale,
                              KVRAW + hd * 128, 512, KRR, KVRAW + hd * 128 + 64, 512,
                              rowA, lenA, 0, NLAT + b * CTXL, CTXL, 0.f, 0.f, true, YC + (size_t)q0row * 1024 + 512 + hd * 64);
            }
        }
        if (failmask == 0u) break;
    }
    for (int ii = bid; ii < 512 + G; ii += G) {
        const int i = (ii < 512) ? ii : ((ii - 512 >= G - 16 && ii - 512 < G - 8) ? 512 + (ii - 512 - (G - 16)) : -1);
        if (i < 0) continue;
        int b, hd, q0row, t0, rowA, lenA, posA; bool rope;
        if (i < 512) {
            const int bh = i & 7, qt = i >> 3; b = bh >> 2; hd = bh & 3; t0 = qt * 256; q0row = b * SEQ + t0; rope = true;
            posA = max(t0 - 128, 0); const int endA = min(t0 + 384, SEQ); rowA = b * SEQ + posA; lenA = endA - posA;
        } else { const int k = i - 512; b = k >> 2; hd = k & 3; t0 = 0; q0row = NLAT + b * CTXL; rowA = 0; lenA = 0; posA = 0; rope = false; }
        const int kvh = hd >> 1;
        const float sink = p.in[9][l * 4 + hd] * LOG2E;
        attn_item<64, true>(smem, lds3, tS, tS + 256 * 16, Z + (size_t)q0row * DINP + C_SWA_Q + hd * 64, DINP, rope, t0, swa_scale,
                      KSR + kvh * 64, 128, nullptr, Z + C_SWA_V + kvh * 64, DINP,
                      rowA, lenA, posA, NLAT + b * CTXL, CTXL, sink, 1.f, false, YC + (size_t)q0row * 1024 + 256 + hd * 64);
    }
    for (int c = bid; c < 260; c += G) sgu_item(smem, lds3, p, l, c);
}

#define XB_TMO      128
#define XB_XCNT(j)  (256  + 64 * (j))
#define XB_XSUB(j)  (1280 + 64 * (j))
#define XB_XGEN(j)  (2304 + 64 * (j))
#define XB_TOP      3328
#define XB_TOPGEN   3392
#define XCD_BAR_WORDS 3456
#define XB_SPIN_CAP (1u << 18)
#define LAS __attribute__((address_space(3)))

__device__ __forceinline__ unsigned xb_ld(unsigned* p)              { return __hip_atomic_load(p, __ATOMIC_RELAXED, __HIP_MEMORY_SCOPE_AGENT); }
__device__ __forceinline__ unsigned xb_add(unsigned* p, unsigned v) { return __hip_atomic_fetch_add(p, v, __ATOMIC_RELAXED, __HIP_MEMORY_SCOPE_AGENT); }
__device__ __forceinline__ unsigned xb_xcc_id() { return (unsigned)__builtin_amdgcn_s_getreg((3 << 11) | 20) & 0xFu; }
#define XB_SPIN(cond, bar) do { unsigned _sp = 0; while (cond) { __builtin_amdgcn_s_sleep(1); \
    if ((++_sp & 255u) == 0u) { if (xb_ld(&(bar)[XB_TMO])) break; if (_sp > XB_SPIN_CAP) { atomicAdd(&(bar)[XB_TMO], 1u); break; } } } } while (0)

struct XcdBarrier {
    unsigned* bar; unsigned x;
    volatile LAS unsigned* st;
};

__device__ __forceinline__ XcdBarrier xcd_barrier_post(unsigned* bar, volatile LAS unsigned* st) {
    XcdBarrier b; b.bar = bar; b.x = xb_xcc_id(); b.st = st;
    if (threadIdx.x == 0) (void)xb_add(&bar[XB_XCNT(b.x)], 1u);
    return b;
}
__device__ __forceinline__ void xcd_barrier_complete(unsigned* bar, unsigned x, unsigned& nloc, unsigned& nx) {
    const unsigned G = gridDim.x * gridDim.y * gridDim.z;
    unsigned sum, cnt, mine, sp = 0u;
    for (;;) {
        sum = 0u; cnt = 0u; mine = 0u;
#pragma unroll
        for (unsigned j = 0; j < 16; ++j) { const unsigned c = xb_ld(&bar[XB_XCNT(j)]); sum += c; cnt += (c > 0u) ? 1u : 0u; mine = (j == x) ? c : mine; }
        if (sum == G) break;
        __builtin_amdgcn_s_sleep(1);
        if ((++sp & 255u) == 0u) { if (xb_ld(&bar[XB_TMO])) break; if (sp > XB_SPIN_CAP) { atomicAdd(&bar[XB_TMO], 1u); break; } }
    }
    nloc = mine > 0u ? mine : 1u; nx = cnt > 0u ? cnt : 1u;
}

__device__ __forceinline__ void xcd_barrier(const XcdBarrier& b) {
    asm volatile("s_waitcnt vmcnt(0)" ::: "memory");
    __syncthreads();
    if (threadIdx.x == 0) {
        unsigned* bar = b.bar;
        __builtin_amdgcn_s_waitcnt(0);
        unsigned nloc = b.st[0], nx = b.st[1];
        if (nloc == 0u) { xcd_barrier_complete(bar, b.x, nloc, nx); b.st[0] = nloc; b.st[1] = nx; }
        const unsigned old = xb_add(&bar[XB_XSUB(b.x)], 1u);
        const unsigned gen = old / nloc;
        if (old + 1u == (gen + 1u) * nloc) {
            __builtin_amdgcn_fence(__ATOMIC_RELEASE, "agent");
            asm volatile("s_waitcnt vmcnt(0)" ::: "memory");
            const unsigned og = xb_add(&bar[XB_TOP], 1u);
            const unsigned tg = og / nx;
            if (og + 1u == (tg + 1u) * nx) xb_add(&bar[XB_TOPGEN], 1u);
            else XB_SPIN(xb_ld(&bar[XB_TOPGEN]) == tg, bar);
            __builtin_amdgcn_fence(__ATOMIC_ACQUIRE, "agent");
            xb_add(&bar[XB_XGEN(b.x)], 1u);
            asm volatile("s_waitcnt vmcnt(0)" ::: "memory");
        } else {
            XB_SPIN(xb_ld(&bar[XB_XGEN(b.x)]) == gen, bar);
            __builtin_amdgcn_fence(__ATOMIC_ACQUIRE, "agent");
            asm volatile("s_waitcnt vmcnt(0)" ::: "memory");
        }
    }
    __syncthreads();
}


DI void grid_bar(lds_ptr lds3) {
    XcdBarrier b; b.bar = (unsigned*)(params_().ws + WS_BAR); b.x = xb_xcc_id(); b.st = (volatile LAS unsigned*)(lds3 + LDS_BYTES);
    xcd_barrier(b);
}

__global__ __launch_bounds__(512, 2) void fwd_megakernel(Params p_unused) {
    extern __shared__ __attribute__((aligned(16))) unsigned char smem[];
    cg::grid_group grid = cg::this_grid();
    lds_ptr lds3 = (lds_ptr)smem;
    {
        const Params& p = params_();
        if (blockIdx.x == 0) { unsigned* bw = (unsigned*)(p.ws + WS_BAR); for (int i = threadIdx.x; i < XCD_BAR_WORDS; i += 512) bw[i] = 0u; }
        if (threadIdx.x == 0) { *(volatile LAS unsigned*)(lds3 + LDS_BYTES) = 0u; *(volatile LAS unsigned*)(lds3 + LDS_BYTES + 4) = 0u; }
        phase_adaln(p, (float*)smem);
        phase_tables(p);
        convert_layer(p, 0, smem);
    }
    grid.sync();
    (void)xcd_barrier_post((unsigned*)(params_().ws + WS_BAR), (volatile LAS unsigned*)(lds3 + LDS_BYTES));
    {
        const Params& p = params_();
        phase_ln(p, 0, nullptr, nullptr, (const float*)(p.ws + WS_MOD), 0);
    }
    grid_bar(lds3);
    for (int l = 0; l < DEPTH; ++l) {
        {
            const Params& p = params_(); unsigned char* U = p.ws + WS_U;
            pg8::EpiBf16<0> E; E.O = (bf16_t*)(U + U_Z); E.ldc = DINP; E.bias = nullptr; E.split_cols = 0; E.split_stride = 0;
            run_gemm(lds3, (const bf16_t*)(U + U_H), (const bf16_t*)(p.ws + W_IN), R, DINP, 1024, E);
        }
        grid_bar(lds3);
        phase_postz(params_(), l);
        grid_bar(lds3);
        {
            const Params& p = params_(); unsigned char* U = p.ws + WS_U;
            pg8::EpiBf16<0> E; E.bias = nullptr; E.split_cols = 0; E.split_stride = 0;
            E.O = (bf16_t*)(U + U_QRAW); E.ldc = 512;
            run_gemm(lds3, (const bf16_t*)(U + U_CQN), (const bf16_t*)(p.ws + W_UQ), R, 512, 256, E);
        }
        {
            const Params& p = params_(); unsigned char* U = p.ws + WS_U;
            pg8::EpiBf16<0> E; E.bias = nullptr; E.split_cols = 0; E.split_stride = 0;
            E.O = (bf16_t*)(U + U_KVRAW); E.ldc = 512;
            run_gemm(lds3, (const bf16_t*)(U + U_CKVN), (const bf16_t*)(p.ws + W_UKV), R, 512, 256, E, nblk_() - 8);
        }
        {
            const Params& p = params_(); unsigned char* U = p.ws + WS_U;
            pg8::EpiBf16<0> E; E.bias = nullptr; E.split_cols = 0; E.split_stride = 0;
            E.O = (bf16_t*)(U + U_YCAT); E.ldc = 1024;
            run_gemm(lds3, (const bf16_t*)(U + U_DPOOL), (const bf16_t*)(p.ws + W_POOL), R, 256, 256, E, nblk_() - 16);
        }
        grid_bar(lds3);
        phase_mix(params_(), l, smem, lds3);
        grid_bar(lds3);
        {
            const Params& p = params_(); unsigned char* U = p.ws + WS_U;
            EpiScaleBf16 E; E.O = (bf16_t*)(U + U_Z); E.modl = (const float*)(p.ws + WS_MOD) + (size_t)l * 3 * 6144; E.idx = 2;
            run_gemm(lds3, (const bf16_t*)(U + U_YCAT), (const bf16_t*)(p.ws + W_OUT), (l + 1 < DEPTH) ? R : NLAT, 1024, 1024, E);
        }
        grid_bar(lds3);
        {
            const Params& p = params_();
            phase_ln(p, 1, p.in[19] + l * 1024, p.in[20] + l * 1024, (const float*)(p.ws + WS_MOD) + (size_t)l * 3 * 6144, 3,
                     (const bf16_t*)(p.ws + WS_U + U_Z), (l + 1 < DEPTH) ? R : NLAT);
        }
        grid_bar(lds3);
        {
            const Params& p = params_(); unsigned char* U = p.ws + WS_U;
            EpiRelu2 E; E.O = (bf16_t*)(U + U_F1); E.ldc = 4096;
            run_gemm(lds3, (const bf16_t*)(U + U_H), (const bf16_t*)(p.ws + W_FF1), (l + 1 < DEPTH) ? R : NLAT, 4096, 1024, E);
        }
        grid_bar(lds3);
        {
            const Params& p = params_(); unsigned char* U = p.ws + WS_U;
            EpiScaleBf16 E; E.O = (bf16_t*)(U + U_H); E.modl = (const float*)(p.ws + WS_MOD) + (size_t)l * 3 * 6144; E.idx = 5;
            run_gemm(lds3, (const bf16_t*)(U + U_F1), (const bf16_t*)(p.ws + W_FF2), (l + 1 < DEPTH) ? R : NLAT, 1024, 4096, E);
        }
        grid_bar(lds3);
        {
            const Params& p = params_();
            const float* modl = (const float*)(p.ws + WS_MOD) + (size_t)l * 3 * 6144;
            if (l + 1 < DEPTH) {
                phase_ln(p, 1, p.in[23] + l * 1024, p.in[24] + l * 1024, modl + 3 * 6144, 0, (const bf16_t*)(p.ws + WS_U + U_H));
                convert_layer(p, l + 1, smem);
            } else {
                phase_ln(p, 2, p.in[23] + l * 1024, p.in[24] + l * 1024, modl, 0, (const bf16_t*)(p.ws + WS_U + U_H));
            }
        }
        grid_bar(lds3);
    }
}

extern "C" void kernel_launch(void* const* d_in, const int* in_sizes, int n_in, void* d_out, int out_size, void* d_ws, size_t ws_size, hipStream_t stream) {
    static int grid_blocks = 0;
    if (!grid_blocks) {
        int dev = 0, cus = 0, per_cu = 0;
        hipGetDevice(&dev);
        hipDeviceGetAttribute(&cus, hipDeviceAttributeMultiprocessorCount, dev);
        if (hipFuncSetAttribute((const void*)fwd_megakernel, hipFuncAttributeMaxDynamicSharedMemorySize, LDS_ALLOC) != hipSuccess)
            fprintf(stderr, "kernel_launch: hipFuncSetAttribute(%d B LDS) failed\n", LDS_BYTES);
        if (hipOccupancyMaxActiveBlocksPerMultiprocessor(&per_cu, (const void*)fwd_megakernel, 512, LDS_ALLOC) != hipSuccess || per_cu < 1) per_cu = 1;
        (void)hipGetLastError();
        grid_blocks = cus * per_cu;
        if (ws_size < WS_END) fprintf(stderr, "kernel_launch: workspace %zu < needed %zu\n", ws_size, (size_t)WS_END);
    }
    Params p{};
    for (int i = 0; i < 25; ++i) p.in[i] = (const float*)d_in[i];
    p.out = (float*)d_out; p.ws = (unsigned char*)d_ws;
    void* args[] = {&p};
    hipError_t e = hipLaunchCooperativeKernel((const void*)fwd_megakernel, dim3(grid_blocks), dim3(512), args, LDS_ALLOC, stream);
    if (e != hipSuccess) fprintf(stderr, "cooperative launch failed: %s (grid %d)\n", hipGetErrorString(e), grid_blocks);
}
```
